# Optimizing an MI355X kernel written in HIP

```python
import math
import jax, jax.numpy as jnp
from jax import lax
import numpy as np

D_MODEL = 1024
BATCH = 16
SEQ = 2048
DEPTH = 4

D_MIX = D_MODEL
A_HEADS = 4
A_QK_DIM = 32
A_V_DIM = 64
B_HEADS = 4
B_DIM = 64
B_CONFIGS = ((128, 1), (512, 4), (2048, 16))
B_BLOCK = 64
C_HEADS = 8
C_NOPE = 64
C_ROPE = 32
C_V = 64
C_Q_RANK = 256
C_KV_RANK = 128
ROPE_BASE = 10000.0
D_FF = 2816
CONV_W = 3
Q_BLOCK = 128
EPS = 1e-6
NEG = -1e30

A_Q_COLS = A_HEADS * 2 * A_QK_DIM
A_K_COLS = A_HEADS * 2 * A_QK_DIM
A_V_COLS = A_HEADS * A_V_DIM
B_COLS = B_HEADS * B_DIM
IN_SPLITS = (A_Q_COLS, A_K_COLS, A_V_COLS, B_COLS, B_COLS, B_COLS,
             C_Q_RANK, C_KV_RANK, C_ROPE)
N_IN = sum(IN_SPLITS)

kernel_name = "hybrid_diff_dilated_mla_encoder"


def _alibi_slopes():
    n = A_HEADS + B_HEADS
    s = (2.0 ** (-8.0 * np.arange(1, n + 1) / n)).astype(np.float32)
    return jnp.asarray(s[0::2]), jnp.asarray(s[1::2])


def _rmsnorm(x, g):
    xf = x.astype(jnp.float32)
    y = xf * lax.rsqrt(jnp.mean(xf * xf, axis=-1, keepdims=True) + EPS)
    return (y * g.astype(jnp.float32)).astype(x.dtype)


def _heads(t, n_heads):
    b, s, _ = t.shape
    return t.reshape(b, s, n_heads, -1).transpose(0, 2, 1, 3)


def _merge_heads(t):
    b, h, s, d = t.shape
    return t.transpose(0, 2, 1, 3).reshape(b, s, h * d)


def _rope(t, cos, sin):
    half = t.shape[-1] // 2
    t1 = t[..., :half].astype(jnp.float32)
    t2 = t[..., half:].astype(jnp.float32)
    return jnp.concatenate([t1 * cos - t2 * sin, t2 * cos + t1 * sin], axis=-1).astype(t.dtype)


def _sweep_queries(block_fn, qs):
    b, h, s, _ = qs[0].shape
    nq = s // Q_BLOCK
    blocks = tuple(q.reshape(b, h, nq, Q_BLOCK, q.shape[-1]).transpose(2, 0, 1, 3, 4) for q in qs)
    out = lax.map(lambda a: block_fn(a[0], *a[1]), (jnp.arange(nq), blocks))
    return out.transpose(1, 2, 0, 3, 4).reshape(b, h, s, -1)


def _diff_attention(q1, q2, k1, k2, v, lam, slopes):
    s_len = k1.shape[2]
    scale = A_QK_DIM ** -0.5
    kpos = jnp.arange(s_len)

    def block(i, qb1, qb2):
        qpos = i * Q_BLOCK + jnp.arange(Q_BLOCK)
        dist = jnp.abs(qpos[:, None] - kpos[None, :]).astype(jnp.float32)
        bias = -slopes[:, None, None] * dist
        s1 = jnp.einsum('bhqd,bhkd->bhqk', qb1, k1).astype(jnp.float32) * scale + bias
        s2 = jnp.einsum('bhqd,bhkd->bhqk', qb2, k2).astype(jnp.float32) * scale + bias
        p = jax.nn.softmax(s1, axis=-1) - lam * jax.nn.softmax(s2, axis=-1)
        return jnp.einsum('bhqk,bhkd->bhqd', p.astype(v.dtype), v)

    return _sweep_queries(block, (q1, q2))


def _dilated_branch(q, k, v, window, dil, slopes):
    b, h, s_len, d = q.shape
    half = window // (2 * dil)
    L = s_len // dil
    nb = -(-L // B_BLOCK)
    lp = nb * B_BLOCK
    scale = d ** -0.5

    def to_sub(t):
        t = t.reshape(b, h, L, dil, d).transpose(0, 1, 3, 2, 4)
        return jnp.pad(t, ((0, 0), (0, 0), (0, 0), (0, lp - L), (0, 0)))

    def band(t):
        tb = t.reshape(b, h, dil, nb, B_BLOCK, d)
        tb = jnp.pad(tb, ((0, 0), (0, 0), (0, 0), (1, 1), (0, 0), (0, 0)))
        return jnp.concatenate([tb[:, :, :, :-2], tb[:, :, :, 1:-1], tb[:, :, :, 2:]], axis=4)

    qb = to_sub(q).reshape(b, h, dil, nb, B_BLOCK, d)
    kb = band(to_sub(k))
    vb = band(to_sub(v))
    sc = jnp.einsum('bhrnqd,bhrnkd->bhrnqk', qb, kb).astype(jnp.float32) * scale
    a_idx = jnp.arange(B_BLOCK)
    c_idx = jnp.arange(3 * B_BLOCK)
    rel = c_idx[None, :] - B_BLOCK - a_idx[:, None]
    kidx = (jnp.arange(nb)[:, None, None] - 1) * B_BLOCK + c_idx[None, None, :]
    valid = (jnp.abs(rel) <= half)[None] & (kidx >= 0) & (kidx < L)
    dist = (dil * jnp.abs(rel)).astype(jnp.float32)
    bias = -slopes[:, None, None, None, None] * dist
    sc = jnp.where(valid, sc + bias, NEG)
    m = jnp.max(sc, axis=-1, keepdims=True)
    p = jnp.exp(sc - m)
    den = jnp.sum(p, axis=-1, keepdims=True)
    o = jnp.einsum('bhrnqk,bhrnkd->bhrnqd', (p / den).astype(v.dtype), vb)
    lse = (m + jnp.log(den))[..., 0]
    o = o.reshape(b, h, dil, lp, d)[:, :, :, :L].transpose(0, 1, 3, 2, 4).reshape(b, h, s_len, d)
    lse = lse.reshape(b, h, dil, lp)[:, :, :, :L].transpose(0, 1, 3, 2).reshape(b, h, s_len)
    return o, lse


def _dilated_attention(q, k, v, slopes):
    outs, lses = [], []
    for window, dil in B_CONFIGS:
        o, lse = _dilated_branch(q, k, v, window, dil, slopes)
        outs.append(o)
        lses.append(lse)
    w = jax.nn.softmax(jnp.stack(lses, axis=0), axis=0)
    o = jnp.sum(w[..., None] * jnp.stack(outs, axis=0).astype(jnp.float32), axis=0)
    return o.astype(q.dtype)


def _mla_attention(q_nope, q_rope, k_nope, k_rope, v):
    scale = (C_NOPE + C_ROPE) ** -0.5

    def block(i, qn, qr):
        s = (jnp.einsum('bhqd,bhkd->bhqk', qn, k_nope)
             + jnp.einsum('bhqr,bkr->bhqk', qr, k_rope)).astype(jnp.float32) * scale
        p = jax.nn.softmax(s, axis=-1)
        return jnp.einsum('bhqk,bhkd->bhqd', p.astype(v.dtype), v)

    return _sweep_queries(block, (q_nope, q_rope))


def setup_inputs(seed: int = 0) -> dict:
    key = jax.random.key(seed)
    ks = jax.random.split(key, 20)
    f32 = jnp.float32

    def nrm(k, shape, scale):
        return jax.random.normal(k, shape, f32) * scale

    def gain(k, shape):
        return 1.0 + 0.01 * jax.random.normal(k, shape, f32)

    return {
        "x": jax.random.normal(ks[0], (BATCH, SEQ, D_MODEL), f32),
        "w_in": nrm(ks[1], (DEPTH, D_MODEL, N_IN), D_MODEL ** -0.5),
        "g_attn": gain(ks[2], (DEPTH, D_MODEL)),
        "a_lq1": nrm(ks[3], (DEPTH, A_QK_DIM), 0.1),
        "a_lk1": nrm(ks[4], (DEPTH, A_QK_DIM), 0.1),
        "a_lq2": nrm(ks[5], (DEPTH, A_QK_DIM), 0.1),
        "a_lk2": nrm(ks[6], (DEPTH, A_QK_DIM), 0.1),
        "a_subln": gain(ks[7], (DEPTH, A_V_DIM)),
        "c_g_q": gain(ks[8], (DEPTH, C_Q_RANK)),
        "c_w_uq": nrm(ks[9], (DEPTH, C_Q_RANK, C_HEADS * (C_NOPE + C_ROPE)), C_Q_RANK ** -0.5),
        "c_g_kv": gain(ks[10], (DEPTH, C_KV_RANK)),
        "c_w_ukv": nrm(ks[11], (DEPTH, C_KV_RANK, C_HEADS * (C_NOPE + C_V)), C_KV_RANK ** -0.5),
        "w_out": nrm(ks[12], (DEPTH, D_MIX, D_MODEL), D_MIX ** -0.5),
        "g_ffn": gain(ks[13], (DEPTH, D_MODEL)),
        "w_up": nrm(ks[14], (DEPTH, D_MODEL, 2 * D_FF), D_MODEL ** -0.5),
        "conv_w": nrm(ks[15], (DEPTH, CONV_W, 2 * D_FF), CONV_W ** -0.5),
        "conv_b": nrm(ks[16], (DEPTH, 2 * D_FF), 0.01),
        "w_down": nrm(ks[17], (DEPTH, D_FF, D_MODEL), D_FF ** -0.5),
        "g_final": gain(ks[18], (D_MODEL,)),
    }


def reference(x, w_in, g_attn, a_lq1, a_lk1, a_lq2, a_lk2, a_subln, c_g_q, c_w_uq,
              c_g_kv, c_w_ukv, w_out, g_ffn, w_up, conv_w, conv_b, w_down, g_final):
    b, s_len, _ = x.shape
    slopes_a, slopes_b = _alibi_slopes()
    pos = jnp.arange(s_len, dtype=jnp.float32)
    inv_freq = ROPE_BASE ** (-jnp.arange(0, C_ROPE, 2, dtype=jnp.float32) / C_ROPE)
    ang = pos[:, None] * inv_freq[None, :]
    cos, sin = jnp.cos(ang), jnp.sin(ang)
    split_idx = [int(i) for i in np.cumsum(IN_SPLITS)[:-1]]

    for l in range(DEPTH):
        h = _rmsnorm(x, g_attn[l])
        proj = h @ w_in[l]
        a_q, a_k, a_v, b_q, b_k, b_v, c_q, c_kv, c_kr = jnp.split(proj, split_idx, axis=-1)

        a_q = a_q.reshape(b, s_len, A_HEADS, 2, A_QK_DIM).transpose(0, 2, 3, 1, 4)
        a_k = a_k.reshape(b, s_len, A_HEADS, 2, A_QK_DIM).transpose(0, 2, 3, 1, 4)
        lam_init = 0.8 - 0.6 * math.exp(-0.3 * l)
        lam = (jnp.exp(jnp.sum(a_lq1[l].astype(jnp.float32) * a_lk1[l].astype(jnp.float32)))
               - jnp.exp(jnp.sum(a_lq2[l].astype(jnp.float32) * a_lk2[l].astype(jnp.float32)))
               + lam_init)
        a_o = _diff_attention(a_q[:, :, 0], a_q[:, :, 1], a_k[:, :, 0], a_k[:, :, 1],
                              _heads(a_v, A_HEADS), lam, slopes_a)
        a_o = _rmsnorm(a_o, a_subln[l]) * (1.0 - lam_init)
        a_out = _merge_heads(a_o)

        b_o = _dilated_attention(_heads(b_q, B_HEADS), _heads(b_k, B_HEADS),
                                 _heads(b_v, B_HEADS), slopes_b)
        b_out = _merge_heads(b_o)

        cq = _rmsnorm(c_q, c_g_q[l]) @ c_w_uq[l]
        cq = cq.reshape(b, s_len, C_HEADS, C_NOPE + C_ROPE)
        q_nope = cq[..., :C_NOPE].transpose(0, 2, 1, 3)
        q_rope = _rope(cq[..., C_NOPE:], cos[:, None, :], sin[:, None, :]).transpose(0, 2, 1, 3)
        ckv = (_rmsnorm(c_kv, c_g_kv[l]) @ c_w_ukv[l]).reshape(b, s_len, C_HEADS, C_NOPE + C_V)
        k_nope = ckv[..., :C_NOPE].transpose(0, 2, 1, 3)
        c_v = ckv[..., C_NOPE:].transpose(0, 2, 1, 3)
        k_rope = _rope(c_kr, cos, sin)
        c_out = _merge_heads(_mla_attention(q_nope, q_rope, k_nope, k_rope, c_v))

        mix = jnp.concatenate([a_out, b_out, c_out], axis=-1)
        x = x + mix @ w_out[l]

        h = _rmsnorm(x, g_ffn[l])
        u = h @ w_up[l]
        up = jnp.pad(u, ((0, 0), (1, 1), (0, 0)))
        cw = conv_w[l]
        u = up[:, :-2] * cw[0] + up[:, 1:-1] * cw[1] + up[:, 2:] * cw[2] + conv_b[l]
        gate, val = u[..., :D_FF], u[..., D_FF:]
        x = x + (jax.nn.silu(gate) * val) @ w_down[l]

    return _rmsnorm(x, g_final)
```

```cpp
#include <hip/hip_runtime.h>
#include <hip/hip_cooperative_groups.h>
#include <cstdint>
#include <cstdio>
namespace cg = cooperative_groups;

#define LAS __attribute__((address_space(3)))
typedef unsigned short bf16_t;
typedef short bf16x8 __attribute__((ext_vector_type(8)));
typedef short s16x4 __attribute__((ext_vector_type(4)));
typedef float f32x4 __attribute__((ext_vector_type(4)));
typedef float f32x2 __attribute__((ext_vector_type(2)));
typedef float f32x16 __attribute__((ext_vector_type(16)));
typedef unsigned u32x4 __attribute__((ext_vector_type(4)));
typedef unsigned u32x2 __attribute__((ext_vector_type(2)));
typedef __bf16 bf16x2_t __attribute__((ext_vector_type(2)));

constexpr int T_TOK = 32768, SEQ = 2048, DM = 1024, DEPTH = 4;
constexpr int NPROJ = 2048, NIN = 1952, DFF = 2816, NUP = 5632;
constexpr int NCQ = 768, NCKV = 1024;
constexpr float EPS = 1e-6f;
constexpr float LOG2E = 1.4426950408889634f;

constexpr size_t MiB = 1u << 20;
constexpr size_t WS_LAM = 512 * 1024;
constexpr size_t WS_COS = 576 * 1024, WS_SIN = 704 * 1024;
constexpr size_t WS_W = 1 * MiB;
constexpr size_t W_IN = 0, W_OUT = W_IN + (size_t)NPROJ * DM * 2, W_UP = W_OUT + (size_t)DM * DM * 2, W_DOWN = W_UP + (size_t)NUP * DM * 2,
                 W_UQ = W_DOWN + (size_t)DM * DFF * 2, W_UKV = W_UQ + (size_t)NCQ * 256 * 2, W_LAYER = W_UKV + (size_t)NCKV * 128 * 2;
static_assert(W_LAYER * DEPTH <= 93 * MiB, "weights");
constexpr size_t WS_XB = 94 * MiB, WS_PROJ = 158 * MiB, WS_CQ = 286 * MiB, WS_CKV = 334 * MiB, WS_MIX = 398 * MiB;
constexpr size_t WS_SSQA = 462 * MiB, WS_SSQB = 464 * MiB, WS_SSQQ = 466 * MiB, WS_SSQKV = 467 * MiB, WS_END = 468 * MiB;
constexpr size_t WS_ACT = 158 * MiB, WS_UBND = 334 * MiB;
static_assert(WS_ACT + (size_t)T_TOK * DFF * 2 <= WS_UBND && WS_UBND + (size_t)512 * 4 * NUP * 2 <= WS_MIX, "overlay");

constexpr int LDS_BYTES = 147456;
#ifndef MK_SKIP
#define MK_SKIP 0
#endif

struct Params {
    const float* x; const float* w_in; const float* g_attn; const float* a_lq1; const float* a_lk1; const float* a_lq2; const float* a_lk2;
    const float* a_subln; const float* c_g_q; const float* c_w_uq; const float* c_g_kv; const float* c_w_ukv; const float* w_out; const float* g_ffn;
    const float* w_up; const float* conv_w; const float* conv_b; const float* w_down; const float* g_final;
    float* out; unsigned char* ws;
};

__device__ __forceinline__ unsigned cvtpk(float lo, float hi) { f32x2 v = {lo, hi}; bf16x2_t b = __builtin_convertvector(v, bf16x2_t); return __builtin_bit_cast(unsigned, b); }
__device__ __forceinline__ float bf2f(unsigned short b) { return __uint_as_float((unsigned)b << 16); }
__device__ __forceinline__ float wave_sum(float v) {
#pragma unroll
    for (int o = 1; o < 64; o <<= 1) v += __shfl_xor(v, o);
    return v;
}
__device__ __forceinline__ float ld_agent(const float* p) { return __hip_atomic_load(p, __ATOMIC_RELAXED, __HIP_MEMORY_SCOPE_AGENT); }
template <int NS> __device__ __forceinline__ float ssq_sum(const float* p) {
    float t = 0.f;
#pragma unroll
    for (int i = 0; i < NS / 4; ++i) { const f32x4 v = *(const f32x4*)(p + 4 * i); t += (v[0] + v[1]) + (v[2] + v[3]); }
    return t;
}
__device__ __forceinline__ float fast_exp2(float x) { return __builtin_amdgcn_exp2f(x); }
__device__ __forceinline__ float fast_rcp(float x) { return __builtin_amdgcn_rcpf(x); }

namespace pg8 {
constexpr int BM = 256, BK = 64, HALF = 128, HTB = HALF * BK * 2, STAGE_BYTES = 8 * HTB, NXCD = 8, WGM = 8;
__host__ __device__ __forceinline__ int lds_byte(int r, int c) { const int st = (r >> 4) * 2 + (c >> 5), rr = r & 15, cc = c & 31, ob = rr * 64 + cc * 2; return st * 1024 + (ob ^ (((ob >> 9) & 1) << 5)); }
__host__ __device__ __forceinline__ void stage_rc(int b, int& R, int& C) { const int st = b / 1024, sb = b % 1024, swz = sb ^ (((sb >> 9) & 1) << 5); R = (st >> 1) * 16 + swz / 64; C = (st & 1) * 32 + (swz % 64) / 2; }
__host__ __device__ __forceinline__ int perm32(int rho) { const int n = rho >> 4, i = rho & 15; return 8 * (i >> 2) + 4 * n + (i & 3); }
struct Unit { int pm, pn; };
struct Gemm { const bf16_t* A; const bf16_t* Bt; int M, N, K, lda; };
struct StaticOrder {
    int nM, nN, nwg, G, c;
    __device__ void init(int M, int N, int G_, int c_) { nM = M / BM; nN = N / BM; nwg = nM * nN; G = G_; c = c_; }
    __device__ bool next(int i, Unit& u) const {
        const long L = (long)i * G + c; if (L >= nwg) return false;
        int wgid = (int)L; { const int q = nwg / NXCD, r = nwg % NXCD, xcd = wgid % NXCD, off = wgid / NXCD; wgid = (xcd < r ? xcd * (q + 1) : r * (q + 1) + (xcd - r) * q) + off; }
        const int nig = WGM * nN, gid = wgid / nig, fm = gid * WGM, gsz = (nM - fm) < WGM ? (nM - fm) : WGM;
        u.pm = fm + ((wgid % nig) % gsz); u.pn = (wgid % nig) / gsz; return true;
    }
};

template <class Epi>
__device__ __forceinline__ void gemm_phase(LAS unsigned char* lds, const Gemm g, const Epi& E) {
    int tid = threadIdx.x; asm volatile("" : "+v"(tid));
    const int wid = __builtin_amdgcn_readfirstlane(tid >> 6), lane = tid & 63, wr = wid >> 2, wc = wid & 3, fr = lane & 15, fq = lane >> 4;
    int K = g.K, lda = g.lda; asm volatile("" : "+s"(K), "+s"(lda));
    const int nt = K / BK;
    StaticOrder S; S.init(g.M, g.N, (int)gridDim.x, (int)blockIdx.x);
    unsigned voffA[2], voffB[2];
#pragma unroll
    for (int i = 0; i < 2; ++i) { int R, C; stage_rc(tid * 16 + i * 8192, R, C); const int Rb = Epi::PERM ? ((R & ~31) + perm32(R & 31)) : R;
        voffA[i] = (unsigned)(R * lda + C) * 2u; voffB[i] = (unsigned)(Rb * K + C) * 2u; }
    const size_t kstep = (size_t)(BK * 2);
    const size_t hstepA = (size_t)HALF * lda * 2, hstepB = (size_t)HALF * K * 2;
    const size_t tstepA = 2 * hstepA, tstepB = 2 * hstepB;
    const unsigned ldsw = (unsigned)wid * 1024u;
    const int aoff = lds_byte(wr * 64 + fr, fq * 8), boff = lds_byte(wc * 32 + fr, fq * 8);
#define PG8_SA(b, h) (((b) * 2 + (h)) * HTB)
#define PG8_SB(b, h) ((4 + (b) * 2 + (h)) * HTB)
#define PG8_STAGE(bufoff, gbase, voff) do { _Pragma("unroll") for (int _i = 0; _i < 2; ++_i) \
        __builtin_amdgcn_global_load_lds((const unsigned*)((const char*)(gbase) + (voff)[_i]), (LAS unsigned*)(lds + (bufoff) + ldsw + _i * 8192), 16, 0, 0); } while (0)
#define PG8_LDA(dst, b, h) do { _Pragma("unroll") for (int m = 0; m < 4; ++m) _Pragma("unroll") for (int k = 0; k < 2; ++k) dst[m][k] = *(const LAS bf16x8*)(lds + PG8_SA(b, h) + aoff + m * 2048 + k * 1024); } while (0)
#define PG8_LDB(dst, b, h) do { _Pragma("unroll") for (int n = 0; n < 2; ++n) _Pragma("unroll") for (int k = 0; k < 2; ++k) dst[n][k] = *(const LAS bf16x8*)(lds + PG8_SB(b, h) + boff + n * 2048 + k * 1024); } while (0)
#define PG8_MMA(ai, bj, At, Bt) do { __builtin_amdgcn_s_setprio(1); _Pragma("unroll") for (int m = 0; m < 4; ++m) _Pragma("unroll") for (int n = 0; n < 2; ++n) _Pragma("unroll") for (int k = 0; k < 2; ++k) \
        acc[ai][bj][m][n] = __builtin_amdgcn_mfma_f32_16x16x32_bf16(Bt[n][k], At[m][k], acc[ai][bj][m][n], 0, 0, 0); __builtin_amdgcn_s_setprio(0); } while (0)
#define PG8_WAIT_V(n) asm volatile("s_waitcnt vmcnt(" #n ")" ::: "memory")
#define PG8_WAIT_L(n) asm volatile("s_waitcnt lgkmcnt(" #n ")" ::: "memory")
#define PG8_BAR __builtin_amdgcn_s_barrier()
#define PG8_SCHED __builtin_amdgcn_sched_barrier(0)
    Unit cur, nxt; int ui = 0;
    if (!S.next(0, cur)) return;
    f32x4 acc[2][2][4][2];
#pragma unroll
    for (int a = 0; a < 2; ++a)
#pragma unroll
        for (int b = 0; b < 2; ++b)
#pragma unroll
            for (int m = 0; m < 4; ++m)
#pragma unroll
                for (int n = 0; n < 2; ++n) acc[a][b][m][n] = (f32x4){0.f, 0.f, 0.f, 0.f};
    bf16x8 At[4][2], B0[2][2], B1[2][2];
    const char* cA = (const char*)g.A + (size_t)cur.pm * tstepA; const char* cB = (const char*)g.Bt + (size_t)cur.pn * tstepB;
    PG8_STAGE(PG8_SB(0, 0), cB, voffB); PG8_STAGE(PG8_SB(0, 1), cB + hstepB, voffB); PG8_STAGE(PG8_SA(0, 0), cA, voffA); PG8_STAGE(PG8_SA(0, 1), cA + hstepA, voffA);
    if (wr == 1) PG8_BAR;
    PG8_WAIT_V(2); PG8_BAR;
    PG8_STAGE(PG8_SB(1, 0), cB + kstep, voffB); PG8_STAGE(PG8_SA(1, 0), cA + kstep, voffA); PG8_STAGE(PG8_SB(1, 1), cB + hstepB + kstep, voffB);
    PG8_WAIT_V(6); PG8_BAR;
    for (;;) {
        const bool has_next = S.next(ui + 1, nxt);
        const char* nA = has_next ? (const char*)g.A + (size_t)nxt.pm * tstepA : cA; const char* nB = has_next ? (const char*)g.Bt + (size_t)nxt.pn * tstepB : cB;
        for (int t = 0; t < nt; t += 2) {
            const bool last = (t == nt - 2);
            const char* a1 = cA + (size_t)(t + 1) * kstep;
            const char* a2 = last ? nA : cA + (size_t)(t + 2) * kstep; const char* b2 = last ? nB : cB + (size_t)(t + 2) * kstep;
            const char* a3 = a2 + kstep; const char* b3 = b2 + kstep;
            PG8_LDB(B0, 0, 0); PG8_LDB(B1, 0, 1); PG8_SCHED; PG8_LDA(At, 0, 0); PG8_STAGE(PG8_SA(1, 1), a1 + hstepA, voffA);
            PG8_WAIT_V(8); PG8_WAIT_L(0); PG8_BAR; PG8_MMA(0, 0, At, B0); PG8_MMA(0, 1, At, B1); PG8_BAR; PG8_SCHED;
            PG8_LDA(At, 0, 1); PG8_STAGE(PG8_SB(0, 0), b2, voffB); PG8_STAGE(PG8_SB(0, 1), b2 + hstepB, voffB); PG8_STAGE(PG8_SA(0, 0), a2, voffA);
            PG8_WAIT_V(8); PG8_WAIT_L(0); PG8_BAR; PG8_MMA(1, 0, At, B0); PG8_MMA(1, 1, At, B1); PG8_BAR; PG8_SCHED;
            PG8_LDB(B0, 1, 0); PG8_LDB(B1, 1, 1); PG8_SCHED; PG8_LDA(At, 1, 0); PG8_STAGE(PG8_SA(0, 1), a2 + hstepA, voffA);
            PG8_WAIT_V(8); PG8_WAIT_L(0); PG8_BAR; PG8_MMA(0, 0, At, B0); PG8_MMA(0, 1, At, B1); PG8_BAR; PG8_SCHED;
            PG8_LDA(At, 1, 1); PG8_STAGE(PG8_SB(1, 0), b3, voffB); PG8_STAGE(PG8_SB(1, 1), b3 + hstepB, voffB); PG8_STAGE(PG8_SA(1, 0), a3, voffA);
            PG8_WAIT_V(8); PG8_WAIT_L(0); PG8_BAR; PG8_MMA(1, 0, At, B0); PG8_MMA(1, 1, At, B1); PG8_BAR; PG8_SCHED;
        }
        if (wr == 0) PG8_BAR;
        E(acc, cur, wr, wc, fr, fq);
        if (!has_next) break;
#pragma unroll
        for (int a = 0; a < 2; ++a)
#pragma unroll
            for (int b = 0; b < 2; ++b)
#pragma unroll
                for (int m = 0; m < 4; ++m)
#pragma unroll
                    for (int n = 0; n < 2; ++n) acc[a][b][m][n] = (f32x4){0.f, 0.f, 0.f, 0.f};
        cur = nxt; cA = nA; cB = nB; ++ui;
        if (wr == 1) PG8_BAR;
    }
    PG8_WAIT_V(0);
    PG8_BAR;
#undef PG8_SA
#undef PG8_SB
#undef PG8_STAGE
#undef PG8_LDA
#undef PG8_LDB
#undef PG8_MMA
#undef PG8_WAIT_V
#undef PG8_WAIT_L
#undef PG8_BAR
#undef PG8_SCHED
}
}
using pg8::Unit;
typedef f32x4 (&AccRef)[2][2][4][2];

__device__ __forceinline__ void rope8(f32x4& v0, f32x4& v1, const float* cosr, const float* sinr, int fq) {
    const int j0 = 8 * (fq & 1);
    const f32x4 c0 = *(const f32x4*)(cosr + j0), c1 = *(const f32x4*)(cosr + j0 + 4), s0 = *(const f32x4*)(sinr + j0), s1 = *(const f32x4*)(sinr + j0 + 4);
    const float sg = (fq < 2) ? -1.f : 1.f;
#pragma unroll
    for (int i = 0; i < 4; ++i) {
        const float p0 = __shfl_xor(v0[i], 32), p1 = __shfl_xor(v1[i], 32);
        v0[i] = v0[i] * c0[i] + sg * p0 * s0[i]; v1[i] = v1[i] * c1[i] + sg * p1 * s1[i];
    }
}

struct EpiProj {
    static constexpr bool PERM = true;
    bf16_t* O; const float* ssqx; float* ssqq; float* ssqkv; const float* cost; const float* sint;
    __device__ __forceinline__ void operator()(AccRef acc, const Unit& u, int wr, int wc, int fr, int fq) const {
        const int row0 = u.pm * 256 + wr * 64 + fr, col0 = u.pn * 256 + wc * 32 + 8 * fq;
#pragma unroll
        for (int ai = 0; ai < 2; ++ai)
#pragma unroll
            for (int m = 0; m < 4; ++m) {
                const int row = row0 + ai * 128 + m * 16;
                const float rs = rsqrtf(ssq_sum<16>(ssqx + (size_t)row * 16) * (1.0f / DM) + EPS);
                bf16_t* rowp = O + (size_t)row * NPROJ + col0;
#pragma unroll
                for (int bj = 0; bj < 2; ++bj) {
                    f32x4 v0 = acc[ai][bj][m][0] * rs, v1 = acc[ai][bj][m][1] * rs;
                    if (u.pn == 6 || (u.pn == 7 && bj == 0)) {
                        float s = (v0[0] * v0[0] + v0[1] * v0[1]) + (v0[2] * v0[2] + v0[3] * v0[3]) + (v1[0] * v1[0] + v1[1] * v1[1]) + (v1[2] * v1[2] + v1[3] * v1[3]);
                        s += __shfl_xor(s, 16); s += __shfl_xor(s, 32);
                        if (fq == 0) { if (u.pn == 6) ssqq[(size_t)row * 8 + bj * 4 + wc] = s; else ssqkv[(size_t)row * 4 + wc] = s; }
                    }
                    if (u.pn == 7 && bj == 1 && wc == 0) { const int pos = row & (SEQ - 1); rope8(v0, v1, cost + pos * 16, sint + pos * 16, fq); }
                    u32x4 w; w.x = cvtpk(v0[0], v0[1]); w.y = cvtpk(v0[2], v0[3]); w.z = cvtpk(v1[0], v1[1]); w.w = cvtpk(v1[2], v1[3]);
                    *(u32x4*)(rowp + bj * 128) = w;
                }
                asm volatile("" ::: "memory");
            }
    }
};
template <bool ROPE, int NS> struct EpiMla {
    static constexpr bool PERM = true;
    bf16_t* O; int ldc; const float* ssq; float inv_n; const float* cost; const float* sint;
    __device__ __forceinline__ void operator()(AccRef acc, const Unit& u, int wr, int wc, int fr, int fq) const {
        const int row0 = u.pm * 256 + wr * 64 + fr, col0 = u.pn * 256 + wc * 32 + 8 * fq;
#pragma unroll
        for (int ai = 0; ai < 2; ++ai)
#pragma unroll
            for (int m = 0; m < 4; ++m) {
                const int row = row0 + ai * 128 + m * 16;
                const float rs = rsqrtf(ssq_sum<NS>(ssq + (size_t)row * NS) * inv_n + EPS);
                bf16_t* rowp = O + (size_t)row * ldc + col0;
#pragma unroll
                for (int bj = 0; bj < 2; ++bj) {
                    f32x4 v0 = acc[ai][bj][m][0] * rs, v1 = acc[ai][bj][m][1] * rs;
                    if (ROPE) { const int g32 = u.pn * 8 + bj * 4 + wc; if (g32 % 3 == 2) { const int pos = row & (SEQ - 1); rope8(v0, v1, cost + pos * 16, sint + pos * 16, fq); } }
                    u32x4 w; w.x = cvtpk(v0[0], v0[1]); w.y = cvtpk(v0[2], v0[3]); w.z = cvtpk(v1[0], v1[1]); w.w = cvtpk(v1[2], v1[3]);
                    *(u32x4*)(rowp + bj * 128) = w;
                }
                asm volatile("" ::: "memory");
            }
    }
};
struct EpiResid {
    static constexpr bool PERM = false;
    float* X; bf16_t* XB; float* ssq;
    __device__ __forceinline__ void operator()(AccRef acc, const Unit& u, int wr, int wc, int fr, int fq) const {
        const int row0 = u.pm * 256 + wr * 64 + fr, col0 = u.pn * 256 + wc * 32 + 4 * fq;
#pragma unroll
        for (int ai = 0; ai < 2; ++ai)
#pragma unroll
            for (int m = 0; m < 4; ++m) {
                const int row = row0 + ai * 128 + m * 16; const size_t off = (size_t)row * DM + col0; float s = 0.f;
#pragma unroll
                for (int bj = 0; bj < 2; ++bj)
#pragma unroll
                    for (int n = 0; n < 2; ++n) {
                        const f32x4 xo = *(const f32x4*)(X + off + bj * 128 + n * 16);
                        const f32x4 xn = xo + acc[ai][bj][m][n];
                        *(f32x4*)(X + off + bj * 128 + n * 16) = xn;
                        u32x2 w; w.x = cvtpk(xn[0], xn[1]); w.y = cvtpk(xn[2], xn[3]);
                        *(u32x2*)(XB + off + bj * 128 + n * 16) = w;
                        s += (xn[0] * xn[0] + xn[1] * xn[1]) + (xn[2] * xn[2] + xn[3] * xn[3]);
                    }
                s += __shfl_xor(s, 16); s += __shfl_xor(s, 32);
                if (fq == 0) ssq[(size_t)row * 16 + u.pn * 4 + wc] = s;
            }
    }
};
template <int CTRL> __device__ __forceinline__ float dpp_rot(float v) { return __int_as_float(__builtin_amdgcn_update_dpp(__float_as_int(v), __float_as_int(v), CTRL, 0xf, 0xf, false)); }
struct EpiUp {
    static constexpr bool PERM = true;
    bf16_t* ACT; bf16_t* UB; const float* ssqx; const float* cw; const float* cb;
    __device__ __forceinline__ void operator()(AccRef acc, const Unit& u, int wr, int wc, int fr, int fq) const {
        const int row0 = u.pm * 256 + wr * 64 + fr, gcol = u.pn * 128 + wc * 32 + 8 * fq;
#pragma unroll
        for (int ai = 0; ai < 2; ++ai) {
#pragma unroll
            for (int m = 0; m < 4; ++m) {
                const float rs = rsqrtf(ssq_sum<16>(ssqx + (size_t)(row0 + ai * 128 + m * 16) * 16) * (1.0f / DM) + EPS);
#pragma unroll
                for (int bj = 0; bj < 2; ++bj) { acc[ai][bj][m][0] = acc[ai][bj][m][0] * rs; acc[ai][bj][m][1] = acc[ai][bj][m][1] * rs; }
            }
            asm volatile("" ::: "memory");
            const int chunk = u.pm * 4 + ai * 2 + wr;
#pragma unroll
            for (int e = 0; e < 2; ++e) {
                const int m = e ? 3 : 0;
                const bool mine = e ? (fr >= 14) : (fr <= 1);
                const int slot = e ? (fr - 12) : fr;
                if (mine) {
#pragma unroll
                    for (int bj = 0; bj < 2; ++bj) {
                        const f32x4 v0 = acc[ai][bj][m][0], v1 = acc[ai][bj][m][1];
                        u32x4 w; w.x = cvtpk(v0[0], v0[1]); w.y = cvtpk(v0[2], v0[3]); w.z = cvtpk(v1[0], v1[1]); w.w = cvtpk(v1[2], v1[3]);
                        *(u32x4*)(UB + ((size_t)chunk * 4 + slot) * NUP + bj * DFF + gcol) = w;
                    }
                }
            }
            asm volatile("" ::: "memory");
#pragma unroll
            for (int n = 0; n < 2; ++n) {
                unsigned wpk[4][2]; float rlo[4];
#pragma unroll
                for (int i = 0; i < 4; ++i) {
                    const int cg_ = gcol + 4 * n + i, cv_ = cg_ + DFF;
                    const float g0 = cw[cg_], g1 = cw[NUP + cg_], g2 = cw[2 * NUP + cg_], gb = cb[cg_];
                    const float h0 = cw[cv_], h1 = cw[NUP + cv_], h2 = cw[2 * NUP + cv_], hb = cb[cv_];
                    float gt[4];
                    {
                        float pg[4], ng[4];
#pragma unroll
                        for (int m = 0; m < 4; ++m) { pg[m] = dpp_rot<0x121>(acc[ai][0][m][n][i]); ng[m] = dpp_rot<0x12F>(acc[ai][0][m][n][i]); }
#pragma unroll
                        for (int m = 0; m < 4; ++m) {
                            const float gp = (fr == 0) ? (m ? pg[m - 1] : 0.f) : pg[m], gn = (fr == 15) ? (m < 3 ? ng[m + 1] : 0.f) : ng[m];
                            const float t = g0 * gp + g1 * acc[ai][0][m][n][i] + g2 * gn + gb;
                            gt[m] = t * fast_rcp(1.f + fast_exp2(-LOG2E * t));
                        }
                    }
                    asm volatile("" : "+v"(gt[0]), "+v"(gt[1]), "+v"(gt[2]), "+v"(gt[3]));
                    {
                        float pv[4], nv[4];
#pragma unroll
                        for (int m = 0; m < 4; ++m) { pv[m] = dpp_rot<0x121>(acc[ai][1][m][n][i]); nv[m] = dpp_rot<0x12F>(acc[ai][1][m][n][i]); }
#pragma unroll
                        for (int m = 0; m < 4; ++m) {
                            const float vp = (fr == 0) ? (m ? pv[m - 1] : 0.f) : pv[m], vn = (fr == 15) ? (m < 3 ? nv[m + 1] : 0.f) : nv[m];
                            const float vl = h0 * vp + h1 * acc[ai][1][m][n][i] + h2 * vn + hb;
                            const float rv = gt[m] * vl;
                            if (i & 1) wpk[m][i >> 1] = cvtpk(rlo[m], rv); else rlo[m] = rv;
                        }
                    }
                    asm volatile("" ::: "memory");
                }
#pragma unroll
                for (int m = 0; m < 4; ++m) { u32x2 w; w.x = wpk[m][0]; w.y = wpk[m][1];
                    *(u32x2*)(ACT + (size_t)(row0 + ai * 128 + m * 16) * DFF + gcol + 4 * n) = w; }
                asm volatile("" ::: "memory");
            }
        }
    }
};

constexpr int AT_BUF = 20480, AT_V = 12288, AT_TAB = 2 * AT_BUF;
__device__ __forceinline__ float xmax(float a) { auto rr = __builtin_amdgcn_permlane32_swap(__float_as_uint(a), __float_as_uint(a), false, false); return fmaxf(__uint_as_float(rr[0]), __uint_as_float(rr[1])); }
__device__ __forceinline__ float xsum(float a) { auto rr = __builtin_amdgcn_permlane32_swap(__float_as_uint(a), __float_as_uint(a), false, false); return __uint_as_float(rr[0]) + __uint_as_float(rr[1]); }
typedef short v4i16_t __attribute__((ext_vector_type(4)));
__device__ __forceinline__ s16x4 vtr(const LAS unsigned char* p) { return __builtin_bit_cast(s16x4, __builtin_amdgcn_ds_read_tr16_b64_v4i16((LAS v4i16_t*)p)); }

template <int MODE>
__device__ __forceinline__ void attn_unit(LAS unsigned char* lds, const Params& P, int layer, int b, int h, int qb) {
    constexpr int NMAP = (MODE == 1) ? 2 : 1, ND0 = (MODE == 0) ? 6 : (MODE == 1 ? 2 : 4);
    int tid = threadIdx.x; asm volatile("" : "+v"(tid));
    const int lane = tid & 63, r32 = lane & 31, hi = lane >> 5, wave = __builtin_amdgcn_readfirstlane(tid >> 6);
    const bf16_t* proj = (const bf16_t*)(P.ws + WS_PROJ); const bf16_t* cq = (const bf16_t*)(P.ws + WS_CQ); const bf16_t* ckv = (const bf16_t*)(P.ws + WS_CKV);
    bf16_t* mix = (bf16_t*)(P.ws + WS_MIX);
    const size_t rowbase = (size_t)b * SEQ; const int q0 = qb * 256;
    const bf16_t *Qp, *Kp, *Vp; int qpitch, kpitch, vpitch, ocol; float c;
    if (MODE == 0) { Qp = cq + h * 96; qpitch = NCQ; Kp = ckv + h * 128; kpitch = NCKV; Vp = ckv + h * 128 + 64; vpitch = NCKV; ocol = 512 + h * 64; c = 0.10206207261596577f * LOG2E; }
    else if (MODE == 1) { Qp = proj + h * 64; qpitch = NPROJ; Kp = proj + 256 + h * 64; kpitch = NPROJ; Vp = proj + 512 + h * 64; vpitch = NPROJ; ocol = h * 64; c = 0.17677669529663687f * LOG2E; }
    else { Qp = proj + 768 + h * 64; qpitch = NPROJ; Kp = proj + 1024 + h * 64; kpitch = NPROJ; Vp = proj + 1280 + h * 64; vpitch = NPROJ; ocol = 256 + h * 64; c = 0.125f * LOG2E; }
    int kt0 = 0, kt1 = SEQ / 64;
    if (MODE == 2) { kt0 = (q0 - 1024) / 64; if (kt0 < 0) kt0 = 0; kt1 = (q0 + 256 + 1024) / 64; if (kt1 > SEQ / 64) kt1 = SEQ / 64; }
    LAS float* tab = (LAS float*)(lds + AT_TAB);
    if (MODE != 0) {
        const float slope = (MODE == 1) ? exp2f(-(float)(2 * h + 1)) : exp2f(-(float)(2 * h + 2));
        for (int j = tid; j < 4096; j += 512) {
            const int d = (j > 2047) ? (j - 2047) : (2047 - j);
            float v = -slope * LOG2E * (float)d;
            if (MODE == 2) {
                const int mult = (d <= 64 ? 1 : 0) + (((d & 3) == 0 && d <= 256) ? 1 : 0) + (((d & 15) == 0 && d <= 1024) ? 1 : 0);
                v = (mult == 0) ? -1e30f : (mult == 1 ? v : (mult == 2 ? v + 1.0f : v + 1.5849625007211562f));
            }
            tab[j] = v;
        }
    }
    const int qpos = q0 + wave * 32 + r32;
    bf16x8 qf[NMAP][ND0];
    {
        const bf16_t* qrow = Qp + (rowbase + qpos) * qpitch + hi * 8;
#pragma unroll
        for (int mp = 0; mp < NMAP; ++mp)
#pragma unroll
            for (int d0 = 0; d0 < ND0; ++d0) qf[mp][d0] = *(const bf16x8*)(qrow + mp * 32 + d0 * 16);
    }
    u32x4 kreg, kreg2 = (u32x4){0u, 0u, 0u, 0u}, vreg;
#define AT_GLOAD(kt) do { const size_t r_ = rowbase + (size_t)(kt) * 64; \
        kreg = *(const u32x4*)(Kp + (r_ + lane) * kpitch + wave * 8); \
        if (MODE == 0 && wave < 4) kreg2 = *(const u32x4*)(proj + (r_ + lane) * NPROJ + 1920 + wave * 8); \
        vreg = *(const u32x4*)(Vp + (r_ + 16 * (wave & 3) + (lane >> 2)) * vpitch + (wave >> 2) * 32 + (lane & 3) * 8); } while (0)
#define AT_LSTORE(buf) do { LAS unsigned char* d_ = lds + (buf) * AT_BUF; \
        *(LAS u32x4*)(d_ + wave * 1024 + lane * 16) = kreg; \
        if (MODE == 0 && wave < 4) *(LAS u32x4*)(d_ + (8 + wave) * 1024 + lane * 16) = kreg2; \
        *(LAS u32x4*)(d_ + AT_V + wave * 1024 + lane * 16) = vreg; } while (0)
    float mrun[NMAP], lrun[NMAP]; f32x16 o[NMAP][2];
#pragma unroll
    for (int mp = 0; mp < NMAP; ++mp) { mrun[mp] = -1e20f; lrun[mp] = 0.f; o[mp][0] = f32x16{}; o[mp][1] = f32x16{}; }
    AT_GLOAD(kt0); AT_LSTORE(0);
    __syncthreads();
    const int vlane = ((lane >> 4) & 1) * 32 + (lane & 3) * 8 + (4 * hi + ((lane & 15) >> 2)) * 64;
    for (int kt = kt0; kt < kt1; ++kt) {
        const int buf = (kt - kt0) & 1;
        if (kt + 1 < kt1) AT_GLOAD(kt + 1);
        const LAS unsigned char* kb = lds + buf * AT_BUF;
        const LAS unsigned char* vb = kb + AT_V + vlane;
#pragma unroll
        for (int hf = 0; hf < 2; ++hf) {
            bf16x8 pw[NMAP][2];
#pragma unroll
            for (int mp = 0; mp < NMAP; ++mp) {
                f32x16 s0 = f32x16{};
#pragma unroll
                for (int d0 = 0; d0 < ND0; ++d0) {
                    const int ch = (mp * ND0 + d0) * 2;
                    const bf16x8 ka0 = *(const LAS bf16x8*)(kb + (ch + hi) * 1024 + hf * 512 + r32 * 16);
                    s0 = __builtin_amdgcn_mfma_f32_32x32x16_bf16(ka0, qf[mp][d0], s0, 0, 0, 0);
                }
                float rm = -3e38f;
                if (MODE != 0) {
                    if (mp) asm volatile("" ::: "memory");
                    const LAS float* tp = tab + (kt * 64 + hf * 32 + 4 * hi - qpos + 2047);
#pragma unroll
                    for (int r = 0; r < 16; ++r) { s0[r] = s0[r] * c + tp[(r & 3) + 8 * (r >> 2)]; rm = fmaxf(rm, s0[r]); }
                } else {
#pragma unroll
                    for (int r = 0; r < 16; ++r) { s0[r] *= c; rm = fmaxf(rm, s0[r]); }
                }
                rm = xmax(rm);
                const float mn = fmaxf(mrun[mp], rm);
                if (__any(mn > mrun[mp])) {
                    const float al = fast_exp2(mrun[mp] - mn); lrun[mp] *= al;
#pragma unroll
                    for (int r = 0; r < 16; ++r) { o[mp][0][r] *= al; o[mp][1][r] *= al; }
                    mrun[mp] = mn;
                }
                float ls = 0.f;
#pragma unroll
                for (int r = 0; r < 16; ++r) { s0[r] = fast_exp2(s0[r] - mn); ls += s0[r]; }
                lrun[mp] += ls;
                u32x4 w;
                w.x = cvtpk(s0[0], s0[1]); w.y = cvtpk(s0[2], s0[3]); w.z = cvtpk(s0[4], s0[5]); w.w = cvtpk(s0[6], s0[7]); pw[mp][0] = __builtin_bit_cast(bf16x8, w);
                w.x = cvtpk(s0[8], s0[9]); w.y = cvtpk(s0[10], s0[11]); w.z = cvtpk(s0[12], s0[13]); w.w = cvtpk(s0[14], s0[15]); pw[mp][1] = __builtin_bit_cast(bf16x8, w);
            }
#pragma unroll
            for (int dv = 0; dv < 2; ++dv)
#pragma unroll
                for (int k2 = 0; k2 < 2; ++k2) {
                    const int ks = 2 * hf + k2;
                    const s16x4 lo = vtr(vb + dv * 4096 + ks * 1024), hh = vtr(vb + dv * 4096 + ks * 1024 + 512);
                    const bf16x8 vf = (bf16x8){lo[0], lo[1], lo[2], lo[3], hh[0], hh[1], hh[2], hh[3]};
#pragma unroll
                    for (int mp = 0; mp < NMAP; ++mp) o[mp][dv] = __builtin_amdgcn_mfma_f32_32x32x16_bf16(vf, pw[mp][k2], o[mp][dv], 0, 0, 0);
                }
        }
        if (kt + 1 < kt1) AT_LSTORE(buf ^ 1);
        __syncthreads();
    }
#undef AT_GLOAD
#undef AT_LSTORE
    bf16_t* orow = mix + (rowbase + qpos) * DM + ocol + 4 * hi;
    if (MODE != 1) {
        const float inv = 1.f / xsum(lrun[0]);
#pragma unroll
        for (int d = 0; d < 2; ++d)
#pragma unroll
            for (int g = 0; g < 4; ++g) {
                u32x2 w; w.x = cvtpk(o[0][d][4 * g] * inv, o[0][d][4 * g + 1] * inv); w.y = cvtpk(o[0][d][4 * g + 2] * inv, o[0][d][4 * g + 3] * inv);
                *(u32x2*)(orow + 32 * d + 8 * g) = w;
            }
    } else {
        const float lam = __hip_atomic_load((const float*)(P.ws + WS_LAM) + layer, __ATOMIC_RELAXED, __HIP_MEMORY_SCOPE_AGENT);
        const float lam_init = 0.8f - 0.6f * expf(-0.3f * (float)layer);
        const float i1 = 1.f / xsum(lrun[0]), i2 = lam / xsum(lrun[NMAP - 1]);
        float ss = 0.f;
#pragma unroll
        for (int d = 0; d < 2; ++d)
#pragma unroll
            for (int r = 0; r < 16; ++r) { const float v = o[0][d][r] * i1 - o[NMAP - 1][d][r] * i2; o[0][d][r] = v; ss += v * v; }
        ss = xsum(ss);
        const float sc = rsqrtf(ss * (1.0f / 64.0f) + EPS) * (1.f - lam_init);
        const float* gn = P.a_subln + layer * 64 + 4 * hi;
#pragma unroll
        for (int d = 0; d < 2; ++d)
#pragma unroll
            for (int g = 0; g < 4; ++g) {
                const f32x4 gv = *(const f32x4*)(gn + 32 * d + 8 * g);
                u32x2 w; w.x = cvtpk(o[0][d][4 * g] * sc * gv[0], o[0][d][4 * g + 1] * sc * gv[1]); w.y = cvtpk(o[0][d][4 * g + 2] * sc * gv[2], o[0][d][4 * g + 3] * sc * gv[3]);
                *(u32x2*)(orow + 32 * d + 8 * g) = w;
            }
    }
}

__device__ __forceinline__ void transpose_item(const float* W, int K, int Nsrc, const float* g, bf16_t* WT, int n0_dst, int n0_src, int k0, LAS float* scr, int lane) {
#pragma unroll 8
    for (int i = 0; i < 32; ++i) { const int kk = 2 * i + (lane >> 5);
        float v = 0.f; if (n0_src >= 0) { v = W[(size_t)(k0 + kk) * Nsrc + n0_src + (lane & 31)]; if (g) v *= g[k0 + kk]; }
        scr[kk * 33 + (lane & 31)] = v; }
    asm volatile("s_waitcnt lgkmcnt(0)" ::: "memory");
    const int c = lane & 7;
#pragma unroll
    for (int j = 0; j < 4; ++j) { const int n = (lane >> 3) + 8 * j; const LAS float* s = scr + (8 * c) * 33 + n;
        u32x4 o; o.x = cvtpk(s[0 * 33], s[1 * 33]); o.y = cvtpk(s[2 * 33], s[3 * 33]); o.z = cvtpk(s[4 * 33], s[5 * 33]); o.w = cvtpk(s[6 * 33], s[7 * 33]);
        *(u32x4*)(WT + (size_t)(n0_dst + n) * K + k0 + 8 * c) = o; }
    asm volatile("s_waitcnt lgkmcnt(0)" ::: "memory");
}

__device__ __forceinline__ void zero_f32(float* p, int n) { for (int i = blockIdx.x * 512 + threadIdx.x; i < n; i += gridDim.x * 512) p[i] = 0.f; }

__device__ __forceinline__ void prologue(const Params& P, LAS unsigned char* lds) {
    const int tid = threadIdx.x, lane = tid & 63, wave = tid >> 6;
    const int gw = blockIdx.x * 8 + wave, NGW = gridDim.x * 8;
    LAS float* scr = (LAS float*)(lds + wave * 16384);
    constexpr int I_IN = 16 * 64, I_OUT = 16 * 32, I_UP = 16 * 176, I_DN = 44 * 32, I_UQ = 4 * 24, I_UKV = 2 * 32, I_L = I_IN + I_OUT + I_UP + I_DN + I_UQ + I_UKV;
    for (int it = gw; it < I_L * DEPTH; it += NGW) {
        const int l = it / I_L; int r = it % I_L;
        unsigned char* wl = P.ws + WS_W + (size_t)l * W_LAYER;
        if (r < I_IN) { const int kb = r / 64, nb = r % 64; transpose_item(P.w_in + (size_t)l * DM * NIN, DM, NIN, P.g_attn + l * DM, (bf16_t*)(wl + W_IN), nb * 32, nb < 61 ? nb * 32 : -1, kb * 64, scr, lane); continue; } r -= I_IN;
        if (r < I_OUT) { const int kb = r / 32, nb = r % 32; transpose_item(P.w_out + (size_t)l * DM * DM, DM, DM, nullptr, (bf16_t*)(wl + W_OUT), nb * 32, nb * 32, kb * 64, scr, lane); continue; } r -= I_OUT;
        if (r < I_UP) { const int kb = r / 176, nb = r % 176; const int nd = nb * 32, pn = nd >> 8, wi = nd & 255, src = (wi >> 7) * DFF + pn * 128 + (wi & 127);
            transpose_item(P.w_up + (size_t)l * DM * NUP, DM, NUP, P.g_ffn + l * DM, (bf16_t*)(wl + W_UP), nd, src, kb * 64, scr, lane); continue; } r -= I_UP;
        if (r < I_DN) { const int kb = r / 32, nb = r % 32; transpose_item(P.w_down + (size_t)l * DFF * DM, DFF, DM, nullptr, (bf16_t*)(wl + W_DOWN), nb * 32, nb * 32, kb * 64, scr, lane); continue; } r -= I_DN;
        if (r < I_UQ) { const int kb = r / 24, nb = r % 24; transpose_item(P.c_w_uq + (size_t)l * 256 * NCQ, 256, NCQ, P.c_g_q + l * 256, (bf16_t*)(wl + W_UQ), nb * 32, nb * 32, kb * 64, scr, lane); continue; } r -= I_UQ;
        { const int kb = r / 32, nb = r % 32; transpose_item(P.c_w_ukv + (size_t)l * 128 * NCKV, 128, NCKV, P.c_g_kv + l * 128, (bf16_t*)(wl + W_UKV), nb * 32, nb * 32, kb * 64, scr, lane); }
    }
    float* ssqA = (float*)(P.ws + WS_SSQA); bf16_t* xb = (bf16_t*)(P.ws + WS_XB);
    for (int m = gw; m < T_TOK; m += NGW) {
        const f32x4* xr = (const f32x4*)(P.x + (size_t)m * DM) + lane; f32x4* orow = (f32x4*)(P.out + (size_t)m * DM) + lane; u32x2* brow = (u32x2*)(xb + (size_t)m * DM) + lane;
        float s = 0.f;
#pragma unroll
        for (int j = 0; j < 4; ++j) { const f32x4 v = xr[64 * j]; orow[64 * j] = v; u32x2 w; w.x = cvtpk(v[0], v[1]); w.y = cvtpk(v[2], v[3]); brow[64 * j] = w; s += (v[0] * v[0] + v[1] * v[1]) + (v[2] * v[2] + v[3] * v[3]); }
        s = wave_sum(s);
        if (lane < 16) ssqA[(size_t)m * 16 + lane] = lane ? 0.f : s;
    }
    float* cost = (float*)(P.ws + WS_COS); float* sint = (float*)(P.ws + WS_SIN);
    for (int i = blockIdx.x * 512 + tid; i < SEQ * 16; i += gridDim.x * 512) {
        const int pos = i >> 4, j = i & 15; const float inv = exp2f(-(float)j * (13.287712379549449f / 16.0f)); const float ang = (float)pos * inv;
        cost[i] = cosf(ang); sint[i] = sinf(ang);
    }
    if (blockIdx.x == 0 && tid < DEPTH) {
        float d1 = 0.f, d2 = 0.f;
        for (int j = 0; j < 32; ++j) { d1 += P.a_lq1[tid * 32 + j] * P.a_lk1[tid * 32 + j]; d2 += P.a_lq2[tid * 32 + j] * P.a_lk2[tid * 32 + j]; }
        ((float*)(P.ws + WS_LAM))[tid] = expf(d1) - expf(d2) + (0.8f - 0.6f * expf(-0.3f * (float)tid));
    }
}

__device__ __forceinline__ void ffn_fixup(const Params& P, int layer) {
    const bf16_t* UB = (const bf16_t*)(P.ws + WS_UBND); bf16_t* ACT = (bf16_t*)(P.ws + WS_ACT);
    const float* cw = P.conv_w + (size_t)layer * 3 * NUP; const float* cb = P.conv_b + (size_t)layer * NUP;
    constexpr int CG = DFF / 8;
    for (int it = blockIdx.x * 512 + threadIdx.x; it < 512 * 2 * CG; it += gridDim.x * 512) {
        const int cgi = it % CG, e = (it / CG) & 1, chunk = it / (2 * CG), col = cgi * 8;
        const bf16_t *up, *mid, *dn; bool zu = false, zd = false;
        if (e == 0) { zu = (chunk % 32) == 0; up = UB + ((size_t)(zu ? chunk : chunk - 1) * 4 + 3) * NUP; mid = UB + ((size_t)chunk * 4 + 0) * NUP; dn = UB + ((size_t)chunk * 4 + 1) * NUP; }
        else { zd = (chunk % 32) == 31; up = UB + ((size_t)chunk * 4 + 2) * NUP; mid = UB + ((size_t)chunk * 4 + 3) * NUP; dn = UB + ((size_t)(zd ? chunk : chunk + 1) * 4 + 0) * NUP; }
        const float fu = zu ? 0.f : 1.f, fd = zd ? 0.f : 1.f;
        float res[8];
        bf16_t ug[8], mg[8], dg[8], uv[8], mv[8], dv[8];
        *(u32x4*)ug = *(const u32x4*)(up + col); *(u32x4*)mg = *(const u32x4*)(mid + col); *(u32x4*)dg = *(const u32x4*)(dn + col);
        *(u32x4*)uv = *(const u32x4*)(up + DFF + col); *(u32x4*)mv = *(const u32x4*)(mid + DFF + col); *(u32x4*)dv = *(const u32x4*)(dn + DFF + col);
#pragma unroll
        for (int k = 0; k < 8; ++k) {
            const int cg_ = col + k, cv_ = DFF + col + k;
            const float gt = cw[cg_] * bf2f(ug[k]) * fu + cw[NUP + cg_] * bf2f(mg[k]) + cw[2 * NUP + cg_] * bf2f(dg[k]) * fd + cb[cg_];
            const float vl = cw[cv_] * bf2f(uv[k]) * fu + cw[NUP + cv_] * bf2f(mv[k]) + cw[2 * NUP + cv_] * bf2f(dv[k]) * fd + cb[cv_];
            res[k] = gt * fast_rcp(1.f + fast_exp2(-LOG2E * gt)) * vl;
        }
        u32x4 w; w.x = cvtpk(res[0], res[1]); w.y = cvtpk(res[2], res[3]); w.z = cvtpk(res[4], res[5]); w.w = cvtpk(res[6], res[7]);
        *(u32x4*)(ACT + (size_t)(chunk * 64 + (e ? 63 : 0)) * DFF + col) = w;
    }
}

__global__ void __launch_bounds__(512, 2) fwd_megakernel(Params P) {
    extern __shared__ __attribute__((aligned(16))) unsigned char lds_raw[];
    LAS unsigned char* lds = (LAS unsigned char*)lds_raw;
    cg::grid_group grid = cg::this_grid();
#define GRID_SYNC() do { asm volatile("s_waitcnt vmcnt(0) lgkmcnt(0)" ::: "memory"); __syncthreads(); grid.sync(); \
        __builtin_amdgcn_fence(__ATOMIC_ACQUIRE, "agent"); asm volatile("s_waitcnt vmcnt(0)" ::: "memory"); } while (0)
    unsigned char* ws = P.ws;
    float* ssqA = (float*)(ws + WS_SSQA); float* ssqB = (float*)(ws + WS_SSQB); float* ssqQ = (float*)(ws + WS_SSQQ); float* ssqKV = (float*)(ws + WS_SSQKV);
    const float* cost = (const float*)(ws + WS_COS); const float* sint = (const float*)(ws + WS_SIN);
    bf16_t* xb = (bf16_t*)(ws + WS_XB); bf16_t* proj = (bf16_t*)(ws + WS_PROJ); bf16_t* cq = (bf16_t*)(ws + WS_CQ); bf16_t* ckv = (bf16_t*)(ws + WS_CKV);
    bf16_t* mix = (bf16_t*)(ws + WS_MIX); bf16_t* act = (bf16_t*)(ws + WS_ACT); bf16_t* ubnd = (bf16_t*)(ws + WS_UBND);

    prologue(P, lds);
    GRID_SYNC();
    for (int l = 0; l < DEPTH; ++l) {
        const unsigned char* wl = ws + WS_W + (size_t)l * W_LAYER;
#if !(MK_SKIP & 1)
        { pg8::Gemm g{xb, (const bf16_t*)(wl + W_IN), T_TOK, NPROJ, DM, DM}; EpiProj E{proj, ssqA, ssqQ, ssqKV, cost, sint}; pg8::gemm_phase(lds, g, E); }
#endif
        GRID_SYNC();
#if !(MK_SKIP & 2)
        { pg8::Gemm g{proj + 1536, (const bf16_t*)(wl + W_UQ), T_TOK, NCQ, 256, NPROJ}; EpiMla<true, 8> E{cq, NCQ, ssqQ, 1.0f / 256.0f, cost, sint}; pg8::gemm_phase(lds, g, E); }
        { pg8::Gemm g{proj + 1792, (const bf16_t*)(wl + W_UKV), T_TOK, NCKV, 128, NPROJ}; EpiMla<false, 4> E{ckv, NCKV, ssqKV, 1.0f / 128.0f, cost, sint}; pg8::gemm_phase(lds, g, E); }
#endif
#if !(MK_SKIP & 4)
        for (int u = blockIdx.x; u < 1024; u += gridDim.x) {
            if (u < 512) { attn_unit<1>(lds, P, l, u >> 5, (u >> 3) & 3, u & 7); }
            else { const int v = u - 512; int qb = v & 7; if (v >= 256) qb = (qb + 4) & 7; attn_unit<2>(lds, P, l, (v >> 5) & 15, (v >> 3) & 3, qb); }
        }
#endif
        GRID_SYNC();
#if !(MK_SKIP & 8)
        for (int u = blockIdx.x; u < 1024; u += gridDim.x) attn_unit<0>(lds, P, l, u >> 6, (u >> 3) & 7, u & 7);
#endif
        GRID_SYNC();
#if !(MK_SKIP & 16)
        { pg8::Gemm g{mix, (const bf16_t*)(wl + W_OUT), T_TOK, DM, DM, DM}; EpiResid E{P.out, xb, ssqB}; pg8::gemm_phase(lds, g, E); }
#endif
        GRID_SYNC();
#if !(MK_SKIP & 32)
        { pg8::Gemm g{xb, (const bf16_t*)(wl + W_UP), T_TOK, NUP, DM, DM}; EpiUp E{act, ubnd, ssqB, P.conv_w + (size_t)l * 3 * NUP, P.conv_b + (size_t)l * NUP}; pg8::gemm_phase(lds, g, E); }
#endif
        GRID_SYNC();
        ffn_fixup(P, l);
        GRID_SYNC();
#if !(MK_SKIP & 64)
        { pg8::Gemm g{act, (const bf16_t*)(wl + W_DOWN), T_TOK, DM, DFF, DFF}; EpiResid E{P.out, xb, ssqA}; pg8::gemm_phase(lds, g, E); }
#endif
        GRID_SYNC();
    }
    for (int i = blockIdx.x * 512 + threadIdx.x; i < T_TOK * (DM / 4); i += gridDim.x * 512) {
        const int row = i >> 8, c4 = i & 255;
        const float rs = rsqrtf(ssq_sum<16>(ssqA + (size_t)row * 16) * (1.0f / DM) + EPS);
        f32x4 v = ((f32x4*)P.out)[i]; const f32x4 gv = ((const f32x4*)P.g_final)[c4];
        v = v * rs * gv; ((f32x4*)P.out)[i] = v;
    }
}

extern "C" void kernel_launch(void* const* d_in, const int* in_sizes, int n_in, void* d_out, int out_size, void* d_ws, size_t ws_size, hipStream_t stream) {
    static int grid_blocks = 0;
    if (!grid_blocks) {
        if (n_in != 19 || ws_size < WS_END) { fprintf(stderr, "kernel_launch: unexpected n_in %d / ws %zu\n", n_in, ws_size); grid_blocks = -1; return; }
        int dev = 0, cus = 0, per_cu = 0;
        hipGetDevice(&dev);
        hipDeviceGetAttribute(&cus, hipDeviceAttributeMultiprocessorCount, dev);
        hipFuncSetAttribute((const void*)fwd_megakernel, hipFuncAttributeMaxDynamicSharedMemorySize, LDS_BYTES);
        hipOccupancyMaxActiveBlocksPerMultiprocessor(&per_cu, (const void*)fwd_megakernel, 512, LDS_BYTES);
        if (per_cu < 1) { fprintf(stderr, "kernel_launch: occupancy query says %d blocks/CU\n", per_cu); per_cu = 1; }
        grid_blocks = cus * per_cu;
    }
    if (grid_blocks < 0) return;
    Params p{};
    const float** f = (const float**)&p;
    for (int i = 0; i < 19; ++i) f[i] = (const float*)d_in[i];
    p.out = (float*)d_out; p.ws = (unsigned char*)d_ws;
    void* args[] = {&p};
    hipError_t e = hipLaunchCooperativeKernel((const void*)fwd_megakernel, dim3(grid_blocks), dim3(512), args, LDS_BYTES, stream);
    if (e != hipSuccess) fprintf(stderr, "cooperative launch failed: %s (grid %d)\n", hipGetErrorString(e), grid_blocks);
}
```

```cpp
#include <hip/hip_runtime.h>
#include <hip/hip_cooperative_groups.h>
#include <cstdint>
#include <cstdio>
namespace cg = cooperative_groups;

#define LAS __attribute__((address_space(3)))
typedef unsigned short bf16_t;
typedef short bf16x8 __attribute__((ext_vector_type(8)));
typedef short s16x4 __attribute__((ext_vector_type(4)));
typedef float f32x4 __attribute__((ext_vector_type(4)));
typedef float f32x2 __attribute__((ext_vector_type(2)));
typedef float f32x16 __attribute__((ext_vector_type(16)));
typedef unsigned u32x4 __attribute__((ext_vector_type(4)));
typedef unsigned u32x2 __attribute__((ext_vector_type(2)));
typedef __bf16 bf16x2_t __attribute__((ext_vector_type(2)));

constexpr int T_TOK = 32768, SEQ = 2048, DM = 1024, DEPTH = 4;
constexpr int NPROJ = 2048, NIN = 1952, DFF = 2816, NUP = 5632;
constexpr int NCQ = 768, NCKV = 1024;
constexpr float EPS = 1e-6f;
constexpr float LOG2E = 1.4426950408889634f;

constexpr size_t MiB = 1u << 20;
constexpr size_t WS_BAR = 0, WS_BAR_BYTES = 16384;
constexpr size_t WS_LAM = 512 * 1024;
constexpr size_t WS_COS = 576 * 1024, WS_SIN = 704 * 1024;
constexpr size_t WS_W = 1 * MiB;
constexpr size_t W_IN = 0, W_OUT = W_IN + (size_t)NPROJ * DM * 2, W_UP = W_OUT + (size_t)DM * DM * 2, W_DOWN = W_UP + (size_t)NUP * DM * 2,
                 W_UQ = W_DOWN + (size_t)DM * DFF * 2, W_UKV = W_UQ + (size_t)NCQ * 256 * 2, W_LAYER = W_UKV + (size_t)NCKV * 128 * 2;
static_assert(W_LAYER * DEPTH <= 93 * MiB, "weights");
constexpr size_t WS_XB = 94 * MiB, WS_PROJ = 158 * MiB, WS_CQ = 286 * MiB, WS_CKV = 334 * MiB, WS_MIX = 398 * MiB;
constexpr size_t WS_SSQA = 462 * MiB, WS_SSQB = 464 * MiB, WS_SSQQ = 466 * MiB, WS_SSQKV = 467 * MiB, WS_END = 468 * MiB;
constexpr size_t WS_ACT = 158 * MiB, WS_UBND = 334 * MiB;
static_assert(WS_ACT + (size_t)T_TOK * DFF * 2 <= WS_UBND && WS_UBND + (size_t)512 * 4 * NUP * 2 <= WS_MIX, "overlay");

constexpr int LDS_BYTES = 147456;
#ifndef MK_SKIP
#define MK_SKIP 0
#endif
#ifndef MK_DUP_PRO
#define MK_DUP_PRO 1
#endif
#ifndef MK_DUP_SYNC
#define MK_DUP_SYNC 1
#endif
#ifndef MK_DUP_UP
#define MK_DUP_UP 1
#endif
#ifndef MK_DUP_IN
#define MK_DUP_IN 1
#endif
#ifndef MK_DUP_AB
#define MK_DUP_AB 1
#endif
#ifndef MK_DUP_C
#define MK_DUP_C 1
#endif

struct Params {
    const float* x; const float* w_in; const float* g_attn; const float* a_lq1; const float* a_lk1; const float* a_lq2; const float* a_lk2;
    const float* a_subln; const float* c_g_q; const float* c_w_uq; const float* c_g_kv; const float* c_w_ukv; const float* w_out; const float* g_ffn;
    const float* w_up; const float* conv_w; const float* conv_b; const float* w_down; const float* g_final;
    float* out; unsigned char* ws;
};

__device__ __forceinline__ unsigned cvtpk(float lo, float hi) { f32x2 v = {lo, hi}; bf16x2_t b = __builtin_convertvector(v, bf16x2_t); return __builtin_bit_cast(unsigned, b); }
__device__ __forceinline__ float bf2f(unsigned short b) { return __uint_as_float((unsigned)b << 16); }
__device__ __forceinline__ float wave_sum(float v) {
#pragma unroll
    for (int o = 1; o < 64; o <<= 1) v += __shfl_xor(v, o);
    return v;
}
__device__ __forceinline__ float ld_agent(const float* p) { return __hip_atomic_load(p, __ATOMIC_RELAXED, __HIP_MEMORY_SCOPE_AGENT); }
template <int NS> __device__ __forceinline__ float ssq_sum(const float* p) {
    float t = 0.f;
#pragma unroll
    for (int i = 0; i < NS / 4; ++i) { const f32x4 v = *(const f32x4*)(p + 4 * i); t += (v[0] + v[1]) + (v[2] + v[3]); }
    return t;
}
__device__ __forceinline__ float fast_exp2(float x) { return __builtin_amdgcn_exp2f(x); }
__device__ __forceinline__ float fast_rcp(float x) { return __builtin_amdgcn_rcpf(x); }

namespace pg8 {
constexpr int BM = 256, BK = 64, HALF = 128, HTB = HALF * BK * 2, STAGE_BYTES = 8 * HTB, NXCD = 8, WGM = 8;
__host__ __device__ __forceinline__ int lds_byte(int r, int c) { const int st = (r >> 4) * 2 + (c >> 5), rr = r & 15, cc = c & 31, ob = rr * 64 + cc * 2; return st * 1024 + (ob ^ (((ob >> 9) & 1) << 5)); }
__host__ __device__ __forceinline__ void stage_rc(int b, int& R, int& C) { const int st = b / 1024, sb = b % 1024, swz = sb ^ (((sb >> 9) & 1) << 5); R = (st >> 1) * 16 + swz / 64; C = (st & 1) * 32 + (swz % 64) / 2; }
__host__ __device__ __forceinline__ int perm32(int rho) { const int n = rho >> 4, i = rho & 15; return 8 * (i >> 2) + 4 * n + (i & 3); }
struct Unit { int pm, pn; };
struct Gemm { const bf16_t* A; const bf16_t* Bt; int M, N, K, lda; };
struct StaticOrder {
    int nM, nN, nwg, G, c;
    __device__ void init(int M, int N, int G_, int c_) { nM = M / BM; nN = N / BM; nwg = nM * nN; G = G_; c = c_; }
    __device__ bool next(int i, Unit& u) const {
        const long L = (long)i * G + c; if (L >= nwg) return false;
        int wgid = (int)L; { const int q = nwg / NXCD, r = nwg % NXCD, xcd = wgid % NXCD, off = wgid / NXCD; wgid = (xcd < r ? xcd * (q + 1) : r * (q + 1) + (xcd - r) * q) + off; }
        const int nig = WGM * nN, gid = wgid / nig, fm = gid * WGM, gsz = (nM - fm) < WGM ? (nM - fm) : WGM;
        u.pm = fm + ((wgid % nig) % gsz); u.pn = (wgid % nig) / gsz; return true;
    }
};

template <class Epi>
__device__ __forceinline__ void gemm_phase(LAS unsigned char* lds, const Gemm g, const Epi& E) {
    int tid = threadIdx.x; asm volatile("" : "+v"(tid));
    const int wid = __builtin_amdgcn_readfirstlane(tid >> 6), lane = tid & 63, wr = wid >> 2, wc = wid & 3, fr = lane & 15, fq = lane >> 4;
    int K = g.K, lda = g.lda; asm volatile("" : "+s"(K), "+s"(lda));
    const int nt = K / BK;
    StaticOrder S; S.init(g.M, g.N, (int)gridDim.x, (int)blockIdx.x);
    unsigned voffA[2], voffB[2];
#pragma unroll
    for (int i = 0; i < 2; ++i) { int R, C; stage_rc(tid * 16 + i * 8192, R, C); const int Rb = Epi::PERM ? ((R & ~31) + perm32(R & 31)) : R;
        voffA[i] = (unsigned)(R * lda + C) * 2u; voffB[i] = (unsigned)(Rb * K + C) * 2u; }
    const size_t kstep = (size_t)(BK * 2);
    const size_t hstepA = (size_t)HALF * lda * 2, hstepB = (size_t)HALF * K * 2;
    const size_t tstepA = 2 * hstepA, tstepB = 2 * hstepB;
    const unsigned ldsw = (unsigned)wid * 1024u;
    const int aoff = lds_byte(wr * 64 + fr, fq * 8), boff = lds_byte(wc * 32 + fr, fq * 8);
#define PG8_SA(b, h) (((b) * 2 + (h)) * HTB)
#define PG8_SB(b, h) ((4 + (b) * 2 + (h)) * HTB)
#define PG8_STAGE(bufoff, gbase, voff) do { _Pragma("unroll") for (int _i = 0; _i < 2; ++_i) \
        __builtin_amdgcn_global_load_lds((const unsigned*)((const char*)(gbase) + (voff)[_i]), (LAS unsigned*)(lds + (bufoff) + ldsw + _i * 8192), 16, 0, 0); } while (0)
#define PG8_LDA(dst, b, h) do { _Pragma("unroll") for (int m = 0; m < 4; ++m) _Pragma("unroll") for (int k = 0; k < 2; ++k) dst[m][k] = *(const LAS bf16x8*)(lds + PG8_SA(b, h) + aoff + m * 2048 + k * 1024); } while (0)
#define PG8_LDB(dst, b, h) do { _Pragma("unroll") for (int n = 0; n < 2; ++n) _Pragma("unroll") for (int k = 0; k < 2; ++k) dst[n][k] = *(const LAS bf16x8*)(lds + PG8_SB(b, h) + boff + n * 2048 + k * 1024); } while (0)
#define PG8_MMA(ai, bj, At, Bt) do { __builtin_amdgcn_s_setprio(1); _Pragma("unroll") for (int m = 0; m < 4; ++m) _Pragma("unroll") for (int n = 0; n < 2; ++n) _Pragma("unroll") for (int k = 0; k < 2; ++k) \
        acc[ai][bj][m][n] = __builtin_amdgcn_mfma_f32_16x16x32_bf16(Bt[n][k], At[m][k], acc[ai][bj][m][n], 0, 0, 0); __builtin_amdgcn_s_setprio(0); } while (0)
#define PG8_WAIT_V(n) asm volatile("s_waitcnt vmcnt(" #n ")" ::: "memory")
#define PG8_WAIT_L(n) asm volatile("s_waitcnt lgkmcnt(" #n ")" ::: "memory")
#define PG8_BAR __builtin_amdgcn_s_barrier()
#define PG8_SCHED __builtin_amdgcn_sched_barrier(0)
    Unit cur, nxt; int ui = 0;
    if (!S.next(0, cur)) return;
    f32x4 acc[2][2][4][2];
#pragma unroll
    for (int a = 0; a < 2; ++a)
#pragma unroll
        for (int b = 0; b < 2; ++b)
#pragma unroll
            for (int m = 0; m < 4; ++m)
#pragma unroll
                for (int n = 0; n < 2; ++n) acc[a][b][m][n] = (f32x4){0.f, 0.f, 0.f, 0.f};
    bf16x8 At[4][2], B0[2][2], B1[2][2];
    const char* cA = (const char*)g.A + (size_t)cur.pm * tstepA; const char* cB = (const char*)g.Bt + (size_t)cur.pn * tstepB;
    PG8_STAGE(PG8_SB(0, 0), cB, voffB); PG8_STAGE(PG8_SB(0, 1), cB + hstepB, voffB); PG8_STAGE(PG8_SA(0, 0), cA, voffA); PG8_STAGE(PG8_SA(0, 1), cA + hstepA, voffA);
    if (wr == 1) PG8_BAR;
    PG8_WAIT_V(2); PG8_BAR;
    PG8_STAGE(PG8_SB(1, 0), cB + kstep, voffB); PG8_STAGE(PG8_SA(1, 0), cA + kstep, voffA); PG8_STAGE(PG8_SB(1, 1), cB + hstepB + kstep, voffB);
    PG8_WAIT_V(6); PG8_BAR;
    for (;;) {
        const bool has_next = S.next(ui + 1, nxt);
        const char* nA = has_next ? (const char*)g.A + (size_t)nxt.pm * tstepA : cA; const char* nB = has_next ? (const char*)g.Bt + (size_t)nxt.pn * tstepB : cB;
        for (int t = 0; t < nt; t += 2) {
            const bool last = (t == nt - 2);
            const char* a1 = cA + (size_t)(t + 1) * kstep;
            const char* a2 = last ? nA : cA + (size_t)(t + 2) * kstep; const char* b2 = last ? nB : cB + (size_t)(t + 2) * kstep;
            const char* a3 = a2 + kstep; const char* b3 = b2 + kstep;
            PG8_LDB(B0, 0, 0); PG8_LDB(B1, 0, 1); PG8_SCHED; PG8_LDA(At, 0, 0); PG8_STAGE(PG8_SA(1, 1), a1 + hstepA, voffA);
            PG8_WAIT_V(8); PG8_WAIT_L(0); PG8_BAR; PG8_MMA(0, 0, At, B0); PG8_MMA(0, 1, At, B1); PG8_BAR; PG8_SCHED;
            PG8_LDA(At, 0, 1); PG8_STAGE(PG8_SB(0, 0), b2, voffB); PG8_STAGE(PG8_SB(0, 1), b2 + hstepB, voffB); PG8_STAGE(PG8_SA(0, 0), a2, voffA);
            PG8_WAIT_V(8); PG8_WAIT_L(0); PG8_BAR; PG8_MMA(1, 0, At, B0); PG8_MMA(1, 1, At, B1); PG8_BAR; PG8_SCHED;
            PG8_LDB(B0, 1, 0); PG8_LDB(B1, 1, 1); PG8_SCHED; PG8_LDA(At, 1, 0); PG8_STAGE(PG8_SA(0, 1), a2 + hstepA, voffA);
            PG8_WAIT_V(8); PG8_WAIT_L(0); PG8_BAR; PG8_MMA(0, 0, At, B0); PG8_MMA(0, 1, At, B1); PG8_BAR; PG8_SCHED;
            PG8_LDA(At, 1, 1); PG8_STAGE(PG8_SB(1, 0), b3, voffB); PG8_STAGE(PG8_SB(1, 1), b3 + hstepB, voffB); PG8_STAGE(PG8_SA(1, 0), a3, voffA);
            PG8_WAIT_V(8); PG8_WAIT_L(0); PG8_BAR; PG8_MMA(1, 0, At, B0); PG8_MMA(1, 1, At, B1); PG8_BAR; PG8_SCHED;
        }
        if (wr == 0) PG8_BAR;
        E(acc, cur, wr, wc, fr, fq);
        if (!has_next) break;
#pragma unroll
        for (int a = 0; a < 2; ++a)
#pragma unroll
            for (int b = 0; b < 2; ++b)
#pragma unroll
                for (int m = 0; m < 4; ++m)
#pragma unroll
                    for (int n = 0; n < 2; ++n) acc[a][b][m][n] = (f32x4){0.f, 0.f, 0.f, 0.f};
        cur = nxt; cA = nA; cB = nB; ++ui;
        if (wr == 1) PG8_BAR;
    }
    PG8_WAIT_V(0);
    PG8_BAR;
#undef PG8_SA
#undef PG8_SB
#undef PG8_STAGE
#undef PG8_LDA
#undef PG8_LDB
#undef PG8_MMA
#undef PG8_WAIT_V
#undef PG8_WAIT_L
#undef PG8_BAR
#undef PG8_SCHED
}
}
using pg8::Unit;
typedef f32x4 (&AccRef)[2][2][4][2];

__device__ __forceinline__ void rope8(f32x4& v0, f32x4& v1, const float* cosr, const float* sinr, int fq) {
    const int j0 = 8 * (fq & 1);
    const f32x4 c0 = *(const f32x4*)(cosr + j0), c1 = *(const f32x4*)(cosr + j0 + 4), s0 = *(const f32x4*)(sinr + j0), s1 = *(const f32x4*)(sinr + j0 + 4);
    const float sg = (fq < 2) ? -1.f : 1.f;
#pragma unroll
    for (int i = 0; i < 4; ++i) {
        const float p0 = __shfl_xor(v0[i], 32), p1 = __shfl_xor(v1[i], 32);
        v0[i] = v0[i] * c0[i] + sg * p0 * s0[i]; v1[i] = v1[i] * c1[i] + sg * p1 * s1[i];
    }
}

struct EpiProj {
    static constexpr bool PERM = true;
    bf16_t* O; const float* ssqx; float* ssqq; float* ssqkv; const float* cost; const float* sint;
    __device__ __forceinline__ void operator()(AccRef acc, const Unit& u, int wr, int wc, int fr, int fq) const {
        const int row0 = u.pm * 256 + wr * 64 + fr, col0 = u.pn * 256 + wc * 32 + 8 * fq;
#pragma unroll
        for (int ai = 0; ai < 2; ++ai)
#pragma unroll
            for (int m = 0; m < 4; ++m) {
                const int row = row0 + ai * 128 + m * 16;
                const float rs = rsqrtf(ssq_sum<16>(ssqx + (size_t)row * 16) * (1.0f / DM) + EPS);
                bf16_t* rowp = O + (size_t)row * NPROJ + col0;
#pragma unroll
                for (int bj = 0; bj < 2; ++bj) {
                    f32x4 v0 = acc[ai][bj][m][0] * rs, v1 = acc[ai][bj][m][1] * rs;
                    if (u.pn == 6 || (u.pn == 7 && bj == 0)) {
                        float s = (v0[0] * v0[0] + v0[1] * v0[1]) + (v0[2] * v0[2] + v0[3] * v0[3]) + (v1[0] * v1[0] + v1[1] * v1[1]) + (v1[2] * v1[2] + v1[3] * v1[3]);
                        s += __shfl_xor(s, 16); s += __shfl_xor(s, 32);
                        if (fq == 0) { if (u.pn == 6) ssqq[(size_t)row * 8 + bj * 4 + wc] = s; else ssqkv[(size_t)row * 4 + wc] = s; }
                    }
                    if (u.pn == 7 && bj == 1 && wc == 0) { const int pos = row & (SEQ - 1); rope8(v0, v1, cost + pos * 16, sint + pos * 16, fq); }
                    u32x4 w; w.x = cvtpk(v0[0], v0[1]); w.y = cvtpk(v0[2], v0[3]); w.z = cvtpk(v1[0], v1[1]); w.w = cvtpk(v1[2], v1[3]);
                    *(u32x4*)(rowp + bj * 128) = w;
                }
                asm volatile("" ::: "memory");
            }
    }
};
template <bool ROPE, int NS> struct EpiMla {
    static constexpr bool PERM = true;
    bf16_t* O; int ldc; const float* ssq; float inv_n; const float* cost; const float* sint;
    __device__ __forceinline__ void operator()(AccRef acc, const Unit& u, int wr, int wc, int fr, int fq) const {
        const int row0 = u.pm * 256 + wr * 64 + fr, col0 = u.pn * 256 + wc * 32 + 8 * fq;
#pragma unroll
        for (int ai = 0; ai < 2; ++ai)
#pragma unroll
            for (int m = 0; m < 4; ++m) {
                const int row = row0 + ai * 128 + m * 16;
                const float rs = rsqrtf(ssq_sum<NS>(ssq + (size_t)row * NS) * inv_n + EPS);
                bf16_t* rowp = O + (size_t)row * ldc + col0;
#pragma unroll
                for (int bj = 0; bj < 2; ++bj) {
                    f32x4 v0 = acc[ai][bj][m][0] * rs, v1 = acc[ai][bj][m][1] * rs;
                    if (ROPE) { const int g32 = u.pn * 8 + bj * 4 + wc; if (g32 % 3 == 2) { const int pos = row & (SEQ - 1); rope8(v0, v1, cost + pos * 16, sint + pos * 16, fq); } }
                    u32x4 w; w.x = cvtpk(v0[0], v0[1]); w.y = cvtpk(v0[2], v0[3]); w.z = cvtpk(v1[0], v1[1]); w.w = cvtpk(v1[2], v1[3]);
                    *(u32x4*)(rowp + bj * 128) = w;
                }
                asm volatile("" ::: "memory");
            }
    }
};
struct EpiResid {
    static constexpr bool PERM = false;
    float* X; bf16_t* XB; float* ssq;
    __device__ __forceinline__ void operator()(AccRef acc, const Unit& u, int wr, int wc, int fr, int fq) const {
        const int row0 = u.pm * 256 + wr * 64 + fr, col0 = u.pn * 256 + wc * 32 + 4 * fq;
#pragma unroll
        for (int ai = 0; ai < 2; ++ai)
#pragma unroll
            for (int m = 0; m < 4; ++m) {
                const int row = row0 + ai * 128 + m * 16; const size_t off = (size_t)row * DM + col0; float s = 0.f;
#pragma unroll
                for (int bj = 0; bj < 2; ++bj)
#pragma unroll
                    for (int n = 0; n < 2; ++n) {
                        const f32x4 xo = *(const f32x4*)(X + off + bj * 128 + n * 16);
                        const f32x4 xn = xo + acc[ai][bj][m][n];
                        *(f32x4*)(X + off + bj * 128 + n * 16) = xn;
                        u32x2 w; w.x = cvtpk(xn[0], xn[1]); w.y = cvtpk(xn[2], xn[3]);
                        *(u32x2*)(XB + off + bj * 128 + n * 16) = w;
                        s += (xn[0] * xn[0] + xn[1] * xn[1]) + (xn[2] * xn[2] + xn[3] * xn[3]);
                    }
                s += __shfl_xor(s, 16); s += __shfl_xor(s, 32);
                if (fq == 0) ssq[(size_t)row * 16 + u.pn * 4 + wc] = s;
            }
    }
};
template <int CTRL> __device__ __forceinline__ float dpp_rot(float v) { return __int_as_float(__builtin_amdgcn_update_dpp(__float_as_int(v), __float_as_int(v), CTRL, 0xf, 0xf, false)); }
struct EpiUp {
    static constexpr bool PERM = true;
    bf16_t* ACT; bf16_t* UB; const float* ssqx; const float* cw; const float* cb;
    __device__ __forceinline__ void operator()(AccRef acc, const Unit& u, int wr, int wc, int fr, int fq) const {
        const int row0 = u.pm * 256 + wr * 64 + fr, gcol = u.pn * 128 + wc * 32 + 8 * fq;
#pragma unroll
        for (int ai = 0; ai < 2; ++ai) {
#pragma unroll
            for (int m = 0; m < 4; ++m) {
                const float rs = rsqrtf(ssq_sum<16>(ssqx + (size_t)(row0 + ai * 128 + m * 16) * 16) * (1.0f / DM) + EPS);
#pragma unroll
                for (int bj = 0; bj < 2; ++bj) { acc[ai][bj][m][0] = acc[ai][bj][m][0] * rs; acc[ai][bj][m][1] = acc[ai][bj][m][1] * rs; }
            }
            asm volatile("" ::: "memory");
            const int chunk = u.pm * 4 + ai * 2 + wr;
#pragma unroll
            for (int e = 0; e < 2; ++e) {
                const int m = e ? 3 : 0;
                const bool mine = e ? (fr >= 14) : (fr <= 1);
                const int slot = e ? (fr - 12) : fr;
                if (mine) {
#pragma unroll
                    for (int bj = 0; bj < 2; ++bj) {
                        const f32x4 v0 = acc[ai][bj][m][0], v1 = acc[ai][bj][m][1];
                        u32x4 w; w.x = cvtpk(v0[0], v0[1]); w.y = cvtpk(v0[2], v0[3]); w.z = cvtpk(v1[0], v1[1]); w.w = cvtpk(v1[2], v1[3]);
                        *(u32x4*)(UB + ((size_t)chunk * 4 + slot) * NUP + bj * DFF + gcol) = w;
                    }
                }
            }
            asm volatile("" ::: "memory");
#pragma unroll
            for (int n = 0; n < 2; ++n) {
                unsigned wpk[4][2]; float rlo[4];
#pragma unroll
                for (int i = 0; i < 4; ++i) {
                    const int cg_ = gcol + 4 * n + i, cv_ = cg_ + DFF;
                    const float g0 = cw[cg_], g1 = cw[NUP + cg_], g2 = cw[2 * NUP + cg_], gb = cb[cg_];
                    const float h0 = cw[cv_], h1 = cw[NUP + cv_], h2 = cw[2 * NUP + cv_], hb = cb[cv_];
                    float gt[4];
                    {
                        float pg[4], ng[4];
#pragma unroll
                        for (int m = 0; m < 4; ++m) { pg[m] = dpp_rot<0x121>(acc[ai][0][m][n][i]); ng[m] = dpp_rot<0x12F>(acc[ai][0][m][n][i]); }
#pragma unroll
                        for (int m = 0; m < 4; ++m) {
                            const float gp = (fr == 0) ? (m ? pg[m - 1] : 0.f) : pg[m], gn = (fr == 15) ? (m < 3 ? ng[m + 1] : 0.f) : ng[m];
                            const float t = g0 * gp + g1 * acc[ai][0][m][n][i] + g2 * gn + gb;
                            gt[m] = t * fast_rcp(1.f + fast_exp2(-LOG2E * t));
                        }
                    }
                    asm volatile("" : "+v"(gt[0]), "+v"(gt[1]), "+v"(gt[2]), "+v"(gt[3]));
                    {
                        float pv[4], nv[4];
#pragma unroll
                        for (int m = 0; m < 4; ++m) { pv[m] = dpp_rot<0x121>(acc[ai][1][m][n][i]); nv[m] = dpp_rot<0x12F>(acc[ai][1][m][n][i]); }
#pragma unroll
                        for (int m = 0; m < 4; ++m) {
                            const float vp = (fr == 0) ? (m ? pv[m - 1] : 0.f) : pv[m], vn = (fr == 15) ? (m < 3 ? nv[m + 1] : 0.f) : nv[m];
                            const float vl = h0 * vp + h1 * acc[ai][1][m][n][i] + h2 * vn + hb;
                            const float rv = gt[m] * vl;
                            if (i & 1) wpk[m][i >> 1] = cvtpk(rlo[m], rv); else rlo[m] = rv;
                        }
                    }
                    asm volatile("" ::: "memory");
                }
#pragma unroll
                for (int m = 0; m < 4; ++m) { u32x2 w; w.x = wpk[m][0]; w.y = wpk[m][1];
                    *(u32x2*)(ACT + (size_t)(row0 + ai * 128 + m * 16) * DFF + gcol + 4 * n) = w; }
                asm volatile("" ::: "memory");
            }
        }
    }
};

constexpr int AT_BUF = 20480, AT_V = 12288, AT_TAB = 2 * AT_BUF;
__device__ __forceinline__ float xmax(float a) { auto rr = __builtin_amdgcn_permlane32_swap(__float_as_uint(a), __float_as_uint(a), false, false); return fmaxf(__uint_as_float(rr[0]), __uint_as_float(rr[1])); }
__device__ __forceinline__ float xsum(float a) { auto rr = __builtin_amdgcn_permlane32_swap(__float_as_uint(a), __float_as_uint(a), false, false); return __uint_as_float(rr[0]) + __uint_as_float(rr[1]); }
typedef short v4i16_t __attribute__((ext_vector_type(4)));
__device__ __forceinline__ s16x4 vtr(const LAS unsigned char* p) { return __builtin_bit_cast(s16x4, __builtin_amdgcn_ds_read_tr16_b64_v4i16((LAS v4i16_t*)p)); }

template <int MODE>
__device__ __forceinline__ void attn_unit(LAS unsigned char* lds, const Params& P, int layer, int b, int h, int qb) {
    constexpr int NMAP = (MODE == 1) ? 2 : 1, ND0 = (MODE == 0) ? 6 : (MODE == 1 ? 2 : 4);
    int tid = threadIdx.x; asm volatile("" : "+v"(tid));
    const int lane = tid & 63, r32 = lane & 31, hi = lane >> 5, wave = __builtin_amdgcn_readfirstlane(tid >> 6);
    const bf16_t* proj = (const bf16_t*)(P.ws + WS_PROJ); const bf16_t* cq = (const bf16_t*)(P.ws + WS_CQ); const bf16_t* ckv = (const bf16_t*)(P.ws + WS_CKV);
    bf16_t* mix = (bf16_t*)(P.ws + WS_MIX);
    const size_t rowbase = (size_t)b * SEQ; const int q0 = qb * 256;
    const bf16_t *Qp, *Kp, *Vp; int qpitch, kpitch, vpitch, ocol; float c;
    if (MODE == 0) { Qp = cq + h * 96; qpitch = NCQ; Kp = ckv + h * 128; kpitch = NCKV; Vp = ckv + h * 128 + 64; vpitch = NCKV; ocol = 512 + h * 64; c = 0.10206207261596577f * LOG2E; }
    else if (MODE == 1) { Qp = proj + h * 64; qpitch = NPROJ; Kp = proj + 256 + h * 64; kpitch = NPROJ; Vp = proj + 512 + h * 64; vpitch = NPROJ; ocol = h * 64; c = 0.17677669529663687f * LOG2E; }
    else { Qp = proj + 768 + h * 64; qpitch = NPROJ; Kp = proj + 1024 + h * 64; kpitch = NPROJ; Vp = proj + 1280 + h * 64; vpitch = NPROJ; ocol = 256 + h * 64; c = 0.125f * LOG2E; }
    int kt0 = 0, kt1 = SEQ / 64;
    if (MODE == 2) { kt0 = (q0 - 1024) / 64; if (kt0 < 0) kt0 = 0; kt1 = (q0 + 256 + 1024) / 64; if (kt1 > SEQ / 64) kt1 = SEQ / 64; }
    LAS float* tab = (LAS float*)(lds + AT_TAB);
    if (MODE != 0) {
        const float slope = (MODE == 1) ? exp2f(-(float)(2 * h + 1)) : exp2f(-(float)(2 * h + 2));
        for (int j = tid; j < 4096; j += 512) {
            const int d = (j > 2047) ? (j - 2047) : (2047 - j);
            float v = -slope * LOG2E * (float)d;
            if (MODE == 2) {
                const int mult = (d <= 64 ? 1 : 0) + (((d & 3) == 0 && d <= 256) ? 1 : 0) + (((d & 15) == 0 && d <= 1024) ? 1 : 0);
                v = (mult == 0) ? -1e30f : (mult == 1 ? v : (mult == 2 ? v + 1.0f : v + 1.5849625007211562f));
            }
            tab[j] = v;
        }
    }
    const int qpos = q0 + wave * 32 + r32;
    bf16x8 qf[NMAP][ND0];
    {
        const bf16_t* qrow = Qp + (rowbase + qpos) * qpitch + hi * 8;
#pragma unroll
        for (int mp = 0; mp < NMAP; ++mp)
#pragma unroll
            for (int d0 = 0; d0 < ND0; ++d0) qf[mp][d0] = *(const bf16x8*)(qrow + mp * 32 + d0 * 16);
    }
    u32x4 kreg, kreg2 = (u32x4){0u, 0u, 0u, 0u}, vreg;
#define AT_GLOAD(kt) do { const size_t r_ = rowbase + (size_t)(kt) * 64; \
        kreg = *(const u32x4*)(Kp + (r_ + lane) * kpitch + wave * 8); \
        if (MODE == 0 && wave < 4) kreg2 = *(const u32x4*)(proj + (r_ + lane) * NPROJ + 1920 + wave * 8); \
        vreg = *(const u32x4*)(Vp + (r_ + 16 * (wave & 3) + (lane >> 2)) * vpitch + (wave >> 2) * 32 + (lane & 3) * 8); } while (0)
#define AT_LSTORE(buf) do { LAS unsigned char* d_ = lds + (buf) * AT_BUF; \
        *(LAS u32x4*)(d_ + wave * 1024 + lane * 16) = kreg; \
        if (MODE == 0 && wave < 4) *(LAS u32x4*)(d_ + (8 + wave) * 1024 + lane * 16) = kreg2; \
        *(LAS u32x4*)(d_ + AT_V + wave * 1024 + lane * 16) = vreg; } while (0)
    float mrun[NMAP], lrun[NMAP]; f32x16 o[NMAP][2];
#pragma unroll
    for (int mp = 0; mp < NMAP; ++mp) { mrun[mp] = -1e20f; lrun[mp] = 0.f; o[mp][0] = f32x16{}; o[mp][1] = f32x16{}; }
    AT_GLOAD(kt0); AT_LSTORE(0);
    __syncthreads();
    const int vlane = ((lane >> 4) & 1) * 32 + (lane & 3) * 8 + (4 * hi + ((lane & 15) >> 2)) * 64;
    for (int kt = kt0; kt < kt1; ++kt) {
        const int buf = (kt - kt0) & 1;
        if (kt + 1 < kt1) AT_GLOAD(kt + 1);
        const LAS unsigned char* kb = lds + buf * AT_BUF;
        const LAS unsigned char* vb = kb + AT_V + vlane;
#pragma unroll
        for (int hf = 0; hf < 2; ++hf) {
            bf16x8 pw[NMAP][2];
#pragma unroll
            for (int mp = 0; mp < NMAP; ++mp) {
                f32x16 s0 = f32x16{};
#pragma unroll
                for (int d0 = 0; d0 < ND0; ++d0) {
                    const int ch = (mp * ND0 + d0) * 2;
                    const bf16x8 ka0 = *(const LAS bf16x8*)(kb + (ch + hi) * 1024 + hf * 512 + r32 * 16);
                    s0 = __builtin_amdgcn_mfma_f32_32x32x16_bf16(ka0, qf[mp][d0], s0, 0, 0, 0);
                }
                float rm = -3e38f;
                if (MODE != 0) {
                    if (mp) asm volatile("" ::: "memory");
                    const LAS float* tp = tab + (kt * 64 + hf * 32 + 4 * hi - qpos + 2047);
#pragma unroll
                    for (int r = 0; r < 16; ++r) { s0[r] = s0[r] * c + tp[(r & 3) + 8 * (r >> 2)]; rm = fmaxf(rm, s0[r]); }
                } else {
#pragma unroll
                    for (int r = 0; r < 16; ++r) { s0[r] *= c; rm = fmaxf(rm, s0[r]); }
                }
                rm = xmax(rm);
                const float mn = fmaxf(mrun[mp], rm);
                if (__any(mn > mrun[mp])) {
                    const float al = fast_exp2(mrun[mp] - mn); lrun[mp] *= al;
#pragma unroll
                    for (int r = 0; r < 16; ++r) { o[mp][0][r] *= al; o[mp][1][r] *= al; }
                    mrun[mp] = mn;
                }
                float ls = 0.f;
#pragma unroll
                for (int r = 0; r < 16; ++r) { s0[r] = fast_exp2(s0[r] - mn); ls += s0[r]; }
                lrun[mp] += ls;
                u32x4 w;
                w.x = cvtpk(s0[0], s0[1]); w.y = cvtpk(s0[2], s0[3]); w.z = cvtpk(s0[4], s0[5]); w.w = cvtpk(s0[6], s0[7]); pw[mp][0] = __builtin_bit_cast(bf16x8, w);
                w.x = cvtpk(s0[8], s0[9]); w.y = cvtpk(s0[10], s0[11]); w.z = cvtpk(s0[12], s0[13]); w.w = cvtpk(s0[14], s0[15]); pw[mp][1] = __builtin_bit_cast(bf16x8, w);
            }
#pragma unroll
            for (int dv = 0; dv < 2; ++dv)
#pragma unroll
                for (int k2 = 0; k2 < 2; ++k2) {
                    const int ks = 2 * hf + k2;
                    const s16x4 lo = vtr(vb + dv * 4096 + ks * 1024), hh = vtr(vb + dv * 4096 + ks * 1024 + 512);
                    const bf16x8 vf = (bf16x8){lo[0], lo[1], lo[2], lo[3], hh[0], hh[1], hh[2], hh[3]};
#pragma unroll
                    for (int mp = 0; mp < NMAP; ++mp) o[mp][dv] = __builtin_amdgcn_mfma_f32_32x32x16_bf16(vf, pw[mp][k2], o[mp][dv], 0, 0, 0);
                }
        }
        if (kt + 1 < kt1) AT_LSTORE(buf ^ 1);
        __syncthreads();
    }
#undef AT_GLOAD
#undef AT_LSTORE
    bf16_t* orow = mix + (rowbase + qpos) * DM + ocol + 4 * hi;
    if (MODE != 1) {
        const float inv = 1.f / xsum(lrun[0]);
#pragma unroll
        for (int d = 0; d < 2; ++d)
#pragma unroll
            for (int g = 0; g < 4; ++g) {
                u32x2 w; w.x = cvtpk(o[0][d][4 * g] * inv, o[0][d][4 * g + 1] * inv); w.y = cvtpk(o[0][d][4 * g + 2] * inv, o[0][d][4 * g + 3] * inv);
                *(u32x2*)(orow + 32 * d + 8 * g) = w;
            }
    } else {
        const float lam = __hip_atomic_load((const float*)(P.ws + WS_LAM) + layer, __ATOMIC_RELAXED, __HIP_MEMORY_SCOPE_AGENT);
        const float lam_init = 0.8f - 0.6f * expf(-0.3f * (float)layer);
        const float i1 = 1.f / xsum(lrun[0]), i2 = lam / xsum(lrun[NMAP - 1]);
        float ss = 0.f;
#pragma unroll
        for (int d = 0; d < 2; ++d)
#pragma unroll
            for (int r = 0; r < 16; ++r) { const float v = o[0][d][r] * i1 - o[NMAP - 1][d][r] * i2; o[0][d][r] = v; ss += v * v; }
        ss = xsum(ss);
        const float sc = rsqrtf(ss * (1.0f / 64.0f) + EPS) * (1.f - lam_init);
        const float* gn = P.a_subln + layer * 64 + 4 * hi;
#pragma unroll
        for (int d = 0; d < 2; ++d)
#pragma unroll
            for (int g = 0; g < 4; ++g) {
                const f32x4 gv = *(const f32x4*)(gn + 32 * d + 8 * g);
                u32x2 w; w.x = cvtpk(o[0][d][4 * g] * sc * gv[0], o[0][d][4 * g + 1] * sc * gv[1]); w.y = cvtpk(o[0][d][4 * g + 2] * sc * gv[2], o[0][d][4 * g + 3] * sc * gv[3]);
                *(u32x2*)(orow + 32 * d + 8 * g) = w;
            }
    }
}

__device__ __forceinline__ void transpose_item(const float* W, int K, int Nsrc, const float* g, bf16_t* WT, int n0_dst, int n0_src, int k0, LAS float* scr, int lane) {
#pragma unroll 8
    for (int i = 0; i < 32; ++i) { const int kk = 2 * i + (lane >> 5);
        float v = 0.f; if (n0_src >= 0) { v = W[(size_t)(k0 + kk) * Nsrc + n0_src + (lane & 31)]; if (g) v *= g[k0 + kk]; }
        scr[kk * 33 + (lane & 31)] = v; }
    asm volatile("s_waitcnt lgkmcnt(0)" ::: "memory");
    const int c = lane & 7;
#pragma unroll
    for (int j = 0; j < 4; ++j) { const int n = (lane >> 3) + 8 * j; const LAS float* s = scr + (8 * c) * 33 + n;
        u32x4 o; o.x = cvtpk(s[0 * 33], s[1 * 33]); o.y = cvtpk(s[2 * 33], s[3 * 33]); o.z = cvtpk(s[4 * 33], s[5 * 33]); o.w = cvtpk(s[6 * 33], s[7 * 33]);
        *(u32x4*)(WT + (size_t)(n0_dst + n) * K + k0 + 8 * c) = o; }
    asm volatile("s_waitcnt lgkmcnt(0)" ::: "memory");
}

__device__ __forceinline__ void zero_f32(float* p, int n) { for (int i = blockIdx.x * 512 + threadIdx.x; i < n; i += gridDim.x * 512) p[i] = 0.f; }

__device__ __forceinline__ void prologue(const Params& P, LAS unsigned char* lds) {
    const int tid = threadIdx.x, lane = tid & 63, wave = tid >> 6;
    const int gw = blockIdx.x * 8 + wave, NGW = gridDim.x * 8;
    LAS float* scr = (LAS float*)(lds + wave * 16384);
    constexpr int I_IN = 16 * 64, I_OUT = 16 * 32, I_UP = 16 * 176, I_DN = 44 * 32, I_UQ = 4 * 24, I_UKV = 2 * 32, I_L = I_IN + I_OUT + I_UP + I_DN + I_UQ + I_UKV;
    for (int it = gw; it < I_L * DEPTH; it += NGW) {
        const int l = it / I_L; int r = it % I_L;
        unsigned char* wl = P.ws + WS_W + (size_t)l * W_LAYER;
        if (r < I_IN) { const int kb = r / 64, nb = r % 64; transpose_item(P.w_in + (size_t)l * DM * NIN, DM, NIN, P.g_attn + l * DM, (bf16_t*)(wl + W_IN), nb * 32, nb < 61 ? nb * 32 : -1, kb * 64, scr, lane); continue; } r -= I_IN;
        if (r < I_OUT) { const int kb = r / 32, nb = r % 32; transpose_item(P.w_out + (size_t)l * DM * DM, DM, DM, nullptr, (bf16_t*)(wl + W_OUT), nb * 32, nb * 32, kb * 64, scr, lane); continue; } r -= I_OUT;
        if (r < I_UP) { const int kb = r / 176, nb = r % 176; const int nd = nb * 32, pn = nd >> 8, wi = nd & 255, src = (wi >> 7) * DFF + pn * 128 + (wi & 127);
            transpose_item(P.w_up + (size_t)l * DM * NUP, DM, NUP, P.g_ffn + l * DM, (bf16_t*)(wl + W_UP), nd, src, kb * 64, scr, lane); continue; } r -= I_UP;
        if (r < I_DN) { const int kb = r / 32, nb = r % 32; transpose_item(P.w_down + (size_t)l * DFF * DM, DFF, DM, nullptr, (bf16_t*)(wl + W_DOWN), nb * 32, nb * 32, kb * 64, scr, lane); continue; } r -= I_DN;
        if (r < I_UQ) { const int kb = r / 24, nb = r % 24; transpose_item(P.c_w_uq + (size_t)l * 256 * NCQ, 256, NCQ, P.c_g_q + l * 256, (bf16_t*)(wl + W_UQ), nb * 32, nb * 32, kb * 64, scr, lane); continue; } r -= I_UQ;
        { const int kb = r / 32, nb = r % 32; transpose_item(P.c_w_ukv + (size_t)l * 128 * NCKV, 128, NCKV, P.c_g_kv + l * 128, (bf16_t*)(wl + W_UKV), nb * 32, nb * 32, kb * 64, scr, lane); }
    }
    float* ssqA = (float*)(P.ws + WS_SSQA); bf16_t* xb = (bf16_t*)(P.ws + WS_XB);
    for (int m = gw; m < T_TOK; m += NGW) {
        const f32x4* xr = (const f32x4*)(P.x + (size_t)m * DM) + lane; f32x4* orow = (f32x4*)(P.out + (size_t)m * DM) + lane; u32x2* brow = (u32x2*)(xb + (size_t)m * DM) + lane;
        float s = 0.f;
#pragma unroll
        for (int j = 0; j < 4; ++j) { const f32x4 v = xr[64 * j]; orow[64 * j] = v; u32x2 w; w.x = cvtpk(v[0], v[1]); w.y = cvtpk(v[2], v[3]); brow[64 * j] = w; s += (v[0] * v[0] + v[1] * v[1]) + (v[2] * v[2] + v[3] * v[3]); }
        s = wave_sum(s);
        if (lane < 16) ssqA[(size_t)m * 16 + lane] = lane ? 0.f : s;
    }
    float* cost = (float*)(P.ws + WS_COS); float* sint = (float*)(P.ws + WS_SIN);
    for (int i = blockIdx.x * 512 + tid; i < SEQ * 16; i += gridDim.x * 512) {
        const int pos = i >> 4, j = i & 15; const float inv = exp2f(-(float)j * (13.287712379549449f / 16.0f)); const float ang = (float)pos * inv;
        cost[i] = cosf(ang); sint[i] = sinf(ang);
    }
    if (blockIdx.x == 0 && tid < DEPTH) {
        float d1 = 0.f, d2 = 0.f;
        for (int j = 0; j < 32; ++j) { d1 += P.a_lq1[tid * 32 + j] * P.a_lk1[tid * 32 + j]; d2 += P.a_lq2[tid * 32 + j] * P.a_lk2[tid * 32 + j]; }
        ((float*)(P.ws + WS_LAM))[tid] = expf(d1) - expf(d2) + (0.8f - 0.6f * expf(-0.3f * (float)tid));
    }
}

__device__ __forceinline__ void ffn_fixup(const Params& P, int layer) {
    const bf16_t* UB = (const bf16_t*)(P.ws + WS_UBND); bf16_t* ACT = (bf16_t*)(P.ws + WS_ACT);
    const float* cw = P.conv_w + (size_t)layer * 3 * NUP; const float* cb = P.conv_b + (size_t)layer * NUP;
    constexpr int CG = DFF / 8;
    for (int it = blockIdx.x * 512 + threadIdx.x; it < 512 * 2 * CG; it += gridDim.x * 512) {
        const int cgi = it % CG, e = (it / CG) & 1, chunk = it / (2 * CG), col = cgi * 8;
        const bf16_t *up, *mid, *dn; bool zu = false, zd = false;
        if (e == 0) { zu = (chunk % 32) == 0; up = UB + ((size_t)(zu ? chunk : chunk - 1) * 4 + 3) * NUP; mid = UB + ((size_t)chunk * 4 + 0) * NUP; dn = UB + ((size_t)chunk * 4 + 1) * NUP; }
        else { zd = (chunk % 32) == 31; up = UB + ((size_t)chunk * 4 + 2) * NUP; mid = UB + ((size_t)chunk * 4 + 3) * NUP; dn = UB + ((size_t)(zd ? chunk : chunk + 1) * 4 + 0) * NUP; }
        const float fu = zu ? 0.f : 1.f, fd = zd ? 0.f : 1.f;
        float res[8];
        bf16_t ug[8], mg[8], dg[8], uv[8], mv[8], dv[8];
        *(u32x4*)ug = *(const u32x4*)(up + col); *(u32x4*)mg = *(const u32x4*)(mid + col); *(u32x4*)dg = *(const u32x4*)(dn + col);
        *(u32x4*)uv = *(const u32x4*)(up + DFF + col); *(u32x4*)mv = *(const u32x4*)(mid + DFF + col); *(u32x4*)dv = *(const u32x4*)(dn + DFF + col);
#pragma unroll
        for (int k = 0; k < 8; ++k) {
            const int cg_ = col + k, cv_ = DFF + col + k;
            const float gt = cw[cg_] * bf2f(ug[k]) * fu + cw[NUP + cg_] * bf2f(mg[k]) + cw[2 * NUP + cg_] * bf2f(dg[k]) * fd + cb[cg_];
            const float vl = cw[cv_] * bf2f(uv[k]) * fu + cw[NUP + cv_] * bf2f(mv[k]) + cw[2 * NUP + cv_] * bf2f(dv[k]) * fd + cb[cv_];
            res[k] = gt * fast_rcp(1.f + fast_exp2(-LOG2E * gt)) * vl;
        }
        u32x4 w; w.x = cvtpk(res[0], res[1]); w.y = cvtpk(res[2], res[3]); w.z = cvtpk(res[4], res[5]); w.w = cvtpk(res[6], res[7]);
        *(u32x4*)(ACT + (size_t)(chunk * 64 + (e ? 63 : 0)) * DFF + col) = w;
    }
}


#define XB_TMO      128
#define XB_XCNT(j)  (256  + 64 * (j))
#define XB_XSUB(j)  (1280 + 64 * (j))
#define XB_XGEN(j)  (2304 + 64 * (j))
#define XB_TOP      3328
#define XB_TOPGEN   3392
#define XCD_BAR_WORDS 3456
#define XB_SPIN_CAP (1u << 22)
__device__ __forceinline__ unsigned xb_ld(unsigned* p)              { return __hip_atomic_load(p, __ATOMIC_RELAXED, __HIP_MEMORY_SCOPE_AGENT); }
__device__ __forceinline__ unsigned xb_add(unsigned* p, unsigned v) { return __hip_atomic_fetch_add(p, v, __ATOMIC_RELAXED, __HIP_MEMORY_SCOPE_AGENT); }
__device__ __forceinline__ unsigned xb_xcc_id() { return (unsigned)__builtin_amdgcn_s_getreg((3 << 11) | 20) & 0xFu; }
#define XB_SPIN(cond, bar) do { unsigned _sp = 0; while (cond) { __builtin_amdgcn_s_sleep(1); \
    if ((++_sp & 255u) == 0u) { if (xb_ld(&(bar)[XB_TMO])) break; if (_sp > XB_SPIN_CAP) { atomicAdd(&(bar)[XB_TMO], 1u); break; } } } } while (0)
struct XcdBarrier { unsigned* bar; unsigned x; volatile LAS unsigned* st; };
__device__ __forceinline__ XcdBarrier xcd_barrier_post(unsigned* bar, volatile LAS unsigned* st) {
    XcdBarrier b; b.bar = bar; b.x = xb_xcc_id(); b.st = st;
    if (threadIdx.x == 0) (void)xb_add(&bar[XB_XCNT(b.x)], 1u);
    return b;
}
__device__ __forceinline__ void xcd_barrier_complete(unsigned* bar, unsigned x, unsigned& nloc, unsigned& nx) {
    const unsigned G = gridDim.x * gridDim.y * gridDim.z;
    unsigned sum, cnt, mine, sp = 0u;
    for (;;) {
        sum = 0u; cnt = 0u; mine = 0u;
#pragma unroll
        for (unsigned j = 0; j < 16; ++j) { const unsigned c = xb_ld(&bar[XB_XCNT(j)]); sum += c; cnt += (c > 0u) ? 1u : 0u; mine = (j == x) ? c : mine; }
        if (sum == G) break;
        __builtin_amdgcn_s_sleep(1);
        if ((++sp & 255u) == 0u) { if (xb_ld(&bar[XB_TMO])) break; if (sp > XB_SPIN_CAP) { atomicAdd(&bar[XB_TMO], 1u); break; } }
    }
    nloc = mine > 0u ? mine : 1u; nx = cnt > 0u ? cnt : 1u;
}
__device__ __forceinline__ void xcd_barrier(const XcdBarrier& b) {
    asm volatile("s_waitcnt vmcnt(0)" ::: "memory");
    __syncthreads();
    if (threadIdx.x == 0) {
        unsigned* bar = b.bar;
        __builtin_amdgcn_s_waitcnt(0);
        unsigned nloc = b.st[0], nx = b.st[1];
        if (nloc == 0u) { xcd_barrier_complete(bar, b.x, nloc, nx); b.st[0] = nloc; b.st[1] = nx; }
        const unsigned old = xb_add(&bar[XB_XSUB(b.x)], 1u);
        const unsigned gen = old / nloc;
        if (old + 1u == (gen + 1u) * nloc) {
            __builtin_amdgcn_fence(__ATOMIC_RELEASE, "agent");
            asm volatile("s_waitcnt vmcnt(0)" ::: "memory");
            const unsigned og = xb_add(&bar[XB_TOP], 1u);
            const unsigned tg = og / nx;
            if (og + 1u == (tg + 1u) * nx) xb_add(&bar[XB_TOPGEN], 1u);
            else XB_SPIN(xb_ld(&bar[XB_TOPGEN]) == tg, bar);
            __builtin_amdgcn_fence(__ATOMIC_ACQUIRE, "agent");
            xb_add(&bar[XB_XGEN(b.x)], 1u);
            asm volatile("s_waitcnt vmcnt(0)" ::: "memory");
        } else {
            XB_SPIN(xb_ld(&bar[XB_XGEN(b.x)]) == gen, bar);
            __builtin_amdgcn_fence(__ATOMIC_ACQUIRE, "agent");
            asm volatile("s_waitcnt vmcnt(0)" ::: "memory");
        }
    }
    __syncthreads();
}

__global__ void __launch_bounds__(512, 2) fwd_megakernel(Params P) {
    extern __shared__ __attribute__((aligned(16))) unsigned char lds_raw[];
    LAS unsigned char* lds = (LAS unsigned char*)lds_raw;
    cg::grid_group grid = cg::this_grid();
#define GRID_SYNC() do { asm volatile("s_waitcnt vmcnt(0) lgkmcnt(0)" ::: "memory"); __syncthreads(); grid.sync(); \
        __builtin_amdgcn_fence(__ATOMIC_ACQUIRE, "agent"); asm volatile("s_waitcnt vmcnt(0)" ::: "memory"); GRID_SYNC2(); } while (0)
#if MK_DUP_SYNC > 1
#define GRID_SYNC2() do { grid.sync(); __builtin_amdgcn_fence(__ATOMIC_ACQUIRE, "agent"); asm volatile("s_waitcnt vmcnt(0)" ::: "memory"); } while (0)
#else
#define GRID_SYNC2() do {} while (0)
#endif
    unsigned char* ws = P.ws;
    float* ssqA = (float*)(ws + WS_SSQA); float* ssqB = (float*)(ws + WS_SSQB); float* ssqQ = (float*)(ws + WS_SSQQ); float* ssqKV = (float*)(ws + WS_SSQKV);
    const float* cost = (const float*)(ws + WS_COS); const float* sint = (const float*)(ws + WS_SIN);
    bf16_t* xb = (bf16_t*)(ws + WS_XB); bf16_t* proj = (bf16_t*)(ws + WS_PROJ); bf16_t* cq = (bf16_t*)(ws + WS_CQ); bf16_t* ckv = (bf16_t*)(ws + WS_CKV);
    bf16_t* mix = (bf16_t*)(ws + WS_MIX); bf16_t* act = (bf16_t*)(ws + WS_ACT); bf16_t* ubnd = (bf16_t*)(ws + WS_UBND);

    volatile LAS unsigned* bst = (volatile LAS unsigned*)(lds + 131072 + 64);
    if (threadIdx.x < 2) bst[threadIdx.x] = 0u;
    __syncthreads();
    const XcdBarrier xbar = xcd_barrier_post((unsigned*)(ws + WS_BAR), bst);
    prologue(P, lds);
#if MK_DUP_PRO > 1
    volatile LAS unsigned* bst = (volatile LAS unsigned*)(lds + 131072 + 64);
    if (threadIdx.x < 2) bst[threadIdx.x] = 0u;
    __syncthreads();
    const XcdBarrier xbar = xcd_barrier_post((unsigned*)(ws + WS_BAR), bst);
    prologue(P, lds);
#endif
    GRID_SYNC();
    for (int l = 0; l < DEPTH; ++l) {
        const unsigned char* wl = ws + WS_W + (size_t)l * W_LAYER;
#if !(MK_SKIP & 1)
        { pg8::Gemm g{xb, (const bf16_t*)(wl + W_IN), T_TOK, NPROJ, DM, DM}; EpiProj E{proj, ssqA, ssqQ, ssqKV, cost, sint}; pg8::gemm_phase(lds, g, E); }
#if MK_DUP_IN > 1
        { pg8::Gemm g{xb, (const bf16_t*)(wl + W_IN), T_TOK, NPROJ, DM, DM}; EpiProj E{proj, ssqA, ssqQ, ssqKV, cost, sint}; pg8::gemm_phase(lds, g, E); }
#endif
#endif
        xcd_barrier(xbar);
#if !(MK_SKIP & 2)
        { pg8::Gemm g{proj + 1536, (const bf16_t*)(wl + W_UQ), T_TOK, NCQ, 256, NPROJ}; EpiMla<true, 8> E{cq, NCQ, ssqQ, 1.0f / 256.0f, cost, sint}; pg8::gemm_phase(lds, g, E); }
        { pg8::Gemm g{proj + 1792, (const bf16_t*)(wl + W_UKV), T_TOK, NCKV, 128, NPROJ}; EpiMla<false, 4> E{ckv, NCKV, ssqKV, 1.0f / 128.0f, cost, sint}; pg8::gemm_phase(lds, g, E); }
#endif
#if !(MK_SKIP & 4)
        for (int rep_ = 0; rep_ < MK_DUP_AB; ++rep_)
        for (int u = blockIdx.x; u < 1024; u += gridDim.x) {
            if (u < 512) { attn_unit<1>(lds, P, l, u >> 5, (u >> 3) & 3, u & 7); }
            else { const int v = u - 512; int qb = v & 7; if (v >= 256) qb = (qb + 4) & 7; attn_unit<2>(lds, P, l, (v >> 5) & 15, (v >> 3) & 3, qb); }
        }
#endif
        xcd_barrier(xbar);
#if !(MK_SKIP & 8)
        for (int rep_ = 0; rep_ < MK_DUP_C; ++rep_)
        for (int u = blockIdx.x; u < 1024; u += gridDim.x) attn_unit<0>(lds, P, l, u >> 6, (u >> 3) & 7, u & 7);
#endif
        xcd_barrier(xbar);
#if !(MK_SKIP & 16)
        { pg8::Gemm g{mix, (const bf16_t*)(wl + W_OUT), T_TOK, DM, DM, DM}; EpiResid E{P.out, xb, ssqB}; pg8::gemm_phase(lds, g, E); }
#endif
        xcd_barrier(xbar);
#if !(MK_SKIP & 32)
        { pg8::Gemm g{xb, (const bf16_t*)(wl + W_UP), T_TOK, NUP, DM, DM}; EpiUp E{act, ubnd, ssqB, P.conv_w + (size_t)l * 3 * NUP, P.conv_b + (size_t)l * NUP}; pg8::gemm_phase(lds, g, E); }
#if MK_DUP_UP > 1
        { pg8::Gemm g{xb, (const bf16_t*)(wl + W_UP), T_TOK, NUP, DM, DM}; EpiUp E{act, ubnd, ssqB, P.conv_w + (size_t)l * 3 * NUP, P.conv_b + (size_t)l * NUP}; pg8::gemm_phase(lds, g, E); }
#endif
#endif
        xcd_barrier(xbar);
        ffn_fixup(P, l);
        xcd_barrier(xbar);
#if !(MK_SKIP & 64)
        { pg8::Gemm g{act, (const bf16_t*)(wl + W_DOWN), T_TOK, DM, DFF, DFF}; EpiResid E{P.out, xb, ssqA}; pg8::gemm_phase(lds, g, E); }
#endif
        xcd_barrier(xbar);
    }
    for (int i = blockIdx.x * 512 + threadIdx.x; i < T_TOK * (DM / 4); i += gridDim.x * 512) {
        const int row = i >> 8, c4 = i & 255;
        const float rs = rsqrtf(ssq_sum<16>(ssqA + (size_t)row * 16) * (1.0f / DM) + EPS);
        f32x4 v = ((f32x4*)P.out)[i]; const f32x4 gv = ((const f32x4*)P.g_final)[c4];
        v = v * rs * gv; ((f32x4*)P.out)[i] = v;
    }
}

extern "C" void kernel_launch(void* const* d_in, const int* in_sizes, int n_in, void* d_out, int out_size, void* d_ws, size_t ws_size, hipStream_t stream) {
    static int grid_blocks = 0;
    if (!grid_blocks) {
        if (n_in != 19 || ws_size < WS_END) { fprintf(stderr, "kernel_launch: unexpected n_in %d / ws %zu\n", n_in, ws_size); grid_blocks = -1; return; }
        int dev = 0, cus = 0, per_cu = 0;
        hipGetDevice(&dev);
        hipDeviceGetAttribute(&cus, hipDeviceAttributeMultiprocessorCount, dev);
        hipFuncSetAttribute((const void*)fwd_megakernel, hipFuncAttributeMaxDynamicSharedMemorySize, LDS_BYTES);
        hipOccupancyMaxActiveBlocksPerMultiprocessor(&per_cu, (const void*)fwd_megakernel, 512, LDS_BYTES);
        if (per_cu < 1) { fprintf(stderr, "kernel_launch: occupancy query says %d blocks/CU\n", per_cu); per_cu = 1; }
        grid_blocks = cus * per_cu;
    }
    if (grid_blocks < 0) return;
    Params p{};
    const float** f = (const float**)&p;
    for (int i = 0; i < 19; ++i) f[i] = (const float*)d_in[i];
    p.out = (float*)d_out; p.ws = (unsigned char*)d_ws;
    (void)hipMemsetAsync((char*)d_ws + WS_BAR, 0, WS_BAR_BYTES, stream);
    void* args[] = {&p};
    hipError_t e = hipLaunchCooperativeKernel((const void*)fwd_megakernel, dim3(grid_blocks), dim3(512), args, LDS_BYTES, stream);
    if (e != hipSuccess) fprintf(stderr, "cooperative launch failed: %s (grid %d)\n", hipGetErrorString(e), grid_blocks);
}
```

```cpp
#include <hip/hip_runtime.h>
#include <hip/hip_cooperative_groups.h>
#include <cstdint>
#include <cstdio>
namespace cg = cooperative_groups;

#define LAS __attribute__((address_space(3)))
typedef unsigned short bf16_t;
typedef short bf16x8 __attribute__((ext_vector_type(8)));
typedef short s16x4 __attribute__((ext_vector_type(4)));
typedef float f32x4 __attribute__((ext_vector_type(4)));
typedef float f32x2 __attribute__((ext_vector_type(2)));
typedef float f32x16 __attribute__((ext_vector_type(16)));
typedef unsigned u32x4 __attribute__((ext_vector_type(4)));
typedef unsigned u32x2 __attribute__((ext_vector_type(2)));
typedef __bf16 bf16x2_t __attribute__((ext_vector_type(2)));

constexpr int T_TOK = 32768, SEQ = 2048, DM = 1024, DEPTH = 4;
constexpr int NPROJ = 2048, NIN = 1952, DFF = 2816, NUP = 5632;
constexpr int NCQ = 768, NCKV = 1024;
constexpr float EPS = 1e-6f;
constexpr float LOG2E = 1.4426950408889634f;

constexpr size_t MiB = 1u << 20;
constexpr size_t WS_BAR = 0, WS_BAR_BYTES = 16384;
constexpr size_t WS_LAM = 512 * 1024;
constexpr size_t WS_COS = 576 * 1024, WS_SIN = 704 * 1024;
constexpr size_t WS_W = 1 * MiB;
constexpr size_t W_IN = 0, W_OUT = W_IN + (size_t)NPROJ * DM * 2, W_UP = W_OUT + (size_t)DM * DM * 2, W_DOWN = W_UP + (size_t)NUP * DM * 2,
                 W_UQ = W_DOWN + (size_t)DM * DFF * 2, W_UKV = W_UQ + (size_t)NCQ * 256 * 2, W_LAYER = W_UKV + (size_t)NCKV * 128 * 2;
static_assert(W_LAYER * DEPTH <= 93 * MiB, "weights");
constexpr size_t WS_XB = 94 * MiB, WS_PROJ = 158 * MiB, WS_CQ = 286 * MiB, WS_CKV = 334 * MiB, WS_MIX = 398 * MiB;
constexpr size_t WS_SSQA = 462 * MiB, WS_SSQB = 464 * MiB, WS_SSQQ = 466 * MiB, WS_SSQKV = 467 * MiB, WS_END = 468 * MiB;
constexpr size_t WS_ACT = 158 * MiB, WS_UBND = 334 * MiB;
static_assert(WS_ACT + (size_t)T_TOK * DFF * 2 <= WS_UBND && WS_UBND + (size_t)512 * 4 * NUP * 2 <= WS_MIX, "overlay");

constexpr int LDS_BYTES = 147456;
#ifndef MK_SKIP
#define MK_SKIP 0
#endif
#ifndef MK_DUP_PRO
#define MK_DUP_PRO 1
#endif
#ifndef MK_DUP_SYNC
#define MK_DUP_SYNC 1
#endif
#ifndef MK_DUP_MLA
#define MK_DUP_MLA 1
#endif
#ifndef MK_DUP_BAR
#define MK_DUP_BAR 1
#endif
#ifndef MK_DUP_UP
#define MK_DUP_UP 1
#endif
#ifndef MK_DUP_IN
#define MK_DUP_IN 1
#endif
#ifndef MK_DUP_AB
#define MK_DUP_AB 1
#endif
#ifndef MK_DUP_C
#define MK_DUP_C 1
#endif

struct Params {
    const float* x; const float* w_in; const float* g_attn; const float* a_lq1; const float* a_lk1; const float* a_lq2; const float* a_lk2;
    const float* a_subln; const float* c_g_q; const float* c_w_uq; const float* c_g_kv; const float* c_w_ukv; const float* w_out; const float* g_ffn;
    const float* w_up; const float* conv_w; const float* conv_b; const float* w_down; const float* g_final;
    float* out; unsigned char* ws;
};

__device__ __forceinline__ unsigned cvtpk(float lo, float hi) { f32x2 v = {lo, hi}; bf16x2_t b = __builtin_convertvector(v, bf16x2_t); return __builtin_bit_cast(unsigned, b); }
__device__ __forceinline__ float bf2f(unsigned short b) { return __uint_as_float((unsigned)b << 16); }
__device__ __forceinline__ float wave_sum(float v) {
#pragma unroll
    for (int o = 1; o < 64; o <<= 1) v += __shfl_xor(v, o);
    return v;
}
__device__ __forceinline__ float ld_agent(const float* p) { return __hip_atomic_load(p, __ATOMIC_RELAXED, __HIP_MEMORY_SCOPE_AGENT); }
template <int NS> __device__ __forceinline__ float ssq_sum(const float* p) {
    float t = 0.f;
#pragma unroll
    for (int i = 0; i < NS / 4; ++i) { const f32x4 v = *(const f32x4*)(p + 4 * i); t += (v[0] + v[1]) + (v[2] + v[3]); }
    return t;
}
__device__ __forceinline__ float fast_exp2(float x) { return __builtin_amdgcn_exp2f(x); }
__device__ __forceinline__ float fast_rcp(float x) { return __builtin_amdgcn_rcpf(x); }

namespace pg8 {
constexpr int BM = 256, BK = 64, HALF = 128, HTB = HALF * BK * 2, STAGE_BYTES = 8 * HTB, NXCD = 8, WGM = 8;
__host__ __device__ __forceinline__ int lds_byte(int r, int c) { const int st = (r >> 4) * 2 + (c >> 5), rr = r & 15, cc = c & 31, ob = rr * 64 + cc * 2; return st * 1024 + (ob ^ (((ob >> 9) & 1) << 5)); }
__host__ __device__ __forceinline__ void stage_rc(int b, int& R, int& C) { const int st = b / 1024, sb = b % 1024, swz = sb ^ (((sb >> 9) & 1) << 5); R = (st >> 1) * 16 + swz / 64; C = (st & 1) * 32 + (swz % 64) / 2; }
__host__ __device__ __forceinline__ int perm32(int rho) { const int n = rho >> 4, i = rho & 15; return 8 * (i >> 2) + 4 * n + (i & 3); }
struct Unit { int pm, pn; };
struct Gemm { const bf16_t* A; const bf16_t* Bt; int M, N, K, lda; };
struct StaticOrder {
    int nM, nN, nwg, G, c;
    __device__ void init(int M, int N, int G_, int c_) { nM = M / BM; nN = N / BM; nwg = nM * nN; G = G_; c = c_; }
    __device__ bool next(int i, Unit& u) const {
        const long L = (long)i * G + c; if (L >= nwg) return false;
        int wgid = (int)L; { const int q = nwg / NXCD, r = nwg % NXCD, xcd = wgid % NXCD, off = wgid / NXCD; wgid = (xcd < r ? xcd * (q + 1) : r * (q + 1) + (xcd - r) * q) + off; }
        const int nig = WGM * nN, gid = wgid / nig, fm = gid * WGM, gsz = (nM - fm) < WGM ? (nM - fm) : WGM;
        u.pm = fm + ((wgid % nig) % gsz); u.pn = (wgid % nig) / gsz; return true;
    }
};

template <class Epi>
__device__ __forceinline__ void gemm_phase(LAS unsigned char* lds, const Gemm g, const Epi& E) {
    int tid = threadIdx.x; asm volatile("" : "+v"(tid));
    const int wid = __builtin_amdgcn_readfirstlane(tid >> 6), lane = tid & 63, wr = wid >> 2, wc = wid & 3, fr = lane & 15, fq = lane >> 4;
    int K = g.K, lda = g.lda; asm volatile("" : "+s"(K), "+s"(lda));
    const int nt = K / BK;
    StaticOrder S; S.init(g.M, g.N, (int)gridDim.x, (int)blockIdx.x);
    unsigned voffA[2], voffB[2];
#pragma unroll
    for (int i = 0; i < 2; ++i) { int R, C; stage_rc(tid * 16 + i * 8192, R, C); const int Rb = Epi::PERM ? ((R & ~31) + perm32(R & 31)) : R;
        voffA[i] = (unsigned)(R * lda + C) * 2u; voffB[i] = (unsigned)(Rb * K + C) * 2u; }
    const size_t kstep = (size_t)(BK * 2);
    const size_t hstepA = (size_t)HALF * lda * 2, hstepB = (size_t)HALF * K * 2;
    const size_t tstepA = 2 * hstepA, tstepB = 2 * hstepB;
    const unsigned ldsw = (unsigned)wid * 1024u;
    const int aoff = lds_byte(wr * 64 + fr, fq * 8), boff = lds_byte(wc * 32 + fr, fq * 8);
#define PG8_SA(b, h) (((b) * 2 + (h)) * HTB)
#define PG8_SB(b, h) ((4 + (b) * 2 + (h)) * HTB)
#define PG8_STAGE(bufoff, gbase, voff) do { _Pragma("unroll") for (int _i = 0; _i < 2; ++_i) \
        __builtin_amdgcn_global_load_lds((const unsigned*)((const char*)(gbase) + (voff)[_i]), (LAS unsigned*)(lds + (bufoff) + ldsw + _i * 8192), 16, 0, 0); } while (0)
#define PG8_LDA(dst, b, h) do { _Pragma("unroll") for (int m = 0; m < 4; ++m) _Pragma("unroll") for (int k = 0; k < 2; ++k) dst[m][k] = *(const LAS bf16x8*)(lds + PG8_SA(b, h) + aoff + m * 2048 + k * 1024); } while (0)
#define PG8_LDB(dst, b, h) do { _Pragma("unroll") for (int n = 0; n < 2; ++n) _Pragma("unroll") for (int k = 0; k < 2; ++k) dst[n][k] = *(const LAS bf16x8*)(lds + PG8_SB(b, h) + boff + n * 2048 + k * 1024); } while (0)
#define PG8_MMA(ai, bj, At, Bt) do { __builtin_amdgcn_s_setprio(1); _Pragma("unroll") for (int m = 0; m < 4; ++m) _Pragma("unroll") for (int n = 0; n < 2; ++n) _Pragma("unroll") for (int k = 0; k < 2; ++k) \
        acc[ai][bj][m][n] = __builtin_amdgcn_mfma_f32_16x16x32_bf16(Bt[n][k], At[m][k], acc[ai][bj][m][n], 0, 0, 0); __builtin_amdgcn_s_setprio(0); } while (0)
#define PG8_WAIT_V(n) asm volatile("s_waitcnt vmcnt(" #n ")" ::: "memory")
#define PG8_WAIT_L(n) asm volatile("s_waitcnt lgkmcnt(" #n ")" ::: "memory")
#define PG8_BAR __builtin_amdgcn_s_barrier()
#define PG8_SCHED __builtin_amdgcn_sched_barrier(0)
    Unit cur, nxt; int ui = 0;
    if (!S.next(0, cur)) return;
    f32x4 acc[2][2][4][2];
#pragma unroll
    for (int a = 0; a < 2; ++a)
#pragma unroll
        for (int b = 0; b < 2; ++b)
#pragma unroll
            for (int m = 0; m < 4; ++m)
#pragma unroll
                for (int n = 0; n < 2; ++n) acc[a][b][m][n] = (f32x4){0.f, 0.f, 0.f, 0.f};
    bf16x8 At[4][2], B0[2][2], B1[2][2];
    const char* cA = (const char*)g.A + (size_t)cur.pm * tstepA; const char* cB = (const char*)g.Bt + (size_t)cur.pn * tstepB;
    PG8_STAGE(PG8_SB(0, 0), cB, voffB); PG8_STAGE(PG8_SB(0, 1), cB + hstepB, voffB); PG8_STAGE(PG8_SA(0, 0), cA, voffA); PG8_STAGE(PG8_SA(0, 1), cA + hstepA, voffA);
    if (wr == 1) PG8_BAR;
    PG8_WAIT_V(2); PG8_BAR;
    PG8_STAGE(PG8_SB(1, 0), cB + kstep, voffB); PG8_STAGE(PG8_SA(1, 0), cA + kstep, voffA); PG8_STAGE(PG8_SB(1, 1), cB + hstepB + kstep, voffB);
    PG8_WAIT_V(6); PG8_BAR;
    for (;;) {
        const bool has_next = S.next(ui + 1, nxt);
        const char* nA = has_next ? (const char*)g.A + (size_t)nxt.pm * tstepA : cA; const char* nB = has_next ? (const char*)g.Bt + (size_t)nxt.pn * tstepB : cB;
        for (int t = 0; t < nt; t += 2) {
            const bool last = (t == nt - 2);
            const char* a1 = cA + (size_t)(t + 1) * kstep;
            const char* a2 = last ? nA : cA + (size_t)(t + 2) * kstep; const char* b2 = last ? nB : cB + (size_t)(t + 2) * kstep;
            const char* a3 = a2 + kstep; const char* b3 = b2 + kstep;
            PG8_LDB(B0, 0, 0); PG8_LDB(B1, 0, 1); PG8_SCHED; PG8_LDA(At, 0, 0); PG8_STAGE(PG8_SA(1, 1), a1 + hstepA, voffA);
            PG8_WAIT_V(8); PG8_WAIT_L(0); PG8_BAR; PG8_MMA(0, 0, At, B0); PG8_MMA(0, 1, At, B1); PG8_BAR; PG8_SCHED;
            PG8_LDA(At, 0, 1); PG8_STAGE(PG8_SB(0, 0), b2, voffB); PG8_STAGE(PG8_SB(0, 1), b2 + hstepB, voffB); PG8_STAGE(PG8_SA(0, 0), a2, voffA);
            PG8_WAIT_V(8); PG8_WAIT_L(0); PG8_BAR; PG8_MMA(1, 0, At, B0); PG8_MMA(1, 1, At, B1); PG8_BAR; PG8_SCHED;
            PG8_LDB(B0, 1, 0); PG8_LDB(B1, 1, 1); PG8_SCHED; PG8_LDA(At, 1, 0); PG8_STAGE(PG8_SA(0, 1), a2 + hstepA, voffA);
            PG8_WAIT_V(8); PG8_WAIT_L(0); PG8_BAR; PG8_MMA(0, 0, At, B0); PG8_MMA(0, 1, At, B1); PG8_BAR; PG8_SCHED;
            PG8_LDA(At, 1, 1); PG8_STAGE(PG8_SB(1, 0), b3, voffB); PG8_STAGE(PG8_SB(1, 1), b3 + hstepB, voffB); PG8_STAGE(PG8_SA(1, 0), a3, voffA);
            PG8_WAIT_V(8); PG8_WAIT_L(0); PG8_BAR; PG8_MMA(1, 0, At, B0); PG8_MMA(1, 1, At, B1); PG8_BAR; PG8_SCHED;
        }
        if (wr == 0) PG8_BAR;
        E(acc, cur, wr, wc, fr, fq);
        if (!has_next) break;
#pragma unroll
        for (int a = 0; a < 2; ++a)
#pragma unroll
            for (int b = 0; b < 2; ++b)
#pragma unroll
                for (int m = 0; m < 4; ++m)
#pragma unroll
                    for (int n = 0; n < 2; ++n) acc[a][b][m][n] = (f32x4){0.f, 0.f, 0.f, 0.f};
        cur = nxt; cA = nA; cB = nB; ++ui;
        if (wr == 1) PG8_BAR;
    }
    PG8_WAIT_V(0);
    PG8_BAR;
#undef PG8_SA
#undef PG8_SB
#undef PG8_STAGE
#undef PG8_LDA
#undef PG8_LDB
#undef PG8_MMA
#undef PG8_WAIT_V
#undef PG8_WAIT_L
#undef PG8_BAR
#undef PG8_SCHED
}
}
using pg8::Unit;
typedef f32x4 (&AccRef)[2][2][4][2];

__device__ __forceinline__ void rope8(f32x4& v0, f32x4& v1, const float* cosr, const float* sinr, int fq) {
    const int j0 = 8 * (fq & 1);
    const f32x4 c0 = *(const f32x4*)(cosr + j0), c1 = *(const f32x4*)(cosr + j0 + 4), s0 = *(const f32x4*)(sinr + j0), s1 = *(const f32x4*)(sinr + j0 + 4);
    const float sg = (fq < 2) ? -1.f : 1.f;
#pragma unroll
    for (int i = 0; i < 4; ++i) {
        const float p0 = __shfl_xor(v0[i], 32), p1 = __shfl_xor(v1[i], 32);
        v0[i] = v0[i] * c0[i] + sg * p0 * s0[i]; v1[i] = v1[i] * c1[i] + sg * p1 * s1[i];
    }
}

struct EpiProj {
    static constexpr bool PERM = true;
    bf16_t* O; const float* ssqx; float* ssqq; float* ssqkv; const float* cost; const float* sint;
    __device__ __forceinline__ void operator()(AccRef acc, const Unit& u, int wr, int wc, int fr, int fq) const {
        const int row0 = u.pm * 256 + wr * 64 + fr, col0 = u.pn * 256 + wc * 32 + 8 * fq;
#pragma unroll
        for (int ai = 0; ai < 2; ++ai)
#pragma unroll
            for (int m = 0; m < 4; ++m) {
                const int row = row0 + ai * 128 + m * 16;
                const float rs = rsqrtf(ssq_sum<16>(ssqx + (size_t)row * 16) * (1.0f / DM) + EPS);
                bf16_t* rowp = O + (size_t)row * NPROJ + col0;
#pragma unroll
                for (int bj = 0; bj < 2; ++bj) {
                    f32x4 v0 = acc[ai][bj][m][0] * rs, v1 = acc[ai][bj][m][1] * rs;
                    if (u.pn == 6 || (u.pn == 7 && bj == 0)) {
                        float s = (v0[0] * v0[0] + v0[1] * v0[1]) + (v0[2] * v0[2] + v0[3] * v0[3]) + (v1[0] * v1[0] + v1[1] * v1[1]) + (v1[2] * v1[2] + v1[3] * v1[3]);
                        s += __shfl_xor(s, 16); s += __shfl_xor(s, 32);
                        if (fq == 0) { if (u.pn == 6) ssqq[(size_t)row * 8 + bj * 4 + wc] = s; else ssqkv[(size_t)row * 4 + wc] = s; }
                    }
                    if (u.pn == 7 && bj == 1 && wc == 0) { const int pos = row & (SEQ - 1); rope8(v0, v1, cost + pos * 16, sint + pos * 16, fq); }
                    u32x4 w; w.x = cvtpk(v0[0], v0[1]); w.y = cvtpk(v0[2], v0[3]); w.z = cvtpk(v1[0], v1[1]); w.w = cvtpk(v1[2], v1[3]);
                    *(u32x4*)(rowp + bj * 128) = w;
                }
                asm volatile("" ::: "memory");
            }
    }
};
template <bool ROPE, int NS> struct EpiMla {
    static constexpr bool PERM = true;
    bf16_t* O; int ldc; const float* ssq; float inv_n; const float* cost; const float* sint;
    __device__ __forceinline__ void operator()(AccRef acc, const Unit& u, int wr, int wc, int fr, int fq) const {
        const int row0 = u.pm * 256 + wr * 64 + fr, col0 = u.pn * 256 + wc * 32 + 8 * fq;
#pragma unroll
        for (int ai = 0; ai < 2; ++ai)
#pragma unroll
            for (int m = 0; m < 4; ++m) {
                const int row = row0 + ai * 128 + m * 16;
                const float rs = rsqrtf(ssq_sum<NS>(ssq + (size_t)row * NS) * inv_n + EPS);
                bf16_t* rowp = O + (size_t)row * ldc + col0;
#pragma unroll
                for (int bj = 0; bj < 2; ++bj) {
                    f32x4 v0 = acc[ai][bj][m][0] * rs, v1 = acc[ai][bj][m][1] * rs;
                    if (ROPE) { const int g32 = u.pn * 8 + bj * 4 + wc; if (g32 % 3 == 2) { const int pos = row & (SEQ - 1); rope8(v0, v1, cost + pos * 16, sint + pos * 16, fq); } }
                    u32x4 w; w.x = cvtpk(v0[0], v0[1]); w.y = cvtpk(v0[2], v0[3]); w.z = cvtpk(v1[0], v1[1]); w.w = cvtpk(v1[2], v1[3]);
                    *(u32x4*)(rowp + bj * 128) = w;
                }
                asm volatile("" ::: "memory");
            }
    }
};
struct EpiResid {
    static constexpr bool PERM = true;
    bf16_t* XB; float* ssq;
    __device__ __forceinline__ void operator()(AccRef acc, const Unit& u, int wr, int wc, int fr, int fq) const {
        const int row0 = u.pm * 256 + wr * 64 + fr, col0 = u.pn * 256 + wc * 32 + 8 * fq;
#pragma unroll
        for (int ai = 0; ai < 2; ++ai)
#pragma unroll
            for (int m = 0; m < 4; ++m) {
                const int row = row0 + ai * 128 + m * 16; bf16_t* rowp = XB + (size_t)row * DM + col0; float s = 0.f;
#pragma unroll
                for (int bj = 0; bj < 2; ++bj) {
                    const u32x4 xo = *(const u32x4*)(rowp + bj * 128);
                    float v[8];
#pragma unroll
                    for (int k = 0; k < 4; ++k) { v[2 * k] = __uint_as_float(xo[k] << 16) + acc[ai][bj][m][k >> 1][(2 * k) & 3]; v[2 * k + 1] = __uint_as_float(xo[k] & 0xffff0000u) + acc[ai][bj][m][k >> 1][(2 * k + 1) & 3]; }
#pragma unroll
                    for (int k = 0; k < 8; ++k) s += v[k] * v[k];
                    u32x4 w; w.x = cvtpk(v[0], v[1]); w.y = cvtpk(v[2], v[3]); w.z = cvtpk(v[4], v[5]); w.w = cvtpk(v[6], v[7]);
                    *(u32x4*)(rowp + bj * 128) = w;
                }
                s += __shfl_xor(s, 16); s += __shfl_xor(s, 32);
                if (fq == 0) ssq[(size_t)row * 16 + u.pn * 4 + wc] = s;
                asm volatile("" ::: "memory");
            }
    }
};
template <int CTRL> __device__ __forceinline__ float dpp_rot(float v) { return __int_as_float(__builtin_amdgcn_update_dpp(__float_as_int(v), __float_as_int(v), CTRL, 0xf, 0xf, false)); }
struct EpiUp {
    static constexpr bool PERM = true;
    bf16_t* ACT; bf16_t* UB; const float* ssqx; const float* cw; const float* cb;
    __device__ __forceinline__ void operator()(AccRef acc, const Unit& u, int wr, int wc, int fr, int fq) const {
        const int row0 = u.pm * 256 + wr * 64 + fr, gcol = u.pn * 128 + wc * 32 + 8 * fq;
#pragma unroll
        for (int ai = 0; ai < 2; ++ai) {
#pragma unroll
            for (int m = 0; m < 4; ++m) {
                const float rs = rsqrtf(ssq_sum<16>(ssqx + (size_t)(row0 + ai * 128 + m * 16) * 16) * (1.0f / DM) + EPS);
#pragma unroll
                for (int bj = 0; bj < 2; ++bj) { acc[ai][bj][m][0] = acc[ai][bj][m][0] * rs; acc[ai][bj][m][1] = acc[ai][bj][m][1] * rs; }
            }
            asm volatile("" ::: "memory");
            const int chunk = u.pm * 4 + ai * 2 + wr;
#pragma unroll
            for (int e = 0; e < 2; ++e) {
                const int m = e ? 3 : 0;
                const bool mine = e ? (fr >= 14) : (fr <= 1);
                const int slot = e ? (fr - 12) : fr;
                if (mine) {
#pragma unroll
                    for (int bj = 0; bj < 2; ++bj) {
                        const f32x4 v0 = acc[ai][bj][m][0], v1 = acc[ai][bj][m][1];
                        u32x4 w; w.x = cvtpk(v0[0], v0[1]); w.y = cvtpk(v0[2], v0[3]); w.z = cvtpk(v1[0], v1[1]); w.w = cvtpk(v1[2], v1[3]);
                        *(u32x4*)(UB + ((size_t)chunk * 4 + slot) * NUP + bj * DFF + gcol) = w;
                    }
                }
            }
            asm volatile("" ::: "memory");
#pragma unroll
            for (int n = 0; n < 2; ++n) {
                unsigned wpk[4][2]; float rlo[4];
#pragma unroll
                for (int i = 0; i < 4; ++i) {
                    const int cg_ = gcol + 4 * n + i, cv_ = cg_ + DFF;
                    const float g0 = cw[cg_], g1 = cw[NUP + cg_], g2 = cw[2 * NUP + cg_], gb = cb[cg_];
                    const float h0 = cw[cv_], h1 = cw[NUP + cv_], h2 = cw[2 * NUP + cv_], hb = cb[cv_];
                    float gt[4];
                    {
                        float pg[4], ng[4];
#pragma unroll
                        for (int m = 0; m < 4; ++m) { pg[m] = dpp_rot<0x121>(acc[ai][0][m][n][i]); ng[m] = dpp_rot<0x12F>(acc[ai][0][m][n][i]); }
#pragma unroll
                        for (int m = 0; m < 4; ++m) {
                            const float gp = (fr == 0) ? (m ? pg[m - 1] : 0.f) : pg[m], gn = (fr == 15) ? (m < 3 ? ng[m + 1] : 0.f) : ng[m];
                            const float t = g0 * gp + g1 * acc[ai][0][m][n][i] + g2 * gn + gb;
                            gt[m] = t * fast_rcp(1.f + fast_exp2(-LOG2E * t));
                        }
                    }
                    asm volatile("" : "+v"(gt[0]), "+v"(gt[1]), "+v"(gt[2]), "+v"(gt[3]));
                    {
                        float pv[4], nv[4];
#pragma unroll
                        for (int m = 0; m < 4; ++m) { pv[m] = dpp_rot<0x121>(acc[ai][1][m][n][i]); nv[m] = dpp_rot<0x12F>(acc[ai][1][m][n][i]); }
#pragma unroll
                        for (int m = 0; m < 4; ++m) {
                            const float vp = (fr == 0) ? (m ? pv[m - 1] : 0.f) : pv[m], vn = (fr == 15) ? (m < 3 ? nv[m + 1] : 0.f) : nv[m];
                            const float vl = h0 * vp + h1 * acc[ai][1][m][n][i] + h2 * vn + hb;
                            const float rv = gt[m] * vl;
                            if (i & 1) wpk[m][i >> 1] = cvtpk(rlo[m], rv); else rlo[m] = rv;
                        }
                    }
                    asm volatile("" ::: "memory");
                }
#pragma unroll
                for (int m = 0; m < 4; ++m) { u32x2 w; w.x = wpk[m][0]; w.y = wpk[m][1];
                    *(u32x2*)(ACT + (size_t)(row0 + ai * 128 + m * 16) * DFF + gcol + 4 * n) = w; }
                asm volatile("" ::: "memory");
            }
        }
    }
};

constexpr int AT_BUF = 20480, AT_V = 12288, AT_TAB = 3 * AT_BUF;
__device__ __forceinline__ float xmax(float a) { auto rr = __builtin_amdgcn_permlane32_swap(__float_as_uint(a), __float_as_uint(a), false, false); return fmaxf(__uint_as_float(rr[0]), __uint_as_float(rr[1])); }
__device__ __forceinline__ float xsum(float a) { auto rr = __builtin_amdgcn_permlane32_swap(__float_as_uint(a), __float_as_uint(a), false, false); return __uint_as_float(rr[0]) + __uint_as_float(rr[1]); }
typedef short v4i16_t __attribute__((ext_vector_type(4)));
__device__ __forceinline__ s16x4 vtr(const LAS unsigned char* p) { return __builtin_bit_cast(s16x4, __builtin_amdgcn_ds_read_tr16_b64_v4i16((LAS v4i16_t*)p)); }

template <int MODE>
__device__ __forceinline__ void attn_unit(LAS unsigned char* lds, const Params& P, int layer, int b, int h, int qb) {
    constexpr int NMAP = (MODE == 1) ? 2 : 1, ND0 = (MODE == 0) ? 6 : (MODE == 1 ? 2 : 4);
    int tid = threadIdx.x; asm volatile("" : "+v"(tid));
    const int lane = tid & 63, r32 = lane & 31, hi = lane >> 5, wave = __builtin_amdgcn_readfirstlane(tid >> 6);
    const bf16_t* proj = (const bf16_t*)(P.ws + WS_PROJ); const bf16_t* cq = (const bf16_t*)(P.ws + WS_CQ); const bf16_t* ckv = (const bf16_t*)(P.ws + WS_CKV);
    bf16_t* mix = (bf16_t*)(P.ws + WS_MIX);
    const size_t rowbase = (size_t)b * SEQ; const int q0 = qb * 256;
    const bf16_t *Qp, *Kp, *Vp; int qpitch, kpitch, vpitch, ocol; float c;
    if (MODE == 0) { Qp = cq + h * 96; qpitch = NCQ; Kp = ckv + h * 128; kpitch = NCKV; Vp = ckv + h * 128 + 64; vpitch = NCKV; ocol = 512 + h * 64; c = 0.10206207261596577f * LOG2E; }
    else if (MODE == 1) { Qp = proj + h * 64; qpitch = NPROJ; Kp = proj + 256 + h * 64; kpitch = NPROJ; Vp = proj + 512 + h * 64; vpitch = NPROJ; ocol = h * 64; c = 0.17677669529663687f * LOG2E; }
    else { Qp = proj + 768 + h * 64; qpitch = NPROJ; Kp = proj + 1024 + h * 64; kpitch = NPROJ; Vp = proj + 1280 + h * 64; vpitch = NPROJ; ocol = 256 + h * 64; c = 0.125f * LOG2E; }
    int kt0 = 0, kt1 = SEQ / 64;
    if (MODE == 2) { kt0 = (q0 - 1024) / 64; if (kt0 < 0) kt0 = 0; kt1 = (q0 + 256 + 1024) / 64; if (kt1 > SEQ / 64) kt1 = SEQ / 64; }
    LAS float* tab = (LAS float*)(lds + AT_TAB);
    if (MODE != 0) {
        const float slope = (MODE == 1) ? exp2f(-(float)(2 * h + 1)) : exp2f(-(float)(2 * h + 2));
        for (int j = tid; j < 4096; j += 512) {
            const int d = (j > 2047) ? (j - 2047) : (2047 - j);
            float v = -slope * LOG2E * (float)d;
            if (MODE == 2) {
                const int mult = (d <= 64 ? 1 : 0) + (((d & 3) == 0 && d <= 256) ? 1 : 0) + (((d & 15) == 0 && d <= 1024) ? 1 : 0);
                v = (mult == 0) ? -1e30f : (mult == 1 ? v : (mult == 2 ? v + 1.0f : v + 1.5849625007211562f));
            }
            tab[j] = v;
        }
    }
    const int qpos = q0 + wave * 32 + r32;
    bf16x8 qf[NMAP][ND0];
    {
        const bf16_t* qrow = Qp + (rowbase + qpos) * qpitch + hi * 8;
#pragma unroll
        for (int mp = 0; mp < NMAP; ++mp)
#pragma unroll
            for (int d0 = 0; d0 < ND0; ++d0) qf[mp][d0] = *(const bf16x8*)(qrow + mp * 32 + d0 * 16);
    }
    u32x4 kreg, kreg2 = (u32x4){0u, 0u, 0u, 0u}, vreg;
#define AT_GLOAD(kt) do { const size_t r_ = rowbase + (size_t)(kt) * 64; \
        kreg = *(const u32x4*)(Kp + (r_ + lane) * kpitch + wave * 8); \
        if (MODE == 0 && wave < 4) kreg2 = *(const u32x4*)(proj + (r_ + lane) * NPROJ + 1920 + wave * 8); \
        vreg = *(const u32x4*)(Vp + (r_ + 16 * (wave & 3) + (lane >> 2)) * vpitch + (wave >> 2) * 32 + (lane & 3) * 8); } while (0)
#define AT_LSTORE(buf) do { LAS unsigned char* d_ = lds + (buf) * AT_BUF; \
        *(LAS u32x4*)(d_ + wave * 1024 + lane * 16) = kreg; \
        if (MODE == 0 && wave < 4) *(LAS u32x4*)(d_ + (8 + wave) * 1024 + lane * 16) = kreg2; \
        *(LAS u32x4*)(d_ + AT_V + wave * 1024 + lane * 16) = vreg; } while (0)
    float mrun[NMAP], lrun[NMAP]; f32x16 o[NMAP][2];
#pragma unroll
    for (int mp = 0; mp < NMAP; ++mp) { mrun[mp] = -1e20f; lrun[mp] = 0.f; o[mp][0] = f32x16{}; o[mp][1] = f32x16{}; }
    constexpr int NK = NMAP * ND0;
    bf16x8 kf[NK]; s16x4 vlo[4], vhi[4];
#define AT_KLOAD(bufbase, hf) do { _Pragma("unroll") for (int j_ = 0; j_ < NK; ++j_) kf[j_] = *(const LAS bf16x8*)((bufbase) + (2 * j_ + hi) * 1024 + (hf) * 512 + r32 * 16); } while (0)
#define AT_VLOAD(bufbase, hf) do { _Pragma("unroll") for (int dv_ = 0; dv_ < 2; ++dv_) _Pragma("unroll") for (int k2_ = 0; k2_ < 2; ++k2_) { \
        vlo[dv_ * 2 + k2_] = vtr((bufbase) + AT_V + vlane + dv_ * 4096 + (2 * (hf) + k2_) * 1024); vhi[dv_ * 2 + k2_] = vtr((bufbase) + AT_V + vlane + dv_ * 4096 + (2 * (hf) + k2_) * 1024 + 512); } } while (0)
    const int vlane = ((lane >> 4) & 1) * 32 + (lane & 3) * 8 + (4 * hi + ((lane & 15) >> 2)) * 64;
    AT_GLOAD(kt0); AT_LSTORE(0);
    if (kt0 + 1 < kt1) { AT_GLOAD(kt0 + 1); AT_LSTORE(1); }
    __syncthreads();
    AT_KLOAD(lds, 0);
    int bcur = 0;
    for (int kt = kt0; kt < kt1; ++kt) {
        const int bnx = (bcur == 2) ? 0 : bcur + 1, bn2 = (bnx == 2) ? 0 : bnx + 1;
        const LAS unsigned char* cur = lds + bcur * AT_BUF;
        const LAS unsigned char* nxt = lds + bnx * AT_BUF;
        if (kt + 2 < kt1) AT_GLOAD(kt + 2);
#pragma unroll
        for (int hf = 0; hf < 2; ++hf) {
            f32x16 sc[NMAP];
#pragma unroll
            for (int mp = 0; mp < NMAP; ++mp) {
                sc[mp] = f32x16{};
#pragma unroll
                for (int d0 = 0; d0 < ND0; ++d0) sc[mp] = __builtin_amdgcn_mfma_f32_32x32x16_bf16(kf[mp * ND0 + d0], qf[mp][d0], sc[mp], 0, 0, 0);
            }
            __builtin_amdgcn_sched_barrier(0);
            AT_VLOAD(cur, hf);
            if (hf == 0) AT_KLOAD(cur, 1); else if (kt + 1 < kt1) AT_KLOAD(nxt, 0);
            __builtin_amdgcn_sched_barrier(0);
            bf16x8 pw[NMAP][2];
#pragma unroll
            for (int mp = 0; mp < NMAP; ++mp) {
                f32x16& s0 = sc[mp];
                float mn;
                if (MODE != 0) {
                    if (mp) asm volatile("" ::: "memory");
                    const LAS float* tp = tab + (kt * 64 + hf * 32 + 4 * hi - qpos + 2047);
                    float rm = -3e38f;
#pragma unroll
                    for (int r = 0; r < 16; ++r) { s0[r] = s0[r] * c + tp[(r & 3) + 8 * (r >> 2)]; rm = fmaxf(rm, s0[r]); }
                    rm = xmax(rm);
                    mn = fmaxf(mrun[mp], rm);
                } else {
                    float rm = -3e38f;
#pragma unroll
                    for (int r = 0; r < 16; ++r) rm = fmaxf(rm, s0[r]);
                    rm = xmax(rm);
                    mn = fmaxf(mrun[mp], rm * c);
                }
                if (__any(mn > mrun[mp])) {
                    const float al = fast_exp2(mrun[mp] - mn); lrun[mp] *= al;
#pragma unroll
                    for (int r = 0; r < 16; ++r) { o[mp][0][r] *= al; o[mp][1][r] *= al; }
                    mrun[mp] = mn;
                }
                float ls = 0.f;
                if (MODE != 0) {
#pragma unroll
                    for (int r = 0; r < 16; ++r) { s0[r] = fast_exp2(s0[r] - mn); ls += s0[r]; }
                } else {
                    const float nm = -mn;
#pragma unroll
                    for (int r = 0; r < 16; ++r) { s0[r] = fast_exp2(__builtin_fmaf(s0[r], c, nm)); ls += s0[r]; }
                }
                lrun[mp] += ls;
                u32x4 w;
                w.x = cvtpk(s0[0], s0[1]); w.y = cvtpk(s0[2], s0[3]); w.z = cvtpk(s0[4], s0[5]); w.w = cvtpk(s0[6], s0[7]); pw[mp][0] = __builtin_bit_cast(bf16x8, w);
                w.x = cvtpk(s0[8], s0[9]); w.y = cvtpk(s0[10], s0[11]); w.z = cvtpk(s0[12], s0[13]); w.w = cvtpk(s0[14], s0[15]); pw[mp][1] = __builtin_bit_cast(bf16x8, w);
            }
#pragma unroll
            for (int dv = 0; dv < 2; ++dv)
#pragma unroll
                for (int k2 = 0; k2 < 2; ++k2) {
                    const s16x4 lo = vlo[dv * 2 + k2], hh = vhi[dv * 2 + k2];
                    const bf16x8 vf = (bf16x8){lo[0], lo[1], lo[2], lo[3], hh[0], hh[1], hh[2], hh[3]};
#pragma unroll
                    for (int mp = 0; mp < NMAP; ++mp) o[mp][dv] = __builtin_amdgcn_mfma_f32_32x32x16_bf16(vf, pw[mp][k2], o[mp][dv], 0, 0, 0);
                }
        }
        if (kt + 2 < kt1) AT_LSTORE(bn2);
        __syncthreads();
        bcur = bnx;
    }
#undef AT_KLOAD
#undef AT_VLOAD
#undef AT_GLOAD
#undef AT_LSTORE
    bf16_t* orow = mix + (rowbase + qpos) * DM + ocol + 4 * hi;
    if (MODE != 1) {
        const float inv = 1.f / xsum(lrun[0]);
#pragma unroll
        for (int d = 0; d < 2; ++d)
#pragma unroll
            for (int g = 0; g < 4; ++g) {
                u32x2 w; w.x = cvtpk(o[0][d][4 * g] * inv, o[0][d][4 * g + 1] * inv); w.y = cvtpk(o[0][d][4 * g + 2] * inv, o[0][d][4 * g + 3] * inv);
                *(u32x2*)(orow + 32 * d + 8 * g) = w;
            }
    } else {
        const float lam = __hip_atomic_load((const float*)(P.ws + WS_LAM) + layer, __ATOMIC_RELAXED, __HIP_MEMORY_SCOPE_AGENT);
        const float lam_init = 0.8f - 0.6f * expf(-0.3f * (float)layer);
        const float i1 = 1.f / xsum(lrun[0]), i2 = lam / xsum(lrun[NMAP - 1]);
        float ss = 0.f;
#pragma unroll
        for (int d = 0; d < 2; ++d)
#pragma unroll
            for (int r = 0; r < 16; ++r) { const float v = o[0][d][r] * i1 - o[NMAP - 1][d][r] * i2; o[0][d][r] = v; ss += v * v; }
        ss = xsum(ss);
        const float sc = rsqrtf(ss * (1.0f / 64.0f) + EPS) * (1.f - lam_init);
        const float* gn = P.a_subln + layer * 64 + 4 * hi;
#pragma unroll
        for (int d = 0; d < 2; ++d)
#pragma unroll
            for (int g = 0; g < 4; ++g) {
                const f32x4 gv = *(const f32x4*)(gn + 32 * d + 8 * g);
                u32x2 w; w.x = cvtpk(o[0][d][4 * g] * sc * gv[0], o[0][d][4 * g + 1] * sc * gv[1]); w.y = cvtpk(o[0][d][4 * g + 2] * sc * gv[2], o[0][d][4 * g + 3] * sc * gv[3]);
                *(u32x2*)(orow + 32 * d + 8 * g) = w;
            }
    }
}

__device__ __forceinline__ void transpose_item(const float* W, int K, int Nsrc, const float* g, bf16_t* WT, int n0_dst, int n0_src, int k0, LAS float* scr, int lane) {
#pragma unroll 8
    for (int i = 0; i < 32; ++i) { const int kk = 2 * i + (lane >> 5);
        float v = 0.f; if (n0_src >= 0) { v = W[(size_t)(k0 + kk) * Nsrc + n0_src + (lane & 31)]; if (g) v *= g[k0 + kk]; }
        scr[kk * 33 + (lane & 31)] = v; }
    asm volatile("s_waitcnt lgkmcnt(0)" ::: "memory");
    const int c = lane & 7;
#pragma unroll
    for (int j = 0; j < 4; ++j) { const int n = (lane >> 3) + 8 * j; const LAS float* s = scr + (8 * c) * 33 + n;
        u32x4 o; o.x = cvtpk(s[0 * 33], s[1 * 33]); o.y = cvtpk(s[2 * 33], s[3 * 33]); o.z = cvtpk(s[4 * 33], s[5 * 33]); o.w = cvtpk(s[6 * 33], s[7 * 33]);
        *(u32x4*)(WT + (size_t)(n0_dst + n) * K + k0 + 8 * c) = o; }
    asm volatile("s_waitcnt lgkmcnt(0)" ::: "memory");
}

__device__ __forceinline__ void zero_f32(float* p, int n) { for (int i = blockIdx.x * 512 + threadIdx.x; i < n; i += gridDim.x * 512) p[i] = 0.f; }

__device__ __forceinline__ void prologue(const Params& P, LAS unsigned char* lds) {
    const int tid = threadIdx.x, lane = tid & 63, wave = tid >> 6;
    const int gw = blockIdx.x * 8 + wave, NGW = gridDim.x * 8;
    LAS float* scr = (LAS float*)(lds + wave * 16384);
    constexpr int I_IN = 16 * 64, I_OUT = 16 * 32, I_UP = 16 * 176, I_DN = 44 * 32, I_UQ = 4 * 24, I_UKV = 2 * 32, I_L = I_IN + I_OUT + I_UP + I_DN + I_UQ + I_UKV;
    for (int it = gw; it < I_L * DEPTH; it += NGW) {
        const int l = it / I_L; int r = it % I_L;
        unsigned char* wl = P.ws + WS_W + (size_t)l * W_LAYER;
        if (r < I_IN) { const int kb = r / 64, nb = r % 64; transpose_item(P.w_in + (size_t)l * DM * NIN, DM, NIN, P.g_attn + l * DM, (bf16_t*)(wl + W_IN), nb * 32, nb < 61 ? nb * 32 : -1, kb * 64, scr, lane); continue; } r -= I_IN;
        if (r < I_OUT) { const int kb = r / 32, nb = r % 32; transpose_item(P.w_out + (size_t)l * DM * DM, DM, DM, nullptr, (bf16_t*)(wl + W_OUT), nb * 32, nb * 32, kb * 64, scr, lane); continue; } r -= I_OUT;
        if (r < I_UP) { const int kb = r / 176, nb = r % 176; const int nd = nb * 32, pn = nd >> 8, wi = nd & 255, src = (wi >> 7) * DFF + pn * 128 + (wi & 127);
            transpose_item(P.w_up + (size_t)l * DM * NUP, DM, NUP, P.g_ffn + l * DM, (bf16_t*)(wl + W_UP), nd, src, kb * 64, scr, lane); continue; } r -= I_UP;
        if (r < I_DN) { const int kb = r / 32, nb = r % 32; transpose_item(P.w_down + (size_t)l * DFF * DM, DFF, DM, nullptr, (bf16_t*)(wl + W_DOWN), nb * 32, nb * 32, kb * 64, scr, lane); continue; } r -= I_DN;
        if (r < I_UQ) { const int kb = r / 24, nb = r % 24; transpose_item(P.c_w_uq + (size_t)l * 256 * NCQ, 256, NCQ, P.c_g_q + l * 256, (bf16_t*)(wl + W_UQ), nb * 32, nb * 32, kb * 64, scr, lane); continue; } r -= I_UQ;
        { const int kb = r / 32, nb = r % 32; transpose_item(P.c_w_ukv + (size_t)l * 128 * NCKV, 128, NCKV, P.c_g_kv + l * 128, (bf16_t*)(wl + W_UKV), nb * 32, nb * 32, kb * 64, scr, lane); }
    }
    float* ssqA = (float*)(P.ws + WS_SSQA); bf16_t* xb = (bf16_t*)(P.ws + WS_XB);
    for (int m = gw; m < T_TOK; m += NGW) {
        const f32x4* xr = (const f32x4*)(P.x + (size_t)m * DM) + lane; u32x2* brow = (u32x2*)(xb + (size_t)m * DM) + lane;
        float s = 0.f;
#pragma unroll
        for (int j = 0; j < 4; ++j) { const f32x4 v = xr[64 * j]; u32x2 w; w.x = cvtpk(v[0], v[1]); w.y = cvtpk(v[2], v[3]); brow[64 * j] = w; s += (v[0] * v[0] + v[1] * v[1]) + (v[2] * v[2] + v[3] * v[3]); }
        s = wave_sum(s);
        if (lane < 16) ssqA[(size_t)m * 16 + lane] = lane ? 0.f : s;
    }
    float* cost = (float*)(P.ws + WS_COS); float* sint = (float*)(P.ws + WS_SIN);
    for (int i = blockIdx.x * 512 + tid; i < SEQ * 16; i += gridDim.x * 512) {
        const int pos = i >> 4, j = i & 15; const float inv = exp2f(-(float)j * (13.287712379549449f / 16.0f)); const float ang = (float)pos * inv;
        cost[i] = cosf(ang); sint[i] = sinf(ang);
    }
    if (blockIdx.x == 0 && tid < DEPTH) {
        float d1 = 0.f, d2 = 0.f;
        for (int j = 0; j < 32; ++j) { d1 += P.a_lq1[tid * 32 + j] * P.a_lk1[tid * 32 + j]; d2 += P.a_lq2[tid * 32 + j] * P.a_lk2[tid * 32 + j]; }
        ((float*)(P.ws + WS_LAM))[tid] = expf(d1) - expf(d2) + (0.8f - 0.6f * expf(-0.3f * (float)tid));
    }
}

__device__ __forceinline__ void ffn_fixup(const Params& P, int layer) {
    const bf16_t* UB = (const bf16_t*)(P.ws + WS_UBND); bf16_t* ACT = (bf16_t*)(P.ws + WS_ACT);
    const float* cw = P.conv_w + (size_t)layer * 3 * NUP; const float* cb = P.conv_b + (size_t)layer * NUP;
    constexpr int CG = DFF / 8;
    for (int it = blockIdx.x * 512 + threadIdx.x; it < 512 * 2 * CG; it += gridDim.x * 512) {
        const int cgi = it % CG, e = (it / CG) & 1, chunk = it / (2 * CG), col = cgi * 8;
        const bf16_t *up, *mid, *dn; bool zu = false, zd = false;
        if (e == 0) { zu = (chunk % 32) == 0; up = UB + ((size_t)(zu ? chunk : chunk - 1) * 4 + 3) * NUP; mid = UB + ((size_t)chunk * 4 + 0) * NUP; dn = UB + ((size_t)chunk * 4 + 1) * NUP; }
        else { zd = (chunk % 32) == 31; up = UB + ((size_t)chunk * 4 + 2) * NUP; mid = UB + ((size_t)chunk * 4 + 3) * NUP; dn = UB + ((size_t)(zd ? chunk : chunk + 1) * 4 + 0) * NUP; }
        const float fu = zu ? 0.f : 1.f, fd = zd ? 0.f : 1.f;
        float res[8];
        bf16_t ug[8], mg[8], dg[8], uv[8], mv[8], dv[8];
        *(u32x4*)ug = *(const u32x4*)(up + col); *(u32x4*)mg = *(const u32x4*)(mid + col); *(u32x4*)dg = *(const u32x4*)(dn + col);
        *(u32x4*)uv = *(const u32x4*)(up + DFF + col); *(u32x4*)mv = *(const u32x4*)(mid + DFF + col); *(u32x4*)dv = *(const u32x4*)(dn + DFF + col);
#pragma unroll
        for (int k = 0; k < 8; ++k) {
            const int cg_ = col + k, cv_ = DFF + col + k;
            const float gt = cw[cg_] * bf2f(ug[k]) * fu + cw[NUP + cg_] * bf2f(mg[k]) + cw[2 * NUP + cg_] * bf2f(dg[k]) * fd + cb[cg_];
            const float vl = cw[cv_] * bf2f(uv[k]) * fu + cw[NUP + cv_] * bf2f(mv[k]) + cw[2 * NUP + cv_] * bf2f(dv[k]) * fd + cb[cv_];
            res[k] = gt * fast_rcp(1.f + fast_exp2(-LOG2E * gt)) * vl;
        }
        u32x4 w; w.x = cvtpk(res[0], res[1]); w.y = cvtpk(res[2], res[3]); w.z = cvtpk(res[4], res[5]); w.w = cvtpk(res[6], res[7]);
        *(u32x4*)(ACT + (size_t)(chunk * 64 + (e ? 63 : 0)) * DFF + col) = w;
    }
}


#define XB_TMO      128
#define XB_XCNT(j)  (256  + 64 * (j))
#define XB_XSUB(j)  (1280 + 64 * (j))
#define XB_XGEN(j)  (2304 + 64 * (j))
#define XB_TOP      3328
#define XB_TOPGEN   3392
#define XCD_BAR_WORDS 3456
#define XB_SPIN_CAP (1u << 22)
__device__ __forceinline__ unsigned xb_ld(unsigned* p)              { return __hip_atomic_load(p, __ATOMIC_RELAXED, __HIP_MEMORY_SCOPE_AGENT); }
__device__ __forceinline__ unsigned xb_add(unsigned* p, unsigned v) { return __hip_atomic_fetch_add(p, v, __ATOMIC_RELAXED, __HIP_MEMORY_SCOPE_AGENT); }
__device__ __forceinline__ unsigned xb_xcc_id() { return (unsigned)__builtin_amdgcn_s_getreg((3 << 11) | 20) & 0xFu; }
#define XB_SPIN(cond, bar) do { unsigned _sp = 0; while (cond) { __builtin_amdgcn_s_sleep(1); \
    if ((++_sp & 255u) == 0u) { if (xb_ld(&(bar)[XB_TMO])) break; if (_sp > XB_SPIN_CAP) { atomicAdd(&(bar)[XB_TMO], 1u); break; } } } } while (0)
struct XcdBarrier { unsigned* bar; unsigned x; volatile LAS unsigned* st; };
__device__ __forceinline__ XcdBarrier xcd_barrier_post(unsigned* bar, volatile LAS unsigned* st) {
    XcdBarrier b; b.bar = bar; b.x = xb_xcc_id(); b.st = st;
    if (threadIdx.x == 0) (void)xb_add(&bar[XB_XCNT(b.x)], 1u);
    return b;
}
__device__ __forceinline__ void xcd_barrier_complete(unsigned* bar, unsigned x, unsigned& nloc, unsigned& nx) {
    const unsigned G = gridDim.x * gridDim.y * gridDim.z;
    unsigned sum, cnt, mine, sp = 0u;
    for (;;) {
        sum = 0u; cnt = 0u; mine = 0u;
#pragma unroll
        for (unsigned j = 0; j < 16; ++j) { const unsigned c = xb_ld(&bar[XB_XCNT(j)]); sum += c; cnt += (c > 0u) ? 1u : 0u; mine = (j == x) ? c : mine; }
        if (sum == G) break;
        __builtin_amdgcn_s_sleep(1);
        if ((++sp & 255u) == 0u) { if (xb_ld(&bar[XB_TMO])) break; if (sp > XB_SPIN_CAP) { atomicAdd(&bar[XB_TMO], 1u); break; } }
    }
    nloc = mine > 0u ? mine : 1u; nx = cnt > 0u ? cnt : 1u;
}
__device__ __forceinline__ void xcd_barrier(const XcdBarrier& b) {
    asm volatile("s_waitcnt vmcnt(0)" ::: "memory");
    __syncthreads();
    if (threadIdx.x == 0) {
        unsigned* bar = b.bar;
        __builtin_amdgcn_s_waitcnt(0);
        unsigned nloc = b.st[0], nx = b.st[1];
        if (nloc == 0u) { xcd_barrier_complete(bar, b.x, nloc, nx); b.st[0] = nloc; b.st[1] = nx; }
        const unsigned old = xb_add(&bar[XB_XSUB(b.x)], 1u);
        const unsigned gen = old / nloc;
        if (old + 1u == (gen + 1u) * nloc) {
            __builtin_amdgcn_fence(__ATOMIC_RELEASE, "agent");
            asm volatile("s_waitcnt vmcnt(0)" ::: "memory");
            const unsigned og = xb_add(&bar[XB_TOP], 1u);
            const unsigned tg = og / nx;
            if (og + 1u == (tg + 1u) * nx) xb_add(&bar[XB_TOPGEN], 1u);
            else XB_SPIN(xb_ld(&bar[XB_TOPGEN]) == tg, bar);
            __builtin_amdgcn_fence(__ATOMIC_ACQUIRE, "agent");
            xb_add(&bar[XB_XGEN(b.x)], 1u);
            asm volatile("s_waitcnt vmcnt(0)" ::: "memory");
        } else {
            XB_SPIN(xb_ld(&bar[XB_XGEN(b.x)]) == gen, bar);
            __builtin_amdgcn_fence(__ATOMIC_ACQUIRE, "agent");
            asm volatile("s_waitcnt vmcnt(0)" ::: "memory");
        }
    }
    __syncthreads();
}

__global__ void __launch_bounds__(512, 2) fwd_megakernel(Params P) {
    extern __shared__ __attribute__((aligned(16))) unsigned char lds_raw[];
    LAS unsigned char* lds = (LAS unsigned char*)lds_raw;
    cg::grid_group grid = cg::this_grid();
#define GRID_SYNC() do { asm volatile("s_waitcnt vmcnt(0) lgkmcnt(0)" ::: "memory"); __syncthreads(); grid.sync(); \
        __builtin_amdgcn_fence(__ATOMIC_ACQUIRE, "agent"); asm volatile("s_waitcnt vmcnt(0)" ::: "memory"); GRID_SYNC2(); } while (0)
#if MK_DUP_SYNC > 1
#define GRID_SYNC2() do { grid.sync(); __builtin_amdgcn_fence(__ATOMIC_ACQUIRE, "agent"); asm volatile("s_waitcnt vmcnt(0)" ::: "memory"); } while (0)
#else
#define GRID_SYNC2() do {} while (0)
#endif
    unsigned char* ws = P.ws;
    float* ssqA = (float*)(ws + WS_SSQA); float* ssqB = (float*)(ws + WS_SSQB); float* ssqQ = (float*)(ws + WS_SSQQ); float* ssqKV = (float*)(ws + WS_SSQKV);
    const float* cost = (const float*)(ws + WS_COS); const float* sint = (const float*)(ws + WS_SIN);
    bf16_t* xb = (bf16_t*)(ws + WS_XB); bf16_t* proj = (bf16_t*)(ws + WS_PROJ); bf16_t* cq = (bf16_t*)(ws + WS_CQ); bf16_t* ckv = (bf16_t*)(ws + WS_CKV);
    bf16_t* mix = (bf16_t*)(ws + WS_MIX); bf16_t* act = (bf16_t*)(ws + WS_ACT); bf16_t* ubnd = (bf16_t*)(ws + WS_UBND);

    volatile LAS unsigned* bst = (volatile LAS unsigned*)(lds + 131072 + 64);
    if (threadIdx.x < 2) bst[threadIdx.x] = 0u;
    __syncthreads();
    const XcdBarrier xbar = xcd_barrier_post((unsigned*)(ws + WS_BAR), bst);
    prologue(P, lds);
#if MK_DUP_PRO > 1
    volatile LAS unsigned* bst = (volatile LAS unsigned*)(lds + 131072 + 64);
    if (threadIdx.x < 2) bst[threadIdx.x] = 0u;
    __syncthreads();
    const XcdBarrier xbar = xcd_barrier_post((unsigned*)(ws + WS_BAR), bst);
    prologue(P, lds);
#endif
    GRID_SYNC();
#if MK_DUP_BAR > 1
#define XBAR() do { xcd_barrier(xbar); xcd_barrier(xbar); } while (0)
#else
#define XBAR() xcd_barrier(xbar)
#endif
    for (int l = 0; l < DEPTH; ++l) {
        const unsigned char* wl = ws + WS_W + (size_t)l * W_LAYER;
#if !(MK_SKIP & 1)
        { pg8::Gemm g{xb, (const bf16_t*)(wl + W_IN), T_TOK, NPROJ, DM, DM}; EpiProj E{proj, ssqA, ssqQ, ssqKV, cost, sint}; pg8::gemm_phase(lds, g, E); }
#if MK_DUP_IN > 1
        { pg8::Gemm g{xb, (const bf16_t*)(wl + W_IN), T_TOK, NPROJ, DM, DM}; EpiProj E{proj, ssqA, ssqQ, ssqKV, cost, sint}; pg8::gemm_phase(lds, g, E); }
#endif
#endif
        XBAR();
#if !(MK_SKIP & 2)
        { pg8::Gemm g{proj + 1536, (const bf16_t*)(wl + W_UQ), T_TOK, NCQ, 256, NPROJ}; EpiMla<true, 8> E{cq, NCQ, ssqQ, 1.0f / 256.0f, cost, sint}; pg8::gemm_phase(lds, g, E); }
        { pg8::Gemm g{proj + 1792, (const bf16_t*)(wl + W_UKV), T_TOK, NCKV, 128, NPROJ}; EpiMla<false, 4> E{ckv, NCKV, ssqKV, 1.0f / 128.0f, cost, sint}; pg8::gemm_phase(lds, g, E); }
#if MK_DUP_MLA > 1
        { pg8::Gemm g{proj + 1536, (const bf16_t*)(wl + W_UQ), T_TOK, NCQ, 256, NPROJ}; EpiMla<true, 8> E{cq, NCQ, ssqQ, 1.0f / 256.0f, cost, sint}; pg8::gemm_phase(lds, g, E); }
        { pg8::Gemm g{proj + 1792, (const bf16_t*)(wl + W_UKV), T_TOK, NCKV, 128, NPROJ}; EpiMla<false, 4> E{ckv, NCKV, ssqKV, 1.0f / 128.0f, cost, sint}; pg8::gemm_phase(lds, g, E); }
#endif
#endif
#if !(MK_SKIP & 4)
        for (int rep_ = 0; rep_ < MK_DUP_AB; ++rep_)
        for (int u = blockIdx.x; u < 1024; u += gridDim.x) {
            if (u < 512) { attn_unit<1>(lds, P, l, u >> 5, (u >> 3) & 3, u & 7); }
            else { const int v = u - 512; int qb = v & 7; if (v >= 256) qb = (qb + 4) & 7; attn_unit<2>(lds, P, l, (v >> 5) & 15, (v >> 3) & 3, qb); }
        }
#endif
        XBAR();
#if !(MK_SKIP & 8)
        for (int rep_ = 0; rep_ < MK_DUP_C; ++rep_)
        for (int u = blockIdx.x; u < 1024; u += gridDim.x) attn_unit<0>(lds, P, l, u >> 6, (u >> 3) & 7, u & 7);
#endif
        XBAR();
#if !(MK_SKIP & 16)
        { pg8::Gemm g{mix, (const bf16_t*)(wl + W_OUT), T_TOK, DM, DM, DM}; EpiResid E{xb, ssqB}; pg8::gemm_phase(lds, g, E); }
#endif
        XBAR();
#if !(MK_SKIP & 32)
        { pg8::Gemm g{xb, (const bf16_t*)(wl + W_UP), T_TOK, NUP, DM, DM}; EpiUp E{act, ubnd, ssqB, P.conv_w + (size_t)l * 3 * NUP, P.conv_b + (size_t)l * NUP}; pg8::gemm_phase(lds, g, E); }
#if MK_DUP_UP > 1
        { pg8::Gemm g{xb, (const bf16_t*)(wl + W_UP), T_TOK, NUP, DM, DM}; EpiUp E{act, ubnd, ssqB, P.conv_w + (size_t)l * 3 * NUP, P.conv_b + (size_t)l * NUP}; pg8::gemm_phase(lds, g, E); }
#endif
#endif
        XBAR();
        ffn_fixup(P, l);
        XBAR();
#if !(MK_SKIP & 64)
        { pg8::Gemm g{act, (const bf16_t*)(wl + W_DOWN), T_TOK, DM, DFF, DFF}; EpiResid E{xb, ssqA}; pg8::gemm_phase(lds, g, E); }
#endif
        XBAR();
    }
    for (int i = blockIdx.x * 512 + threadIdx.x; i < T_TOK * (DM / 4); i += gridDim.x * 512) {
        const int row = i >> 8, c4 = i & 255;
        const float rs = rsqrtf(ssq_sum<16>(ssqA + (size_t)row * 16) * (1.0f / DM) + EPS);
        const u32x2 xv = ((const u32x2*)xb)[i]; const f32x4 gv = ((const f32x4*)P.g_final)[c4];
        f32x4 v; v[0] = __uint_as_float(xv.x << 16); v[1] = __uint_as_float(xv.x & 0xffff0000u); v[2] = __uint_as_float(xv.y << 16); v[3] = __uint_as_float(xv.y & 0xffff0000u);
        ((f32x4*)P.out)[i] = v * rs * gv;
    }
}

extern "C" void kernel_launch(void* const* d_in, const int* in_sizes, int n_in, void* d_out, int out_size, void* d_ws, size_t ws_size, hipStream_t stream) {
    static int grid_blocks = 0;
    if (!grid_blocks) {
        if (n_in != 19 || ws_size < WS_END) { fprintf(stderr, "kernel_launch: unexpected n_in %d / ws %zu\n", n_in, ws_size); grid_blocks = -1; return; }
        int dev = 0, cus = 0, per_cu = 0;
        hipGetDevice(&dev);
        hipDeviceGetAttribute(&cus, hipDeviceAttributeMultiprocessorCount, dev);
        hipFuncSetAttribute((const void*)fwd_megakernel, hipFuncAttributeMaxDynamicSharedMemorySize, LDS_BYTES);
        hipOccupancyMaxActiveBlocksPerMultiprocessor(&per_cu, (const void*)fwd_megakernel, 512, LDS_BYTES);
        if (per_cu < 1) { fprintf(stderr, "kernel_launch: occupancy query says %d blocks/CU\n", per_cu); per_cu = 1; }
        grid_blocks = cus * per_cu;
    }
    if (grid_blocks < 0) return;
    Params p{};
    const float** f = (const float**)&p;
    for (int i = 0; i < 19; ++i) f[i] = (const float*)d_in[i];
    p.out = (float*)d_out; p.ws = (unsigned char*)d_ws;
    (void)hipMemsetAsync((char*)d_ws + WS_BAR, 0, WS_BAR_BYTES, stream);
    void* args[] = {&p};
    hipError_t e = hipLaunchCooperativeKernel((const void*)fwd_megakernel, dim3(grid_blocks), dim3(512), args, LDS_BYTES, stream);
    if (e != hipSuccess) fprintf(stderr, "cooperative launch failed: %s (grid %d)\n", hipGetErrorString(e), grid_blocks);
}
```

```cpp
#include <hip/hip_runtime.h>
#include <hip/hip_cooperative_groups.h>
#include <cstdint>
#include <cstdio>
namespace cg = cooperative_groups;

#define LAS __attribute__((address_space(3)))
typedef unsigned short bf16_t;
typedef short bf16x8 __attribute__((ext_vector_type(8)));
typedef short s16x4 __attribute__((ext_vector_type(4)));
typedef float f32x4 __attribute__((ext_vector_type(4)));
typedef float f32x2 __attribute__((ext_vector_type(2)));
typedef float f32x16 __attribute__((ext_vector_type(16)));
typedef unsigned u32x4 __attribute__((ext_vector_type(4)));
typedef unsigned u32x2 __attribute__((ext_vector_type(2)));
typedef __bf16 bf16x2_t __attribute__((ext_vector_type(2)));

constexpr int T_TOK = 32768, SEQ = 2048, DM = 1024, DEPTH = 4;
constexpr int NPROJ = 2048, NIN = 1952, DFF = 2816, NUP = 5632;
constexpr int NCQ = 768, NCKV = 1024;
constexpr float EPS = 1e-6f;
constexpr float LOG2E = 1.4426950408889634f;

constexpr size_t MiB = 1u << 20;
constexpr size_t WS_BAR = 0, WS_BAR_BYTES = 16384;
constexpr size_t WS_LAM = 512 * 1024;
constexpr size_t WS_COS = 576 * 1024, WS_SIN = 704 * 1024;
constexpr size_t WS_W = 1 * MiB;
constexpr size_t W_IN = 0, W_OUT = W_IN + (size_t)NPROJ * DM * 2, W_UP = W_OUT + (size_t)DM * DM * 2, W_DOWN = W_UP + (size_t)NUP * DM * 2,
                 W_UQ = W_DOWN + (size_t)DM * DFF * 2, W_UKV = W_UQ + (size_t)NCQ * 256 * 2, W_LAYER = W_UKV + (size_t)NCKV * 128 * 2;
static_assert(W_LAYER * DEPTH <= 93 * MiB, "weights");
constexpr size_t WS_XB = 94 * MiB, WS_PROJ = 158 * MiB, WS_CQ = 286 * MiB, WS_CKV = 334 * MiB, WS_MIX = 398 * MiB;
constexpr size_t WS_SSQA = 462 * MiB, WS_SSQB = 464 * MiB, WS_SSQQ = 466 * MiB, WS_SSQKV = 467 * MiB, WS_END = 468 * MiB;
constexpr size_t WS_ACT = 158 * MiB, WS_UBND = 334 * MiB;
static_assert(WS_ACT + (size_t)T_TOK * DFF * 2 <= WS_UBND && WS_UBND + (size_t)512 * 4 * NUP * 2 <= WS_MIX, "overlay");

constexpr int LDS_BYTES = 147456;
#ifndef MK_SKIP
#define MK_SKIP 0
#endif
#ifndef MK_DUP_PRO
#define MK_DUP_PRO 1
#endif
#ifndef MK_DUP_SYNC
#define MK_DUP_SYNC 1
#endif
#ifndef MK_DUP_MLA
#define MK_DUP_MLA 1
#endif
#ifndef MK_DUP_BAR
#define MK_DUP_BAR 1
#endif
#ifndef MK_DUP_UP
#define MK_DUP_UP 1
#endif
#ifndef MK_DUP_IN
#define MK_DUP_IN 1
#endif
#ifndef MK_DUP_AB
#define MK_DUP_AB 1
#endif
#ifndef MK_DUP_C
#define MK_DUP_C 1
#endif

struct Params {
    const float* x; const float* w_in; const float* g_attn; const float* a_lq1; const float* a_lk1; const float* a_lq2; const float* a_lk2;
    const float* a_subln; const float* c_g_q; const float* c_w_uq; const float* c_g_kv; const float* c_w_ukv; const float* w_out; const float* g_ffn;
    const float* w_up; const float* conv_w; const float* conv_b; const float* w_down; const float* g_final;
    float* out; unsigned char* ws;
};

__device__ __forceinline__ unsigned cvtpk(float lo, float hi) { f32x2 v = {lo, hi}; bf16x2_t b = __builtin_convertvector(v, bf16x2_t); return __builtin_bit_cast(unsigned, b); }
__device__ __forceinline__ void st16_wt(void* p, u32x4 v) { *(u32x4*)p = v; }
__device__ __forceinline__ void st8_wt(void* p, u32x2 v) { *(u32x2*)p = v; }
__device__ __forceinline__ float bf2f(unsigned short b) { return __uint_as_float((unsigned)b << 16); }
__device__ __forceinline__ float wave_sum(float v) {
#pragma unroll
    for (int o = 1; o < 64; o <<= 1) v += __shfl_xor(v, o);
    return v;
}
__device__ __forceinline__ float ld_agent(const float* p) { return __hip_atomic_load(p, __ATOMIC_RELAXED, __HIP_MEMORY_SCOPE_AGENT); }
template <int NS> __device__ __forceinline__ float ssq_sum(const float* p) {
    float t = 0.f;
#pragma unroll
    for (int i = 0; i < NS / 4; ++i) { const f32x4 v = *(const f32x4*)(p + 4 * i); t += (v[0] + v[1]) + (v[2] + v[3]); }
    return t;
}
__device__ __forceinline__ float fast_exp2(float x) { return __builtin_amdgcn_exp2f(x); }
__device__ __forceinline__ float fast_rcp(float x) { return __builtin_amdgcn_rcpf(x); }

namespace pg8 {
constexpr int BM = 256, BK = 64, HALF = 128, HTB = HALF * BK * 2, STAGE_BYTES = 8 * HTB, NXCD = 8, WGM = 8;
__host__ __device__ __forceinline__ int lds_byte(int r, int c) { const int st = (r >> 4) * 2 + (c >> 5), rr = r & 15, cc = c & 31, ob = rr * 64 + cc * 2; return st * 1024 + (ob ^ (((ob >> 9) & 1) << 5)); }
__host__ __device__ __forceinline__ void stage_rc(int b, int& R, int& C) { const int st = b / 1024, sb = b % 1024, swz = sb ^ (((sb >> 9) & 1) << 5); R = (st >> 1) * 16 + swz / 64; C = (st & 1) * 32 + (swz % 64) / 2; }
__host__ __device__ __forceinline__ int perm32(int rho) { const int n = rho >> 4, i = rho & 15; return 8 * (i >> 2) + 4 * n + (i & 3); }
struct Unit { int pm, pn; };
struct Gemm { const bf16_t* A; const bf16_t* Bt; int M, N, K, lda; };
struct StaticOrder {
    int nM, nN, nwg, G, c;
    __device__ void init(int M, int N, int G_, int c_) { nM = M / BM; nN = N / BM; nwg = nM * nN; G = G_; c = c_; }
    __device__ bool next(int i, Unit& u) const {
        const long L = (long)i * G + c; if (L >= nwg) return false;
        int wgid = (int)L; { const int q = nwg / NXCD, r = nwg % NXCD, xcd = wgid % NXCD, off = wgid / NXCD; wgid = (xcd < r ? xcd * (q + 1) : r * (q + 1) + (xcd - r) * q) + off; }
        const int nig = WGM * nN, gid = wgid / nig, fm = gid * WGM, gsz = (nM - fm) < WGM ? (nM - fm) : WGM;
        u.pm = fm + ((wgid % nig) % gsz); u.pn = (wgid % nig) / gsz; return true;
    }
};

template <class Epi>
__device__ __forceinline__ void gemm_phase(LAS unsigned char* lds, const Gemm g, const Epi& E) {
    int tid = threadIdx.x; asm volatile("" : "+v"(tid));
    const int wid = __builtin_amdgcn_readfirstlane(tid >> 6), lane = tid & 63, wr = wid >> 2, wc = wid & 3, fr = lane & 15, fq = lane >> 4;
    int K = g.K, lda = g.lda; asm volatile("" : "+s"(K), "+s"(lda));
    const int nt = K / BK;
    StaticOrder S; S.init(g.M, g.N, (int)gridDim.x, (int)blockIdx.x);
    unsigned voffA[2], voffB[2];
#pragma unroll
    for (int i = 0; i < 2; ++i) { int R, C; stage_rc(tid * 16 + i * 8192, R, C); const int Rb = Epi::PERM ? ((R & ~31) + perm32(R & 31)) : R;
        voffA[i] = (unsigned)(R * lda + C) * 2u; voffB[i] = (unsigned)(Rb * K + C) * 2u; }
    const size_t kstep = (size_t)(BK * 2);
    const size_t hstepA = (size_t)HALF * lda * 2, hstepB = (size_t)HALF * K * 2;
    const size_t tstepA = 2 * hstepA, tstepB = 2 * hstepB;
    const unsigned ldsw = (unsigned)wid * 1024u;
    const int aoff = lds_byte(wr * 64 + fr, fq * 8), boff = lds_byte(wc * 32 + fr, fq * 8);
#define PG8_SA(b, h) (((b) * 2 + (h)) * HTB)
#define PG8_SB(b, h) ((4 + (b) * 2 + (h)) * HTB)
#define PG8_STAGE(bufoff, gbase, voff) do { _Pragma("unroll") for (int _i = 0; _i < 2; ++_i) \
        __builtin_amdgcn_global_load_lds((const unsigned*)((const char*)(gbase) + (voff)[_i]), (LAS unsigned*)(lds + (bufoff) + ldsw + _i * 8192), 16, 0, 0); } while (0)
#define PG8_LDA(dst, b, h) do { _Pragma("unroll") for (int m = 0; m < 4; ++m) _Pragma("unroll") for (int k = 0; k < 2; ++k) dst[m][k] = *(const LAS bf16x8*)(lds + PG8_SA(b, h) + aoff + m * 2048 + k * 1024); } while (0)
#define PG8_LDB(dst, b, h) do { _Pragma("unroll") for (int n = 0; n < 2; ++n) _Pragma("unroll") for (int k = 0; k < 2; ++k) dst[n][k] = *(const LAS bf16x8*)(lds + PG8_SB(b, h) + boff + n * 2048 + k * 1024); } while (0)
#define PG8_MMA(ai, bj, At, Bt) do { __builtin_amdgcn_s_setprio(1); _Pragma("unroll") for (int m = 0; m < 4; ++m) _Pragma("unroll") for (int n = 0; n < 2; ++n) _Pragma("unroll") for (int k = 0; k < 2; ++k) \
        acc[ai][bj][m][n] = __builtin_amdgcn_mfma_f32_16x16x32_bf16(Bt[n][k], At[m][k], acc[ai][bj][m][n], 0, 0, 0); __builtin_amdgcn_s_setprio(0); } while (0)
#define PG8_WAIT_V(n) asm volatile("s_waitcnt vmcnt(" #n ")" ::: "memory")
#define PG8_WAIT_L(n) asm volatile("s_waitcnt lgkmcnt(" #n ")" ::: "memory")
#define PG8_BAR __builtin_amdgcn_s_barrier()
#define PG8_SCHED __builtin_amdgcn_sched_barrier(0)
    Unit cur, nxt; int ui = 0;
    if (!S.next(0, cur)) return;
    f32x4 acc[2][2][4][2];
#pragma unroll
    for (int a = 0; a < 2; ++a)
#pragma unroll
        for (int b = 0; b < 2; ++b)
#pragma unroll
            for (int m = 0; m < 4; ++m)
#pragma unroll
                for (int n = 0; n < 2; ++n) acc[a][b][m][n] = (f32x4){0.f, 0.f, 0.f, 0.f};
    bf16x8 At[4][2], B0[2][2], B1[2][2];
    const char* cA = (const char*)g.A + (size_t)cur.pm * tstepA; const char* cB = (const char*)g.Bt + (size_t)cur.pn * tstepB;
    PG8_STAGE(PG8_SB(0, 0), cB, voffB); PG8_STAGE(PG8_SB(0, 1), cB + hstepB, voffB); PG8_STAGE(PG8_SA(0, 0), cA, voffA); PG8_STAGE(PG8_SA(0, 1), cA + hstepA, voffA);
    if (wr == 1) PG8_BAR;
    PG8_WAIT_V(2); PG8_BAR;
    PG8_STAGE(PG8_SB(1, 0), cB + kstep, voffB); PG8_STAGE(PG8_SA(1, 0), cA + kstep, voffA); PG8_STAGE(PG8_SB(1, 1), cB + hstepB + kstep, voffB);
    PG8_WAIT_V(6); PG8_BAR;
    for (;;) {
        const bool has_next = S.next(ui + 1, nxt);
        const char* nA = has_next ? (const char*)g.A + (size_t)nxt.pm * tstepA : cA; const char* nB = has_next ? (const char*)g.Bt + (size_t)nxt.pn * tstepB : cB;
        for (int t = 0; t < nt; t += 2) {
            const bool last = (t == nt - 2);
            const char* a1 = cA + (size_t)(t + 1) * kstep;
            const char* a2 = last ? nA : cA + (size_t)(t + 2) * kstep; const char* b2 = last ? nB : cB + (size_t)(t + 2) * kstep;
            const char* a3 = a2 + kstep; const char* b3 = b2 + kstep;
            PG8_LDB(B0, 0, 0); PG8_LDB(B1, 0, 1); PG8_SCHED; PG8_LDA(At, 0, 0); PG8_STAGE(PG8_SA(1, 1), a1 + hstepA, voffA);
            PG8_WAIT_V(8); PG8_WAIT_L(0); PG8_BAR; PG8_MMA(0, 0, At, B0); PG8_MMA(0, 1, At, B1); PG8_BAR; PG8_SCHED;
            PG8_LDA(At, 0, 1); PG8_STAGE(PG8_SB(0, 0), b2, voffB); PG8_STAGE(PG8_SB(0, 1), b2 + hstepB, voffB); PG8_STAGE(PG8_SA(0, 0), a2, voffA);
            PG8_WAIT_V(8); PG8_WAIT_L(0); PG8_BAR; PG8_MMA(1, 0, At, B0); PG8_MMA(1, 1, At, B1); PG8_BAR; PG8_SCHED;
            PG8_LDB(B0, 1, 0); PG8_LDB(B1, 1, 1); PG8_SCHED; PG8_LDA(At, 1, 0); PG8_STAGE(PG8_SA(0, 1), a2 + hstepA, voffA);
            PG8_WAIT_V(8); PG8_WAIT_L(0); PG8_BAR; PG8_MMA(0, 0, At, B0); PG8_MMA(0, 1, At, B1); PG8_BAR; PG8_SCHED;
            PG8_LDA(At, 1, 1); PG8_STAGE(PG8_SB(1, 0), b3, voffB); PG8_STAGE(PG8_SB(1, 1), b3 + hstepB, voffB); PG8_STAGE(PG8_SA(1, 0), a3, voffA);
            PG8_WAIT_V(8); PG8_WAIT_L(0); PG8_BAR; PG8_MMA(1, 0, At, B0); PG8_MMA(1, 1, At, B1); PG8_BAR; PG8_SCHED;
        }
        if (wr == 0) PG8_BAR;
        E(acc, cur, wr, wc, fr, fq);
        if (!has_next) break;
#pragma unroll
        for (int a = 0; a < 2; ++a)
#pragma unroll
            for (int b = 0; b < 2; ++b)
#pragma unroll
                for (int m = 0; m < 4; ++m)
#pragma unroll
                    for (int n = 0; n < 2; ++n) acc[a][b][m][n] = (f32x4){0.f, 0.f, 0.f, 0.f};
        cur = nxt; cA = nA; cB = nB; ++ui;
        if (wr == 1) PG8_BAR;
    }
    PG8_WAIT_V(0);
    PG8_BAR;
#undef PG8_SA
#undef PG8_SB
#undef PG8_STAGE
#undef PG8_LDA
#undef PG8_LDB
#undef PG8_MMA
#undef PG8_WAIT_V
#undef PG8_WAIT_L
#undef PG8_BAR
#undef PG8_SCHED
}
}
using pg8::Unit;
typedef f32x4 (&AccRef)[2][2][4][2];

__device__ __forceinline__ void rope8(f32x4& v0, f32x4& v1, const float* cosr, const float* sinr, int fq) {
    const int j0 = 8 * (fq & 1);
    const f32x4 c0 = *(const f32x4*)(cosr + j0), c1 = *(const f32x4*)(cosr + j0 + 4), s0 = *(const f32x4*)(sinr + j0), s1 = *(const f32x4*)(sinr + j0 + 4);
    const float sg = (fq < 2) ? -1.f : 1.f;
#pragma unroll
    for (int i = 0; i < 4; ++i) {
        const float p0 = __shfl_xor(v0[i], 32), p1 = __shfl_xor(v1[i], 32);
        v0[i] = v0[i] * c0[i] + sg * p0 * s0[i]; v1[i] = v1[i] * c1[i] + sg * p1 * s1[i];
    }
}

struct EpiProj {
    static constexpr bool PERM = true;
    bf16_t* O; const float* ssqx; float* ssqq; float* ssqkv; const float* cost; const float* sint;
    __device__ __forceinline__ void operator()(AccRef acc, const Unit& u, int wr, int wc, int fr, int fq) const {
        const int row0 = u.pm * 256 + wr * 64 + fr, col0 = u.pn * 256 + wc * 32 + 8 * fq;
#pragma unroll
        for (int ai = 0; ai < 2; ++ai)
#pragma unroll
            for (int m = 0; m < 4; ++m) {
                const int row = row0 + ai * 128 + m * 16;
                const float rs = rsqrtf(ssq_sum<16>(ssqx + (size_t)row * 16) * (1.0f / DM) + EPS);
                bf16_t* rowp = O + (size_t)row * NPROJ + col0;
#pragma unroll
                for (int bj = 0; bj < 2; ++bj) {
                    f32x4 v0 = acc[ai][bj][m][0] * rs, v1 = acc[ai][bj][m][1] * rs;
                    if (u.pn == 6 || (u.pn == 7 && bj == 0)) {
                        float s = (v0[0] * v0[0] + v0[1] * v0[1]) + (v0[2] * v0[2] + v0[3] * v0[3]) + (v1[0] * v1[0] + v1[1] * v1[1]) + (v1[2] * v1[2] + v1[3] * v1[3]);
                        s += __shfl_xor(s, 16); s += __shfl_xor(s, 32);
                        if (fq == 0) { if (u.pn == 6) ssqq[(size_t)row * 8 + bj * 4 + wc] = s; else ssqkv[(size_t)row * 4 + wc] = s; }
                    }
                    if (u.pn == 7 && bj == 1 && wc == 0) { const int pos = row & (SEQ - 1); rope8(v0, v1, cost + pos * 16, sint + pos * 16, fq); }
                    u32x4 w; w.x = cvtpk(v0[0], v0[1]); w.y = cvtpk(v0[2], v0[3]); w.z = cvtpk(v1[0], v1[1]); w.w = cvtpk(v1[2], v1[3]);
                    st16_wt(rowp + bj * 128, w);
                }
                asm volatile("" ::: "memory");
            }
    }
};
template <bool ROPE, int NS> struct EpiMla {
    static constexpr bool PERM = true;
    bf16_t* O; int ldc; const float* ssq; float inv_n; const float* cost; const float* sint;
    __device__ __forceinline__ void operator()(AccRef acc, const Unit& u, int wr, int wc, int fr, int fq) const {
        const int row0 = u.pm * 256 + wr * 64 + fr, col0 = u.pn * 256 + wc * 32 + 8 * fq;
#pragma unroll
        for (int ai = 0; ai < 2; ++ai)
#pragma unroll
            for (int m = 0; m < 4; ++m) {
                const int row = row0 + ai * 128 + m * 16;
                const float rs = rsqrtf(ssq_sum<NS>(ssq + (size_t)row * NS) * inv_n + EPS);
                bf16_t* rowp = O + (size_t)row * ldc + col0;
#pragma unroll
                for (int bj = 0; bj < 2; ++bj) {
                    f32x4 v0 = acc[ai][bj][m][0] * rs, v1 = acc[ai][bj][m][1] * rs;
                    if (ROPE) { const int g32 = u.pn * 8 + bj * 4 + wc; if (g32 % 3 == 2) { const int pos = row & (SEQ - 1); rope8(v0, v1, cost + pos * 16, sint + pos * 16, fq); } }
                    u32x4 w; w.x = cvtpk(v0[0], v0[1]); w.y = cvtpk(v0[2], v0[3]); w.z = cvtpk(v1[0], v1[1]); w.w = cvtpk(v1[2], v1[3]);
                    st16_wt(rowp + bj * 128, w);
                }
                asm volatile("" ::: "memory");
            }
    }
};
struct EpiResid {
    static constexpr bool PERM = true;
    bf16_t* XB; float* ssq;
    __device__ __forceinline__ void operator()(AccRef acc, const Unit& u, int wr, int wc, int fr, int fq) const {
        const int row0 = u.pm * 256 + wr * 64 + fr, col0 = u.pn * 256 + wc * 32 + 8 * fq;
#pragma unroll
        for (int ai = 0; ai < 2; ++ai)
#pragma unroll
            for (int m = 0; m < 4; ++m) {
                const int row = row0 + ai * 128 + m * 16; bf16_t* rowp = XB + (size_t)row * DM + col0; float s = 0.f;
#pragma unroll
                for (int bj = 0; bj < 2; ++bj) {
                    const u32x4 xo = *(const u32x4*)(rowp + bj * 128);
                    float v[8];
#pragma unroll
                    for (int k = 0; k < 4; ++k) { v[2 * k] = __uint_as_float(xo[k] << 16) + acc[ai][bj][m][k >> 1][(2 * k) & 3]; v[2 * k + 1] = __uint_as_float(xo[k] & 0xffff0000u) + acc[ai][bj][m][k >> 1][(2 * k + 1) & 3]; }
#pragma unroll
                    for (int k = 0; k < 8; ++k) s += v[k] * v[k];
                    u32x4 w; w.x = cvtpk(v[0], v[1]); w.y = cvtpk(v[2], v[3]); w.z = cvtpk(v[4], v[5]); w.w = cvtpk(v[6], v[7]);
                    st16_wt(rowp + bj * 128, w);
                }
                s += __shfl_xor(s, 16); s += __shfl_xor(s, 32);
                if (fq == 0) ssq[(size_t)row * 16 + u.pn * 4 + wc] = s;
                asm volatile("" ::: "memory");
            }
    }
};
template <int CTRL> __device__ __forceinline__ float dpp_rot(float v) { return __int_as_float(__builtin_amdgcn_update_dpp(__float_as_int(v), __float_as_int(v), CTRL, 0xf, 0xf, false)); }
struct EpiUp {
    static constexpr bool PERM = true;
    bf16_t* ACT; bf16_t* UB; const float* ssqx; const float* cw; const float* cb;
    __device__ __forceinline__ void operator()(AccRef acc, const Unit& u, int wr, int wc, int fr, int fq) const {
        const int row0 = u.pm * 256 + wr * 64 + fr, gcol = u.pn * 128 + wc * 32 + 8 * fq;
#pragma unroll
        for (int ai = 0; ai < 2; ++ai) {
#pragma unroll
            for (int m = 0; m < 4; ++m) {
                const float rs = rsqrtf(ssq_sum<16>(ssqx + (size_t)(row0 + ai * 128 + m * 16) * 16) * (1.0f / DM) + EPS);
#pragma unroll
                for (int bj = 0; bj < 2; ++bj) { acc[ai][bj][m][0] = acc[ai][bj][m][0] * rs; acc[ai][bj][m][1] = acc[ai][bj][m][1] * rs; }
            }
            asm volatile("" ::: "memory");
            const int chunk = u.pm * 4 + ai * 2 + wr;
#pragma unroll
            for (int e = 0; e < 2; ++e) {
                const int m = e ? 3 : 0;
                const bool mine = e ? (fr >= 14) : (fr <= 1);
                const int slot = e ? (fr - 12) : fr;
                if (mine) {
#pragma unroll
                    for (int bj = 0; bj < 2; ++bj) {
                        const f32x4 v0 = acc[ai][bj][m][0], v1 = acc[ai][bj][m][1];
                        u32x4 w; w.x = cvtpk(v0[0], v0[1]); w.y = cvtpk(v0[2], v0[3]); w.z = cvtpk(v1[0], v1[1]); w.w = cvtpk(v1[2], v1[3]);
                        *(u32x4*)(UB + ((size_t)chunk * 4 + slot) * NUP + bj * DFF + gcol) = w;
                    }
                }
            }
            asm volatile("" ::: "memory");
#pragma unroll
            for (int n = 0; n < 2; ++n) {
                unsigned wpk[4][2]; float rlo[4];
#pragma unroll
                for (int i = 0; i < 4; ++i) {
                    const int cg_ = gcol + 4 * n + i, cv_ = cg_ + DFF;
                    const float g0 = cw[cg_], g1 = cw[NUP + cg_], g2 = cw[2 * NUP + cg_], gb = cb[cg_];
                    const float h0 = cw[cv_], h1 = cw[NUP + cv_], h2 = cw[2 * NUP + cv_], hb = cb[cv_];
                    float gt[4];
                    {
                        float pg[4], ng[4];
#pragma unroll
                        for (int m = 0; m < 4; ++m) { pg[m] = dpp_rot<0x121>(acc[ai][0][m][n][i]); ng[m] = dpp_rot<0x12F>(acc[ai][0][m][n][i]); }
#pragma unroll
                        for (int m = 0; m < 4; ++m) {
                            const float gp = (fr == 0) ? (m ? pg[m - 1] : 0.f) : pg[m], gn = (fr == 15) ? (m < 3 ? ng[m + 1] : 0.f) : ng[m];
                            const float t = g0 * gp + g1 * acc[ai][0][m][n][i] + g2 * gn + gb;
                            gt[m] = t * fast_rcp(1.f + fast_exp2(-LOG2E * t));
                        }
                    }
                    asm volatile("" : "+v"(gt[0]), "+v"(gt[1]), "+v"(gt[2]), "+v"(gt[3]));
                    {
                        float pv[4], nv[4];
#pragma unroll
                        for (int m = 0; m < 4; ++m) { pv[m] = dpp_rot<0x121>(acc[ai][1][m][n][i]); nv[m] = dpp_rot<0x12F>(acc[ai][1][m][n][i]); }
#pragma unroll
                        for (int m = 0; m < 4; ++m) {
                            const float vp = (fr == 0) ? (m ? pv[m - 1] : 0.f) : pv[m], vn = (fr == 15) ? (m < 3 ? nv[m + 1] : 0.f) : nv[m];
                            const float vl = h0 * vp + h1 * acc[ai][1][m][n][i] + h2 * vn + hb;
                            const float rv = gt[m] * vl;
                            if (i & 1) wpk[m][i >> 1] = cvtpk(rlo[m], rv); else rlo[m] = rv;
                        }
                    }
                    asm volatile("" ::: "memory");
                }
#pragma unroll
                for (int m = 0; m < 4; ++m) { u32x2 w; w.x = wpk[m][0]; w.y = wpk[m][1];
                    st8_wt(ACT + (size_t)(row0 + ai * 128 + m * 16) * DFF + gcol + 4 * n, w); }
                asm volatile("" ::: "memory");
            }
        }
    }
};

constexpr int AT_BUF = 20480, AT_V = 12288, AT_TAB = 3 * AT_BUF;
__device__ __forceinline__ float xmax(float a) { auto rr = __builtin_amdgcn_permlane32_swap(__float_as_uint(a), __float_as_uint(a), false, false); return fmaxf(__uint_as_float(rr[0]), __uint_as_float(rr[1])); }
__device__ __forceinline__ float xsum(float a) { auto rr = __builtin_amdgcn_permlane32_swap(__float_as_uint(a), __float_as_uint(a), false, false); return __uint_as_float(rr[0]) + __uint_as_float(rr[1]); }
typedef short v4i16_t __attribute__((ext_vector_type(4)));
__device__ __forceinline__ s16x4 vtr(const LAS unsigned char* p) { return __builtin_bit_cast(s16x4, __builtin_amdgcn_ds_read_tr16_b64_v4i16((LAS v4i16_t*)p)); }

template <int MODE, int NQ>
__device__ __forceinline__ void attn_unit(LAS unsigned char* lds, const Params& P, int layer, int b, int h, int qb) {
    constexpr int NMAP = (MODE == 1) ? 2 : 1, ND0 = (MODE == 0) ? 6 : (MODE == 1 ? 2 : 4), NC = NQ * NMAP, QROWS = 256 * NQ;
    int tid = threadIdx.x; asm volatile("" : "+v"(tid));
    const int lane = tid & 63, r32 = lane & 31, hi = lane >> 5, wave = __builtin_amdgcn_readfirstlane(tid >> 6);
    const bf16_t* proj = (const bf16_t*)(P.ws + WS_PROJ); const bf16_t* cq = (const bf16_t*)(P.ws + WS_CQ); const bf16_t* ckv = (const bf16_t*)(P.ws + WS_CKV);
    bf16_t* mix = (bf16_t*)(P.ws + WS_MIX);
    const size_t rowbase = (size_t)b * SEQ; const int q0 = qb * QROWS;
    const bf16_t *Qp, *Kp, *Vp; int qpitch, kpitch, vpitch, ocol; float c;
    if (MODE == 0) { Qp = cq + h * 96; qpitch = NCQ; Kp = ckv + h * 128; kpitch = NCKV; Vp = ckv + h * 128 + 64; vpitch = NCKV; ocol = 512 + h * 64; c = 0.10206207261596577f * LOG2E; }
    else if (MODE == 1) { Qp = proj + h * 64; qpitch = NPROJ; Kp = proj + 256 + h * 64; kpitch = NPROJ; Vp = proj + 512 + h * 64; vpitch = NPROJ; ocol = h * 64; c = 0.17677669529663687f * LOG2E; }
    else { Qp = proj + 768 + h * 64; qpitch = NPROJ; Kp = proj + 1024 + h * 64; kpitch = NPROJ; Vp = proj + 1280 + h * 64; vpitch = NPROJ; ocol = 256 + h * 64; c = 0.125f * LOG2E; }
    int kt0 = 0, kt1 = SEQ / 64;
    if (MODE == 2) { kt0 = (q0 - 1024) / 64; if (kt0 < 0) kt0 = 0; kt1 = (q0 + QROWS + 1024) / 64; if (kt1 > SEQ / 64) kt1 = SEQ / 64; }
    LAS float* tab = (LAS float*)(lds + AT_TAB);
    if (MODE != 0) {
        const float slope = (MODE == 1) ? exp2f(-(float)(2 * h + 1)) : exp2f(-(float)(2 * h + 2));
        for (int j = tid; j < 4096; j += 512) {
            const int d = (j > 2047) ? (j - 2047) : (2047 - j);
            float v = -slope * LOG2E * (float)d;
            if (MODE == 2) {
                const int mult = (d <= 64 ? 1 : 0) + (((d & 3) == 0 && d <= 256) ? 1 : 0) + (((d & 15) == 0 && d <= 1024) ? 1 : 0);
                v = (mult == 0) ? -1e30f : (mult == 1 ? v : (mult == 2 ? v + 1.0f : v + 1.5849625007211562f));
            }
            tab[j] = v;
        }
    }
    const int qpos0 = q0 + wave * (32 * NQ) + r32;
    bf16x8 qf[NC][ND0];
#pragma unroll
    for (int jq = 0; jq < NQ; ++jq) {
        const bf16_t* qrow = Qp + (rowbase + qpos0 + 32 * jq) * qpitch + hi * 8;
#pragma unroll
        for (int mp = 0; mp < NMAP; ++mp)
#pragma unroll
            for (int d0 = 0; d0 < ND0; ++d0) qf[jq * NMAP + mp][d0] = *(const bf16x8*)(qrow + mp * 32 + d0 * 16);
    }
    u32x4 kreg, kreg2 = (u32x4){0u, 0u, 0u, 0u}, vreg;
#define AT_GLOADK(kt) do { const size_t r_ = rowbase + (size_t)(kt) * 64; \
        kreg = *(const u32x4*)(Kp + (r_ + lane) * kpitch + wave * 8); \
        if (MODE == 0 && wave < 4) kreg2 = *(const u32x4*)(proj + (r_ + lane) * NPROJ + 1920 + wave * 8); } while (0)
#define AT_GLOADV(kt) do { const size_t r_ = rowbase + (size_t)(kt) * 64; \
        vreg = *(const u32x4*)(Vp + (r_ + 16 * (wave & 3) + (lane >> 2)) * vpitch + (wave >> 2) * 32 + (lane & 3) * 8); } while (0)
#define AT_LSTOREK(buf) do { LAS unsigned char* d_ = lds + (buf) * AT_BUF; \
        *(LAS u32x4*)(d_ + wave * 1024 + lane * 16) = kreg; \
        if (MODE == 0 && wave < 4) *(LAS u32x4*)(d_ + (8 + wave) * 1024 + lane * 16) = kreg2; } while (0)
#define AT_LSTOREV(buf) do { LAS unsigned char* d_ = lds + (buf) * AT_BUF; \
        *(LAS u32x4*)(d_ + AT_V + wave * 1024 + lane * 16) = vreg; } while (0)
    float mrun[NC], lrun[NC]; f32x16 o[NC][2];
#pragma unroll
    for (int cc = 0; cc < NC; ++cc) { mrun[cc] = -1e20f; lrun[cc] = 0.f; o[cc][0] = f32x16{}; o[cc][1] = f32x16{}; }
    constexpr int NK = NMAP * ND0;
    const bf16x8 ones8 = (bf16x8){0x3F80, 0x3F80, 0x3F80, 0x3F80, 0x3F80, 0x3F80, 0x3F80, 0x3F80};
    bf16x8 kf[NK]; s16x4 vlo[4], vhi[4];
#define AT_KLOAD(bufbase, hf) do { _Pragma("unroll") for (int j_ = 0; j_ < NK; ++j_) kf[j_] = *(const LAS bf16x8*)((bufbase) + (2 * j_ + hi) * 1024 + (hf) * 512 + r32 * 16); } while (0)
#define AT_VLOAD(bufbase, hf) do { _Pragma("unroll") for (int dv_ = 0; dv_ < 2; ++dv_) _Pragma("unroll") for (int k2_ = 0; k2_ < 2; ++k2_) { \
        vlo[dv_ * 2 + k2_] = vtr((bufbase) + AT_V + vlane + dv_ * 4096 + (2 * (hf) + k2_) * 1024); vhi[dv_ * 2 + k2_] = vtr((bufbase) + AT_V + vlane + dv_ * 4096 + (2 * (hf) + k2_) * 1024 + 512); } } while (0)
    const int vlane = ((lane >> 4) & 1) * 32 + (lane & 3) * 8 + (4 * hi + ((lane & 15) >> 2)) * 64;
    AT_GLOADK(kt0); AT_GLOADV(kt0); AT_LSTOREK(0); AT_LSTOREV(0);
    if (kt0 + 1 < kt1) { AT_GLOADK(kt0 + 1); AT_GLOADV(kt0 + 1); AT_LSTOREK(1); AT_LSTOREV(1); }
    __syncthreads();
    AT_KLOAD(lds, 0);
    int bcur = 0;
    for (int kt = kt0; kt < kt1; ++kt) {
        const int bnx = (bcur == 2) ? 0 : bcur + 1, bn2 = (bnx == 2) ? 0 : bnx + 1;
        const LAS unsigned char* cur = lds + bcur * AT_BUF;
        const LAS unsigned char* nxt = lds + bnx * AT_BUF;
#pragma unroll
        for (int hf = 0; hf < 2; ++hf) {
            if (kt + 2 < kt1) { if (hf == 0) AT_GLOADK(kt + 2); else AT_GLOADV(kt + 2); }
            f32x16 sc[NC];
#pragma unroll
            for (int cc = 0; cc < NC; ++cc) {
                sc[cc] = f32x16{};
#pragma unroll
                for (int d0 = 0; d0 < ND0; ++d0) sc[cc] = __builtin_amdgcn_mfma_f32_32x32x16_bf16(kf[(cc % NMAP) * ND0 + d0], qf[cc][d0], sc[cc], 0, 0, 0);
            }
            __builtin_amdgcn_sched_barrier(0);
            AT_VLOAD(cur, hf);
            if (hf == 0) AT_KLOAD(cur, 1); else if (kt + 1 < kt1) AT_KLOAD(nxt, 0);
            __builtin_amdgcn_sched_barrier(0);
            bf16x8 pw[NC][2];
#pragma unroll
            for (int cc = 0; cc < NC; ++cc) {
                f32x16& s0 = sc[cc];
                float mn;
                if (MODE != 0) {
                    const LAS float* tp = tab + (kt * 64 + hf * 32 + 4 * hi - (qpos0 + 32 * (cc / NMAP)) + 2047);
                    float rm = -3e38f;
#pragma unroll
                    for (int r = 0; r < 16; ++r) { s0[r] = s0[r] * c + tp[(r & 3) + 8 * (r >> 2)]; rm = fmaxf(rm, s0[r]); }
                    rm = xmax(rm);
                    mn = fmaxf(mrun[cc], rm);
                } else {
                    float rm = -3e38f;
#pragma unroll
                    for (int r = 0; r < 16; ++r) rm = fmaxf(rm, s0[r]);
                    rm = xmax(rm);
                    mn = fmaxf(mrun[cc], rm * c);
                }
                if (__any(mn > mrun[cc])) {
                    const float al = fast_exp2(mrun[cc] - mn); lrun[cc] *= al;
#pragma unroll
                    for (int r = 0; r < 16; ++r) { o[cc][0][r] *= al; o[cc][1][r] *= al; }
                    mrun[cc] = mn;
                }
                if (MODE != 0) {
#pragma unroll
                    for (int r = 0; r < 16; ++r) s0[r] = fast_exp2(s0[r] - mn);
                } else {
                    const float nm = -mn;
#pragma unroll
                    for (int r = 0; r < 16; ++r) s0[r] = fast_exp2(__builtin_fmaf(s0[r], c, nm));
                }
                u32x4 w;
                w.x = cvtpk(s0[0], s0[1]); w.y = cvtpk(s0[2], s0[3]); w.z = cvtpk(s0[4], s0[5]); w.w = cvtpk(s0[6], s0[7]); pw[cc][0] = __builtin_bit_cast(bf16x8, w);
                w.x = cvtpk(s0[8], s0[9]); w.y = cvtpk(s0[10], s0[11]); w.z = cvtpk(s0[12], s0[13]); w.w = cvtpk(s0[14], s0[15]); pw[cc][1] = __builtin_bit_cast(bf16x8, w);
                f32x16 t = __builtin_amdgcn_mfma_f32_32x32x16_bf16(ones8, pw[cc][0], f32x16{}, 0, 0, 0);
                t = __builtin_amdgcn_mfma_f32_32x32x16_bf16(ones8, pw[cc][1], t, 0, 0, 0);
                lrun[cc] += t[0];
            }
#pragma unroll
            for (int dv = 0; dv < 2; ++dv)
#pragma unroll
                for (int k2 = 0; k2 < 2; ++k2) {
                    const s16x4 lo = vlo[dv * 2 + k2], hh = vhi[dv * 2 + k2];
                    const bf16x8 vf = (bf16x8){lo[0], lo[1], lo[2], lo[3], hh[0], hh[1], hh[2], hh[3]};
#pragma unroll
                    for (int cc = 0; cc < NC; ++cc) o[cc][dv] = __builtin_amdgcn_mfma_f32_32x32x16_bf16(vf, pw[cc][k2], o[cc][dv], 0, 0, 0);
                }
            if (kt + 2 < kt1) { if (hf == 0) AT_LSTOREK(bn2); else AT_LSTOREV(bn2); }
        }
        __syncthreads();
        bcur = bnx;
    }
#undef AT_KLOAD
#undef AT_VLOAD
#undef AT_GLOADK
#undef AT_GLOADV
#undef AT_LSTOREK
#undef AT_LSTOREV
    if (MODE != 1) {
#pragma unroll
        for (int jq = 0; jq < NQ; ++jq) {
            bf16_t* orow = mix + (rowbase + qpos0 + 32 * jq) * DM + ocol + 4 * hi;
            const float inv = 1.f / lrun[jq];
#pragma unroll
            for (int d = 0; d < 2; ++d)
#pragma unroll
                for (int g = 0; g < 4; ++g) {
                    u32x2 w; w.x = cvtpk(o[jq][d][4 * g] * inv, o[jq][d][4 * g + 1] * inv); w.y = cvtpk(o[jq][d][4 * g + 2] * inv, o[jq][d][4 * g + 3] * inv);
                    *(u32x2*)(orow + 32 * d + 8 * g) = w;
                }
        }
    } else {
        bf16_t* orow = mix + (rowbase + qpos0) * DM + ocol + 4 * hi;
        const float lam = __hip_atomic_load((const float*)(P.ws + WS_LAM) + layer, __ATOMIC_RELAXED, __HIP_MEMORY_SCOPE_AGENT);
        const float lam_init = 0.8f - 0.6f * expf(-0.3f * (float)layer);
        const float i1 = 1.f / lrun[0], i2 = lam / lrun[NC - 1];
        float ss = 0.f;
#pragma unroll
        for (int d = 0; d < 2; ++d)
#pragma unroll
            for (int r = 0; r < 16; ++r) { const float v = o[0][d][r] * i1 - o[NC - 1][d][r] * i2; o[0][d][r] = v; ss += v * v; }
        ss = xsum(ss);
        const float sc_ = rsqrtf(ss * (1.0f / 64.0f) + EPS) * (1.f - lam_init);
        const float* gn = P.a_subln + layer * 64 + 4 * hi;
#pragma unroll
        for (int d = 0; d < 2; ++d)
#pragma unroll
            for (int g = 0; g < 4; ++g) {
                const f32x4 gv = *(const f32x4*)(gn + 32 * d + 8 * g);
                u32x2 w; w.x = cvtpk(o[0][d][4 * g] * sc_ * gv[0], o[0][d][4 * g + 1] * sc_ * gv[1]); w.y = cvtpk(o[0][d][4 * g + 2] * sc_ * gv[2], o[0][d][4 * g + 3] * sc_ * gv[3]);
                *(u32x2*)(orow + 32 * d + 8 * g) = w;
            }
    }
}

__device__ __forceinline__ void transpose_item(const float* W, int K, int Nsrc, const float* g, bf16_t* WT, int n0_dst, int n0_src, int k0, LAS float* scr, int lane) {
    float tv[32];
#pragma unroll
    for (int i = 0; i < 32; ++i) { const int kk = 2 * i + (lane >> 5); tv[i] = (n0_src >= 0) ? W[(size_t)(k0 + kk) * Nsrc + n0_src + (lane & 31)] : 0.f; }
    if (g) {
#pragma unroll
        for (int i = 0; i < 32; ++i) tv[i] *= g[k0 + 2 * i + (lane >> 5)];
    }
#pragma unroll
    for (int i = 0; i < 32; ++i) scr[(2 * i + (lane >> 5)) * 33 + (lane & 31)] = tv[i];
    asm volatile("s_waitcnt lgkmcnt(0)" ::: "memory");
    const int c = lane & 7;
#pragma unroll
    for (int j = 0; j < 4; ++j) { const int n = (lane >> 3) + 8 * j; const LAS float* s = scr + (8 * c) * 33 + n;
        u32x4 o; o.x = cvtpk(s[0 * 33], s[1 * 33]); o.y = cvtpk(s[2 * 33], s[3 * 33]); o.z = cvtpk(s[4 * 33], s[5 * 33]); o.w = cvtpk(s[6 * 33], s[7 * 33]);
        *(u32x4*)(WT + (size_t)(n0_dst + n) * K + k0 + 8 * c) = o; }
    asm volatile("s_waitcnt lgkmcnt(0)" ::: "memory");
}

__device__ __forceinline__ void zero_f32(float* p, int n) { for (int i = blockIdx.x * 512 + threadIdx.x; i < n; i += gridDim.x * 512) p[i] = 0.f; }

__device__ __forceinline__ void prologue(const Params& P, LAS unsigned char* lds) {
    const int tid = threadIdx.x, lane = tid & 63, wave = tid >> 6;
    const int gw = blockIdx.x * 8 + wave, NGW = gridDim.x * 8;
    LAS float* scr = (LAS float*)(lds + wave * 16384);
    constexpr int I_IN = 16 * 64, I_OUT = 16 * 32, I_UP = 16 * 176, I_DN = 44 * 32, I_UQ = 4 * 24, I_UKV = 2 * 32, I_L = I_IN + I_OUT + I_UP + I_DN + I_UQ + I_UKV;
    for (int it = gw; it < I_L * DEPTH; it += NGW) {
        const int l = it / I_L; int r = it % I_L;
        unsigned char* wl = P.ws + WS_W + (size_t)l * W_LAYER;
        if (r < I_IN) { const int kb = r / 64, nb = r % 64; transpose_item(P.w_in + (size_t)l * DM * NIN, DM, NIN, P.g_attn + l * DM, (bf16_t*)(wl + W_IN), nb * 32, nb < 61 ? nb * 32 : -1, kb * 64, scr, lane); continue; } r -= I_IN;
        if (r < I_OUT) { const int kb = r / 32, nb = r % 32; transpose_item(P.w_out + (size_t)l * DM * DM, DM, DM, nullptr, (bf16_t*)(wl + W_OUT), nb * 32, nb * 32, kb * 64, scr, lane); continue; } r -= I_OUT;
        if (r < I_UP) { const int kb = r / 176, nb = r % 176; const int nd = nb * 32, pn = nd >> 8, wi = nd & 255, src = (wi >> 7) * DFF + pn * 128 + (wi & 127);
            transpose_item(P.w_up + (size_t)l * DM * NUP, DM, NUP, P.g_ffn + l * DM, (bf16_t*)(wl + W_UP), nd, src, kb * 64, scr, lane); continue; } r -= I_UP;
        if (r < I_DN) { const int kb = r / 32, nb = r % 32; transpose_item(P.w_down + (size_t)l * DFF * DM, DFF, DM, nullptr, (bf16_t*)(wl + W_DOWN), nb * 32, nb * 32, kb * 64, scr, lane); continue; } r -= I_DN;
        if (r < I_UQ) { const int kb = r / 24, nb = r % 24; transpose_item(P.c_w_uq + (size_t)l * 256 * NCQ, 256, NCQ, P.c_g_q + l * 256, (bf16_t*)(wl + W_UQ), nb * 32, nb * 32, kb * 64, scr, lane); continue; } r -= I_UQ;
        { const int kb = r / 32, nb = r % 32; transpose_item(P.c_w_ukv + (size_t)l * 128 * NCKV, 128, NCKV, P.c_g_kv + l * 128, (bf16_t*)(wl + W_UKV), nb * 32, nb * 32, kb * 64, scr, lane); }
    }
    float* ssqA = (float*)(P.ws + WS_SSQA); bf16_t* xb = (bf16_t*)(P.ws + WS_XB);
    for (int m = gw; m < T_TOK; m += NGW) {
        const f32x4* xr = (const f32x4*)(P.x + (size_t)m * DM) + lane; u32x2* brow = (u32x2*)(xb + (size_t)m * DM) + lane;
        float s = 0.f;
#pragma unroll
        for (int j = 0; j < 4; ++j) { const f32x4 v = xr[64 * j]; u32x2 w; w.x = cvtpk(v[0], v[1]); w.y = cvtpk(v[2], v[3]); brow[64 * j] = w; s += (v[0] * v[0] + v[1] * v[1]) + (v[2] * v[2] + v[3] * v[3]); }
        s = wave_sum(s);
        if (lane < 16) ssqA[(size_t)m * 16 + lane] = lane ? 0.f : s;
    }
    float* cost = (float*)(P.ws + WS_COS); float* sint = (float*)(P.ws + WS_SIN);
    for (int i = blockIdx.x * 512 + tid; i < SEQ * 16; i += gridDim.x * 512) {
        const int pos = i >> 4, j = i & 15; const float inv = exp2f(-(float)j * (13.287712379549449f / 16.0f)); const float ang = (float)pos * inv;
        cost[i] = cosf(ang); sint[i] = sinf(ang);
    }
    if (blockIdx.x == 0 && tid < DEPTH) {
        float d1 = 0.f, d2 = 0.f;
        for (int j = 0; j < 32; ++j) { d1 += P.a_lq1[tid * 32 + j] * P.a_lk1[tid * 32 + j]; d2 += P.a_lq2[tid * 32 + j] * P.a_lk2[tid * 32 + j]; }
        ((float*)(P.ws + WS_LAM))[tid] = expf(d1) - expf(d2) + (0.8f - 0.6f * expf(-0.3f * (float)tid));
    }
}

__device__ __forceinline__ void ffn_fixup(const Params& P, int layer) {
    const bf16_t* UB = (const bf16_t*)(P.ws + WS_UBND); bf16_t* ACT = (bf16_t*)(P.ws + WS_ACT);
    const float* cw = P.conv_w + (size_t)layer * 3 * NUP; const float* cb = P.conv_b + (size_t)layer * NUP;
    constexpr int CG = DFF / 8;
    for (int it = blockIdx.x * 512 + threadIdx.x; it < 512 * 2 * CG; it += gridDim.x * 512) {
        const int cgi = it % CG, e = (it / CG) & 1, chunk = it / (2 * CG), col = cgi * 8;
        const bf16_t *up, *mid, *dn; bool zu = false, zd = false;
        if (e == 0) { zu = (chunk % 32) == 0; up = UB + ((size_t)(zu ? chunk : chunk - 1) * 4 + 3) * NUP; mid = UB + ((size_t)chunk * 4 + 0) * NUP; dn = UB + ((size_t)chunk * 4 + 1) * NUP; }
        else { zd = (chunk % 32) == 31; up = UB + ((size_t)chunk * 4 + 2) * NUP; mid = UB + ((size_t)chunk * 4 + 3) * NUP; dn = UB + ((size_t)(zd ? chunk : chunk + 1) * 4 + 0) * NUP; }
        const float fu = zu ? 0.f : 1.f, fd = zd ? 0.f : 1.f;
        float res[8];
        bf16_t ug[8], mg[8], dg[8], uv[8], mv[8], dv[8];
        *(u32x4*)ug = *(const u32x4*)(up + col); *(u32x4*)mg = *(const u32x4*)(mid + col); *(u32x4*)dg = *(const u32x4*)(dn + col);
        *(u32x4*)uv = *(const u32x4*)(up + DFF + col); *(u32x4*)mv = *(const u32x4*)(mid + DFF + col); *(u32x4*)dv = *(const u32x4*)(dn + DFF + col);
#pragma unroll
        for (int k = 0; k < 8; ++k) {
            const int cg_ = col + k, cv_ = DFF + col + k;
            const float gt = cw[cg_] * bf2f(ug[k]) * fu + cw[NUP + cg_] * bf2f(mg[k]) + cw[2 * NUP + cg_] * bf2f(dg[k]) * fd + cb[cg_];
            const float vl = cw[cv_] * bf2f(uv[k]) * fu + cw[NUP + cv_] * bf2f(mv[k]) + cw[2 * NUP + cv_] * bf2f(dv[k]) * fd + cb[cv_];
            res[k] = gt * fast_rcp(1.f + fast_exp2(-LOG2E * gt)) * vl;
        }
        u32x4 w; w.x = cvtpk(res[0], res[1]); w.y = cvtpk(res[2], res[3]); w.z = cvtpk(res[4], res[5]); w.w = cvtpk(res[6], res[7]);
        *(u32x4*)(ACT + (size_t)(chunk * 64 + (e ? 63 : 0)) * DFF + col) = w;
    }
}


#define XB_TMO      128
#define XB_XCNT(j)  (256  + 64 * (j))
#define XB_XSUB(j)  (1280 + 64 * (j))
#define XB_XGEN(j)  (2304 + 64 * (j))
#define XB_TOP      3328
#define XB_TOPGEN   3392
#define XCD_BAR_WORDS 3456
#define XB_SPIN_CAP (1u << 22)
__device__ __forceinline__ unsigned xb_ld(unsigned* p)              { return __hip_atomic_load(p, __ATOMIC_RELAXED, __HIP_MEMORY_SCOPE_AGENT); }
__device__ __forceinline__ unsigned xb_add(unsigned* p, unsigned v) { return __hip_atomic_fetch_add(p, v, __ATOMIC_RELAXED, __HIP_MEMORY_SCOPE_AGENT); }
__device__ __forceinline__ unsigned xb_xcc_id() { return (unsigned)__builtin_amdgcn_s_getreg((3 << 11) | 20) & 0xFu; }
#define XB_SPIN(cond, bar) do { unsigned _sp = 0; while (cond) { __builtin_amdgcn_s_sleep(1); \
    if ((++_sp & 255u) == 0u) { if (xb_ld(&(bar)[XB_TMO])) break; if (_sp > XB_SPIN_CAP) { atomicAdd(&(bar)[XB_TMO], 1u); break; } } } } while (0)
struct XcdBarrier { unsigned* bar; unsigned x; volatile LAS unsigned* st; };
__device__ __forceinline__ XcdBarrier xcd_barrier_post(unsigned* bar, volatile LAS unsigned* st) {
    XcdBarrier b; b.bar = bar; b.x = xb_xcc_id(); b.st = st;
    if (threadIdx.x == 0) (void)xb_add(&bar[XB_XCNT(b.x)], 1u);
    return b;
}
__device__ __forceinline__ void xcd_barrier_complete(unsigned* bar, unsigned x, unsigned& nloc, unsigned& nx) {
    const unsigned G = gridDim.x * gridDim.y * gridDim.z;
    unsigned sum, cnt, mine, sp = 0u;
    for (;;) {
        sum = 0u; cnt = 0u; mine = 0u;
#pragma unroll
        for (unsigned j = 0; j < 16; ++j) { const unsigned c = xb_ld(&bar[XB_XCNT(j)]); sum += c; cnt += (c > 0u) ? 1u : 0u; mine = (j == x) ? c : mine; }
        if (sum == G) break;
        __builtin_amdgcn_s_sleep(1);
        if ((++sp & 255u) == 0u) { if (xb_ld(&bar[XB_TMO])) break; if (sp > XB_SPIN_CAP) { atomicAdd(&bar[XB_TMO], 1u); break; } }
    }
    nloc = mine > 0u ? mine : 1u; nx = cnt > 0u ? cnt : 1u;
}
__device__ __forceinline__ void xcd_barrier(const XcdBarrier& b) {
    asm volatile("s_waitcnt vmcnt(0)" ::: "memory");
    __syncthreads();
    if (threadIdx.x == 0) {
        unsigned* bar = b.bar;
        __builtin_amdgcn_s_waitcnt(0);
        unsigned nloc = b.st[0], nx = b.st[1];
        if (nloc == 0u) { xcd_barrier_complete(bar, b.x, nloc, nx); b.st[0] = nloc; b.st[1] = nx; }
        const unsigned old = xb_add(&bar[XB_XSUB(b.x)], 1u);
        const unsigned gen = old / nloc;
        if (old + 1u == (gen + 1u) * nloc) {
            __builtin_amdgcn_fence(__ATOMIC_RELEASE, "agent");
            asm volatile("s_waitcnt vmcnt(0)" ::: "memory");
            const unsigned og = xb_add(&bar[XB_TOP], 1u);
            const unsigned tg = og / nx;
            if (og + 1u == (tg + 1u) * nx) xb_add(&bar[XB_TOPGEN], 1u);
            else XB_SPIN(xb_ld(&bar[XB_TOPGEN]) == tg, bar);
            __builtin_amdgcn_fence(__ATOMIC_ACQUIRE, "agent");
            xb_add(&bar[XB_XGEN(b.x)], 1u);
            asm volatile("s_waitcnt vmcnt(0)" ::: "memory");
        } else {
            XB_SPIN(xb_ld(&bar[XB_XGEN(b.x)]) == gen, bar);
            __builtin_amdgcn_fence(__ATOMIC_ACQUIRE, "agent");
            asm volatile("s_waitcnt vmcnt(0)" ::: "memory");
        }
    }
    __syncthreads();
}

__global__ void __launch_bounds__(512, 2) fwd_megakernel(Params P) {
    extern __shared__ __attribute__((aligned(16))) unsigned char lds_raw[];
    LAS unsigned char* lds = (LAS unsigned char*)lds_raw;
    cg::grid_group grid = cg::this_grid();
#define GRID_SYNC() do { asm volatile("s_waitcnt vmcnt(0) lgkmcnt(0)" ::: "memory"); __syncthreads(); grid.sync(); \
        __builtin_amdgcn_fence(__ATOMIC_ACQUIRE, "agent"); asm volatile("s_waitcnt vmcnt(0)" ::: "memory"); GRID_SYNC2(); } while (0)
#if MK_DUP_SYNC > 1
#define GRID_SYNC2() do { grid.sync(); __builtin_amdgcn_fence(__ATOMIC_ACQUIRE, "agent"); asm volatile("s_waitcnt vmcnt(0)" ::: "memory"); } while (0)
#else
#define GRID_SYNC2() do {} while (0)
#endif
    unsigned char* ws = P.ws;
    float* ssqA = (float*)(ws + WS_SSQA); float* ssqB = (float*)(ws + WS_SSQB); float* ssqQ = (float*)(ws + WS_SSQQ); float* ssqKV = (float*)(ws + WS_SSQKV);
    const float* cost = (const float*)(ws + WS_COS); const float* sint = (const float*)(ws + WS_SIN);
    bf16_t* xb = (bf16_t*)(ws + WS_XB); bf16_t* proj = (bf16_t*)(ws + WS_PROJ); bf16_t* cq = (bf16_t*)(ws + WS_CQ); bf16_t* ckv = (bf16_t*)(ws + WS_CKV);
    bf16_t* mix = (bf16_t*)(ws + WS_MIX); bf16_t* act = (bf16_t*)(ws + WS_ACT); bf16_t* ubnd = (bf16_t*)(ws + WS_UBND);

    volatile LAS unsigned* bst = (volatile LAS unsigned*)(lds + 131072 + 64);
    if (threadIdx.x < 2) bst[threadIdx.x] = 0u;
    __syncthreads();
    const XcdBarrier xbar = xcd_barrier_post((unsigned*)(ws + WS_BAR), bst);
    prologue(P, lds);
#if MK_DUP_PRO > 1
    volatile LAS unsigned* bst = (volatile LAS unsigned*)(lds + 131072 + 64);
    if (threadIdx.x < 2) bst[threadIdx.x] = 0u;
    __syncthreads();
    const XcdBarrier xbar = xcd_barrier_post((unsigned*)(ws + WS_BAR), bst);
    prologue(P, lds);
#endif
    GRID_SYNC();
#if MK_DUP_BAR > 1
#define XBAR() do { xcd_barrier(xbar); xcd_barrier(xbar); } while (0)
#else
#define XBAR() xcd_barrier(xbar)
#endif
    for (int l = 0; l < DEPTH; ++l) {
        const unsigned char* wl = ws + WS_W + (size_t)l * W_LAYER;
#if !(MK_SKIP & 1)
        { pg8::Gemm g{xb, (const bf16_t*)(wl + W_IN), T_TOK, NPROJ, DM, DM}; EpiProj E{proj, ssqA, ssqQ, ssqKV, cost, sint}; pg8::gemm_phase(lds, g, E); }
#if MK_DUP_IN > 1
        { pg8::Gemm g{xb, (const bf16_t*)(wl + W_IN), T_TOK, NPROJ, DM, DM}; EpiProj E{proj, ssqA, ssqQ, ssqKV, cost, sint}; pg8::gemm_phase(lds, g, E); }
#endif
#endif
        XBAR();
#if !(MK_SKIP & 2)
        { pg8::Gemm g{proj + 1536, (const bf16_t*)(wl + W_UQ), T_TOK, NCQ, 256, NPROJ}; EpiMla<true, 8> E{cq, NCQ, ssqQ, 1.0f / 256.0f, cost, sint}; pg8::gemm_phase(lds, g, E); }
        { pg8::Gemm g{proj + 1792, (const bf16_t*)(wl + W_UKV), T_TOK, NCKV, 128, NPROJ}; EpiMla<false, 4> E{ckv, NCKV, ssqKV, 1.0f / 128.0f, cost, sint}; pg8::gemm_phase(lds, g, E); }
#if MK_DUP_MLA > 1
        { pg8::Gemm g{proj + 1536, (const bf16_t*)(wl + W_UQ), T_TOK, NCQ, 256, NPROJ}; EpiMla<true, 8> E{cq, NCQ, ssqQ, 1.0f / 256.0f, cost, sint}; pg8::gemm_phase(lds, g, E); }
        { pg8::Gemm g{proj + 1792, (const bf16_t*)(wl + W_UKV), T_TOK, NCKV, 128, NPROJ}; EpiMla<false, 4> E{ckv, NCKV, ssqKV, 1.0f / 128.0f, cost, sint}; pg8::gemm_phase(lds, g, E); }
#endif
#endif
#if !(MK_SKIP & 4)
        for (int rep_ = 0; rep_ < MK_DUP_AB; ++rep_)
        for (int u = blockIdx.x; u < 1024; u += gridDim.x) {
            if (u < 512) { attn_unit<1, 1>(lds, P, l, u >> 5, (u >> 3) & 3, u & 7); }
            else { const int v = u - 512; int qb = v & 7; if (v >= 256) qb = (qb + 4) & 7; attn_unit<2, 1>(lds, P, l, (v >> 5) & 15, (v >> 3) & 3, qb); }
        }
#endif
        XBAR();
#if !(MK_SKIP & 8)
        for (int rep_ = 0; rep_ < MK_DUP_C; ++rep_)
        for (int u = blockIdx.x; u < 512; u += gridDim.x) attn_unit<0, 2>(lds, P, l, u >> 5, (u >> 2) & 7, u & 3);
#endif
        XBAR();
#if !(MK_SKIP & 16)
        { pg8::Gemm g{mix, (const bf16_t*)(wl + W_OUT), T_TOK, DM, DM, DM}; EpiResid E{xb, ssqB}; pg8::gemm_phase(lds, g, E); }
#endif
        XBAR();
#if !(MK_SKIP & 32)
        { pg8::Gemm g{xb, (const bf16_t*)(wl + W_UP), T_TOK, NUP, DM, DM}; EpiUp E{act, ubnd, ssqB, P.conv_w + (size_t)l * 3 * NUP, P.conv_b + (size_t)l * NUP}; pg8::gemm_phase(lds, g, E); }
#if MK_DUP_UP > 1
        { pg8::Gemm g{xb, (const bf16_t*)(wl + W_UP), T_TOK, NUP, DM, DM}; EpiUp E{act, ubnd, ssqB, P.conv_w + (size_t)l * 3 * NUP, P.conv_b + (size_t)l * NUP}; pg8::gemm_phase(lds, g, E); }
#endif
#endif
        XBAR();
        ffn_fixup(P, l);
        XBAR();
#if !(MK_SKIP & 64)
        { pg8::Gemm g{act, (const bf16_t*)(wl + W_DOWN), T_TOK, DM, DFF, DFF}; EpiResid E{xb, ssqA}; pg8::gemm_phase(lds, g, E); }
#endif
        XBAR();
    }
    for (int i = blockIdx.x * 512 + threadIdx.x; i < T_TOK * (DM / 4); i += gridDim.x * 512) {
        const int row = i >> 8, c4 = i & 255;
        const float rs = rsqrtf(ssq_sum<16>(ssqA + (size_t)row * 16) * (1.0f / DM) + EPS);
        const u32x2 xv = ((const u32x2*)xb)[i]; const f32x4 gv = ((const f32x4*)P.g_final)[c4];
        f32x4 v; v[0] = __uint_as_float(xv.x << 16); v[1] = __uint_as_float(xv.x & 0xffff0000u); v[2] = __uint_as_float(xv.y << 16); v[3] = __uint_as_float(xv.y & 0xffff0000u);
        ((f32x4*)P.out)[i] = v * rs * gv;
    }
}

extern "C" void kernel_launch(void* const* d_in, const int* in_sizes, int n_in, void* d_out, int out_size, void* d_ws, size_t ws_size, hipStream_t stream) {
    static int grid_blocks = 0;
    if (!grid_blocks) {
        if (n_in != 19 || ws_size < WS_END) { fprintf(stderr, "kernel_launch: unexpected n_in %d / ws %zu\n", n_in, ws_size); grid_blocks = -1; return; }
        int dev = 0, cus = 0, per_cu = 0;
        hipGetDevice(&dev);
        hipDeviceGetAttribute(&cus, hipDeviceAttributeMultiprocessorCount, dev);
        hipFuncSetAttribute((const void*)fwd_megakernel, hipFuncAttributeMaxDynamicSharedMemorySize, LDS_BYTES);
        hipOccupancyMaxActiveBlocksPerMultiprocessor(&per_cu, (const void*)fwd_megakernel, 512, LDS_BYTES);
        if (per_cu < 1) { fprintf(stderr, "kernel_launch: occupancy query says %d blocks/CU\n", per_cu); per_cu = 1; }
        grid_blocks = cus * per_cu;
    }
    if (grid_blocks < 0) return;
    Params p{};
    const float** f = (const float**)&p;
    for (int i = 0; i < 19; ++i) f[i] = (const float*)d_in[i];
    p.out = (float*)d_out; p.ws = (unsigned char*)d_ws;
    (void)hipMemsetAsync((char*)d_ws + WS_BAR, 0, WS_BAR_BYTES, stream);
    void* args[] = {&p};
    hipError_t e = hipLaunchCooperativeKernel((const void*)fwd_megakernel, dim3(grid_blocks), dim3(512), args, LDS_BYTES, stream);
    if (e != hipSuccess) fprintf(stderr, "cooperative launch failed: %s (grid %d)\n", hipGetErrorString(e), grid_blocks);
}
```

```cpp
#include <hip/hip_runtime.h>
#include <hip/hip_cooperative_groups.h>
#include <cstdint>
#include <cstdio>
namespace cg = cooperative_groups;

#define LAS __attribute__((address_space(3)))
typedef unsigned short bf16_t;
typedef short bf16x8 __attribute__((ext_vector_type(8)));
typedef short s16x4 __attribute__((ext_vector_type(4)));
typedef float f32x4 __attribute__((ext_vector_type(4)));
typedef float f32x2 __attribute__((ext_vector_type(2)));
typedef float f32x16 __attribute__((ext_vector_type(16)));
typedef unsigned u32x4 __attribute__((ext_vector_type(4)));
typedef unsigned u32x2 __attribute__((ext_vector_type(2)));
typedef __bf16 bf16x2_t __attribute__((ext_vector_type(2)));

constexpr int T_TOK = 32768, SEQ = 2048, DM = 1024, DEPTH = 4;
constexpr int NPROJW = 2048, NPROJ = 2112, NIN = 1952, DFF = 2816, NUP = 5632;
constexpr int NCQ = 768, NCKV = 1024, PCQ = 832, PCKV = 1088;
constexpr float EPS = 1e-6f;
constexpr float LOG2E = 1.4426950408889634f;

constexpr size_t MiB = 1u << 20;
constexpr size_t WS_BAR = 0, WS_BAR_BYTES = 16384;
constexpr size_t WS_LAM = 512 * 1024;
constexpr size_t WS_COS = 576 * 1024, WS_SIN = 704 * 1024;
constexpr size_t WS_W = 1 * MiB;
constexpr size_t W_IN = 0, W_OUT = W_IN + (size_t)NPROJW * DM * 2, W_UP = W_OUT + (size_t)DM * DM * 2, W_DOWN = W_UP + (size_t)NUP * DM * 2,
                 W_UQ = W_DOWN + (size_t)DM * DFF * 2, W_UKV = W_UQ + (size_t)NCQ * 256 * 2, W_LAYER = W_UKV + (size_t)NCKV * 128 * 2;
static_assert(W_LAYER * DEPTH <= 93 * MiB, "weights");
constexpr size_t WS_XB = 94 * MiB, WS_PROJ = 158 * MiB, WS_CQ = 290 * MiB, WS_CKV = 342 * MiB, WS_MIX = 410 * MiB;
constexpr size_t WS_SSQA = 474 * MiB, WS_SSQB = 476 * MiB, WS_SSQQ = 478 * MiB, WS_SSQKV = 479 * MiB, WS_END = 480 * MiB;
static_assert(WS_PROJ + (size_t)T_TOK * NPROJ * 2 <= WS_CQ && WS_CQ + (size_t)T_TOK * PCQ * 2 <= WS_CKV && WS_CKV + (size_t)T_TOK * PCKV * 2 <= WS_MIX, "attention tensors");
constexpr size_t WS_ACT = 158 * MiB, WS_UBND = 342 * MiB;
static_assert(WS_ACT + (size_t)T_TOK * DFF * 2 <= WS_UBND && WS_UBND + (size_t)512 * 4 * NUP * 2 <= WS_MIX, "overlay");

constexpr int LDS_BYTES = 147456;
#ifndef MK_SKIP
#define MK_SKIP 0
#endif
#ifndef MK_DUP_PRO
#define MK_DUP_PRO 1
#endif
#ifndef MK_DUP_SYNC
#define MK_DUP_SYNC 1
#endif
#ifndef MK_DUP_MLA
#define MK_DUP_MLA 1
#endif
#ifndef MK_DUP_BAR
#define MK_DUP_BAR 1
#endif
#ifndef MK_DUP_UP
#define MK_DUP_UP 1
#endif
#ifndef MK_DUP_IN
#define MK_DUP_IN 1
#endif
#ifndef MK_DUP_AB
#define MK_DUP_AB 1
#endif
#ifndef MK_DUP_C
#define MK_DUP_C 1
#endif

struct Params {
    const float* x; const float* w_in; const float* g_attn; const float* a_lq1; const float* a_lk1; const float* a_lq2; const float* a_lk2;
    const float* a_subln; const float* c_g_q; const float* c_w_uq; const float* c_g_kv; const float* c_w_ukv; const float* w_out; const float* g_ffn;
    const float* w_up; const float* conv_w; const float* conv_b; const float* w_down; const float* g_final;
    float* out; unsigned char* ws;
};

__device__ __forceinline__ unsigned cvtpk(float lo, float hi) { f32x2 v = {lo, hi}; bf16x2_t b = __builtin_convertvector(v, bf16x2_t); return __builtin_bit_cast(unsigned, b); }
__device__ __forceinline__ void st16_wt(void* p, u32x4 v) { *(u32x4*)p = v; }
__device__ __forceinline__ void st8_wt(void* p, u32x2 v) { *(u32x2*)p = v; }
__device__ __forceinline__ float bf2f(unsigned short b) { return __uint_as_float((unsigned)b << 16); }
__device__ __forceinline__ float wave_sum(float v) {
#pragma unroll
    for (int o = 1; o < 64; o <<= 1) v += __shfl_xor(v, o);
    return v;
}
__device__ __forceinline__ float ld_agent(const float* p) { return __hip_atomic_load(p, __ATOMIC_RELAXED, __HIP_MEMORY_SCOPE_AGENT); }
template <int NS> __device__ __forceinline__ float ssq_sum(const float* p) {
    float t = 0.f;
#pragma unroll
    for (int i = 0; i < NS / 4; ++i) { const f32x4 v = *(const f32x4*)(p + 4 * i); t += (v[0] + v[1]) + (v[2] + v[3]); }
    return t;
}
__device__ __forceinline__ float fast_exp2(float x) { return __builtin_amdgcn_exp2f(x); }
__device__ __forceinline__ float fast_rcp(float x) { return __builtin_amdgcn_rcpf(x); }

namespace pg8 {
constexpr int BM = 256, BK = 64, HALF = 128, HTB = HALF * BK * 2, STAGE_BYTES = 8 * HTB, NXCD = 8, WGM = 8;
__host__ __device__ __forceinline__ int lds_byte(int r, int c) { const int st = (r >> 4) * 2 + (c >> 5), rr = r & 15, cc = c & 31, ob = rr * 64 + cc * 2; return st * 1024 + (ob ^ (((ob >> 9) & 1) << 5)); }
__host__ __device__ __forceinline__ void stage_rc(int b, int& R, int& C) { const int st = b / 1024, sb = b % 1024, swz = sb ^ (((sb >> 9) & 1) << 5); R = (st >> 1) * 16 + swz / 64; C = (st & 1) * 32 + (swz % 64) / 2; }
__host__ __device__ __forceinline__ int perm32(int rho) { const int n = rho >> 4, i = rho & 15; return 8 * (i >> 2) + 4 * n + (i & 3); }
struct Unit { int pm, pn; };
struct Gemm { const bf16_t* A; const bf16_t* Bt; int M, N, K, lda; };
struct StaticOrder {
    int nM, nN, nwg, G, c;
    __device__ void init(int M, int N, int G_, int c_) { nM = M / BM; nN = N / BM; nwg = nM * nN; G = G_; c = c_; }
    __device__ bool next(int i, Unit& u) const {
        const long L = (long)i * G + c; if (L >= nwg) return false;
        int wgid = (int)L; { const int q = nwg / NXCD, r = nwg % NXCD, xcd = wgid % NXCD, off = wgid / NXCD; wgid = (xcd < r ? xcd * (q + 1) : r * (q + 1) + (xcd - r) * q) + off; }
        const int nig = WGM * nN, gid = wgid / nig, fm = gid * WGM, gsz = (nM - fm) < WGM ? (nM - fm) : WGM;
        u.pm = fm + ((wgid % nig) % gsz); u.pn = (wgid % nig) / gsz; return true;
    }
};

template <class Epi>
__device__ __forceinline__ void gemm_phase(LAS unsigned char* lds, const Gemm g, const Epi& E) {
    int tid = threadIdx.x; asm volatile("" : "+v"(tid));
    const int wid = __builtin_amdgcn_readfirstlane(tid >> 6), lane = tid & 63, wr = wid >> 2, wc = wid & 3, fr = lane & 15, fq = lane >> 4;
    int K = g.K, lda = g.lda; asm volatile("" : "+s"(K), "+s"(lda));
    const int nt = K / BK;
    StaticOrder S; S.init(g.M, g.N, (int)gridDim.x, (int)blockIdx.x);
    unsigned voffA[2], voffB[2];
#pragma unroll
    for (int i = 0; i < 2; ++i) { int R, C; stage_rc(tid * 16 + i * 8192, R, C); const int Rb = Epi::PERM ? ((R & ~31) + perm32(R & 31)) : R;
        voffA[i] = (unsigned)(R * lda + C) * 2u; voffB[i] = (unsigned)(Rb * K + C) * 2u; }
    const size_t kstep = (size_t)(BK * 2);
    const size_t hstepA = (size_t)HALF * lda * 2, hstepB = (size_t)HALF * K * 2;
    const size_t tstepA = 2 * hstepA, tstepB = 2 * hstepB;
    const unsigned ldsw = (unsigned)wid * 1024u;
    const int aoff = lds_byte(wr * 64 + fr, fq * 8), boff = lds_byte(wc * 32 + fr, fq * 8);
#define PG8_SA(b, h) (((b) * 2 + (h)) * HTB)
#define PG8_SB(b, h) ((4 + (b) * 2 + (h)) * HTB)
#define PG8_STAGE(bufoff, gbase, voff) do { _Pragma("unroll") for (int _i = 0; _i < 2; ++_i) \
        __builtin_amdgcn_global_load_lds((const unsigned*)((const char*)(gbase) + (voff)[_i]), (LAS unsigned*)(lds + (bufoff) + ldsw + _i * 8192), 16, 0, 0); } while (0)
#define PG8_LDA(dst, b, h) do { _Pragma("unroll") for (int m = 0; m < 4; ++m) _Pragma("unroll") for (int k = 0; k < 2; ++k) dst[m][k] = *(const LAS bf16x8*)(lds + PG8_SA(b, h) + aoff + m * 2048 + k * 1024); } while (0)
#define PG8_LDB(dst, b, h) do { _Pragma("unroll") for (int n = 0; n < 2; ++n) _Pragma("unroll") for (int k = 0; k < 2; ++k) dst[n][k] = *(const LAS bf16x8*)(lds + PG8_SB(b, h) + boff + n * 2048 + k * 1024); } while (0)
#define PG8_MMA(ai, bj, At, Bt) do { __builtin_amdgcn_s_setprio(1); _Pragma("unroll") for (int m = 0; m < 4; ++m) _Pragma("unroll") for (int n = 0; n < 2; ++n) _Pragma("unroll") for (int k = 0; k < 2; ++k) \
        acc[ai][bj][m][n] = __builtin_amdgcn_mfma_f32_16x16x32_bf16(Bt[n][k], At[m][k], acc[ai][bj][m][n], 0, 0, 0); __builtin_amdgcn_s_setprio(0); } while (0)
#define PG8_WAIT_V(n) asm volatile("s_waitcnt vmcnt(" #n ")" ::: "memory")
#define PG8_WAIT_L(n) asm volatile("s_waitcnt lgkmcnt(" #n ")" ::: "memory")
#define PG8_BAR __builtin_amdgcn_s_barrier()
#define PG8_SCHED __builtin_amdgcn_sched_barrier(0)
    Unit cur, nxt; int ui = 0;
    if (!S.next(0, cur)) return;
    f32x4 acc[2][2][4][2];
#pragma unroll
    for (int a = 0; a < 2; ++a)
#pragma unroll
        for (int b = 0; b < 2; ++b)
#pragma unroll
            for (int m = 0; m < 4; ++m)
#pragma unroll
                for (int n = 0; n < 2; ++n) acc[a][b][m][n] = (f32x4){0.f, 0.f, 0.f, 0.f};
    bf16x8 At[4][2], B0[2][2], B1[2][2];
    const char* cA = (const char*)g.A + (size_t)cur.pm * tstepA; const char* cB = (const char*)g.Bt + (size_t)cur.pn * tstepB;
    PG8_STAGE(PG8_SB(0, 0), cB, voffB); PG8_STAGE(PG8_SB(0, 1), cB + hstepB, voffB); PG8_STAGE(PG8_SA(0, 0), cA, voffA); PG8_STAGE(PG8_SA(0, 1), cA + hstepA, voffA);
    if (wr == 1) PG8_BAR;
    PG8_WAIT_V(2); PG8_BAR;
    PG8_STAGE(PG8_SB(1, 0), cB + kstep, voffB); PG8_STAGE(PG8_SA(1, 0), cA + kstep, voffA); PG8_STAGE(PG8_SB(1, 1), cB + hstepB + kstep, voffB);
    PG8_WAIT_V(6); PG8_BAR;
    for (;;) {
        const bool has_next = S.next(ui + 1, nxt);
        const char* nA = has_next ? (const char*)g.A + (size_t)nxt.pm * tstepA : cA; const char* nB = has_next ? (const char*)g.Bt + (size_t)nxt.pn * tstepB : cB;
        for (int t = 0; t < nt; t += 2) {
            const bool last = (t == nt - 2);
            const char* a1 = cA + (size_t)(t + 1) * kstep;
            const char* a2 = last ? nA : cA + (size_t)(t + 2) * kstep; const char* b2 = last ? nB : cB + (size_t)(t + 2) * kstep;
            const char* a3 = a2 + kstep; const char* b3 = b2 + kstep;
            PG8_LDB(B0, 0, 0); PG8_LDB(B1, 0, 1); PG8_SCHED; PG8_LDA(At, 0, 0); PG8_STAGE(PG8_SA(1, 1), a1 + hstepA, voffA);
            PG8_WAIT_V(8); PG8_WAIT_L(0); PG8_BAR; PG8_MMA(0, 0, At, B0); PG8_MMA(0, 1, At, B1); PG8_BAR; PG8_SCHED;
            PG8_LDA(At, 0, 1); PG8_STAGE(PG8_SB(0, 0), b2, voffB); PG8_STAGE(PG8_SB(0, 1), b2 + hstepB, voffB); PG8_STAGE(PG8_SA(0, 0), a2, voffA);
            PG8_WAIT_V(8); PG8_WAIT_L(0); PG8_BAR; PG8_MMA(1, 0, At, B0); PG8_MMA(1, 1, At, B1); PG8_BAR; PG8_SCHED;
            PG8_LDB(B0, 1, 0); PG8_LDB(B1, 1, 1); PG8_SCHED; PG8_LDA(At, 1, 0); PG8_STAGE(PG8_SA(0, 1), a2 + hstepA, voffA);
            PG8_WAIT_V(8); PG8_WAIT_L(0); PG8_BAR; PG8_MMA(0, 0, At, B0); PG8_MMA(0, 1, At, B1); PG8_BAR; PG8_SCHED;
            PG8_LDA(At, 1, 1); PG8_STAGE(PG8_SB(1, 0), b3, voffB); PG8_STAGE(PG8_SB(1, 1), b3 + hstepB, voffB); PG8_STAGE(PG8_SA(1, 0), a3, voffA);
            PG8_WAIT_V(8); PG8_WAIT_L(0); PG8_BAR; PG8_MMA(1, 0, At, B0); PG8_MMA(1, 1, At, B1); PG8_BAR; PG8_SCHED;
        }
        if (wr == 0) PG8_BAR;
        E(acc, cur, wr, wc, fr, fq);
        if (!has_next) break;
#pragma unroll
        for (int a = 0; a < 2; ++a)
#pragma unroll
            for (int b = 0; b < 2; ++b)
#pragma unroll
                for (int m = 0; m < 4; ++m)
#pragma unroll
                    for (int n = 0; n < 2; ++n) acc[a][b][m][n] = (f32x4){0.f, 0.f, 0.f, 0.f};
        cur = nxt; cA = nA; cB = nB; ++ui;
        if (wr == 1) PG8_BAR;
    }
    PG8_WAIT_V(0);
    PG8_BAR;
#undef PG8_SA
#undef PG8_SB
#undef PG8_STAGE
#undef PG8_LDA
#undef PG8_LDB
#undef PG8_MMA
#undef PG8_WAIT_V
#undef PG8_WAIT_L
#undef PG8_BAR
#undef PG8_SCHED
}
}
using pg8::Unit;
typedef f32x4 (&AccRef)[2][2][4][2];

__device__ __forceinline__ void rope8(f32x4& v0, f32x4& v1, const float* cosr, const float* sinr, int fq) {
    const int j0 = 8 * (fq & 1);
    const f32x4 c0 = *(const f32x4*)(cosr + j0), c1 = *(const f32x4*)(cosr + j0 + 4), s0 = *(const f32x4*)(sinr + j0), s1 = *(const f32x4*)(sinr + j0 + 4);
    const float sg = (fq < 2) ? -1.f : 1.f;
#pragma unroll
    for (int i = 0; i < 4; ++i) {
        const float p0 = __shfl_xor(v0[i], 32), p1 = __shfl_xor(v1[i], 32);
        v0[i] = v0[i] * c0[i] + sg * p0 * s0[i]; v1[i] = v1[i] * c1[i] + sg * p1 * s1[i];
    }
}

struct EpiProj {
    static constexpr bool PERM = true;
    bf16_t* O; const float* ssqx; float* ssqq; float* ssqkv; const float* cost; const float* sint;
    __device__ __forceinline__ void operator()(AccRef acc, const Unit& u, int wr, int wc, int fr, int fq) const {
        const int row0 = u.pm * 256 + wr * 64 + fr, col0 = u.pn * 256 + wc * 32 + 8 * fq;
#pragma unroll
        for (int ai = 0; ai < 2; ++ai)
#pragma unroll
            for (int m = 0; m < 4; ++m) {
                const int row = row0 + ai * 128 + m * 16;
                const float rs = rsqrtf(ssq_sum<16>(ssqx + (size_t)row * 16) * (1.0f / DM) + EPS);
                bf16_t* rowp = O + (size_t)row * NPROJ + col0;
#pragma unroll
                for (int bj = 0; bj < 2; ++bj) {
                    f32x4 v0 = acc[ai][bj][m][0] * rs, v1 = acc[ai][bj][m][1] * rs;
                    if (u.pn == 6 || (u.pn == 7 && bj == 0)) {
                        float s = (v0[0] * v0[0] + v0[1] * v0[1]) + (v0[2] * v0[2] + v0[3] * v0[3]) + (v1[0] * v1[0] + v1[1] * v1[1]) + (v1[2] * v1[2] + v1[3] * v1[3]);
                        s += __shfl_xor(s, 16); s += __shfl_xor(s, 32);
                        if (fq == 0) { if (u.pn == 6) ssqq[(size_t)row * 8 + bj * 4 + wc] = s; else ssqkv[(size_t)row * 4 + wc] = s; }
                    }
                    if (u.pn == 7 && bj == 1 && wc == 0) { const int pos = row & (SEQ - 1); rope8(v0, v1, cost + pos * 16, sint + pos * 16, fq); }
                    u32x4 w; w.x = cvtpk(v0[0], v0[1]); w.y = cvtpk(v0[2], v0[3]); w.z = cvtpk(v1[0], v1[1]); w.w = cvtpk(v1[2], v1[3]);
                    st16_wt(rowp + bj * 128, w);
                }
                asm volatile("" ::: "memory");
            }
    }
};
template <bool ROPE, int NS> struct EpiMla {
    static constexpr bool PERM = true;
    bf16_t* O; int ldc; const float* ssq; float inv_n; const float* cost; const float* sint;
    __device__ __forceinline__ void operator()(AccRef acc, const Unit& u, int wr, int wc, int fr, int fq) const {
        const int row0 = u.pm * 256 + wr * 64 + fr, col0 = u.pn * 256 + wc * 32 + 8 * fq;
#pragma unroll
        for (int ai = 0; ai < 2; ++ai)
#pragma unroll
            for (int m = 0; m < 4; ++m) {
                const int row = row0 + ai * 128 + m * 16;
                const float rs = rsqrtf(ssq_sum<NS>(ssq + (size_t)row * NS) * inv_n + EPS);
                bf16_t* rowp = O + (size_t)row * ldc + col0;
#pragma unroll
                for (int bj = 0; bj < 2; ++bj) {
                    f32x4 v0 = acc[ai][bj][m][0] * rs, v1 = acc[ai][bj][m][1] * rs;
                    if (ROPE) { const int g32 = u.pn * 8 + bj * 4 + wc; if (g32 % 3 == 2) { const int pos = row & (SEQ - 1); rope8(v0, v1, cost + pos * 16, sint + pos * 16, fq); } }
                    u32x4 w; w.x = cvtpk(v0[0], v0[1]); w.y = cvtpk(v0[2], v0[3]); w.z = cvtpk(v1[0], v1[1]); w.w = cvtpk(v1[2], v1[3]);
                    st16_wt(rowp + bj * 128, w);
                }
                asm volatile("" ::: "memory");
            }
    }
};
struct EpiResid {
    static constexpr bool PERM = true;
    bf16_t* XB; float* ssq;
    __device__ __forceinline__ void operator()(AccRef acc, const Unit& u, int wr, int wc, int fr, int fq) const {
        const int row0 = u.pm * 256 + wr * 64 + fr, col0 = u.pn * 256 + wc * 32 + 8 * fq;
#pragma unroll
        for (int ai = 0; ai < 2; ++ai)
#pragma unroll
            for (int m = 0; m < 4; ++m) {
                const int row = row0 + ai * 128 + m * 16; bf16_t* rowp = XB + (size_t)row * DM + col0; float s = 0.f;
#pragma unroll
                for (int bj = 0; bj < 2; ++bj) {
                    const u32x4 xo = *(const u32x4*)(rowp + bj * 128);
                    float v[8];
#pragma unroll
                    for (int k = 0; k < 4; ++k) { v[2 * k] = __uint_as_float(xo[k] << 16) + acc[ai][bj][m][k >> 1][(2 * k) & 3]; v[2 * k + 1] = __uint_as_float(xo[k] & 0xffff0000u) + acc[ai][bj][m][k >> 1][(2 * k + 1) & 3]; }
#pragma unroll
                    for (int k = 0; k < 8; ++k) s += v[k] * v[k];
                    u32x4 w; w.x = cvtpk(v[0], v[1]); w.y = cvtpk(v[2], v[3]); w.z = cvtpk(v[4], v[5]); w.w = cvtpk(v[6], v[7]);
                    st16_wt(rowp + bj * 128, w);
                }
                s += __shfl_xor(s, 16); s += __shfl_xor(s, 32);
                if (fq == 0) ssq[(size_t)row * 16 + u.pn * 4 + wc] = s;
                asm volatile("" ::: "memory");
            }
    }
};
template <int CTRL> __device__ __forceinline__ float dpp_rot(float v) { return __int_as_float(__builtin_amdgcn_update_dpp(__float_as_int(v), __float_as_int(v), CTRL, 0xf, 0xf, false)); }
struct EpiUp {
    static constexpr bool PERM = true;
    bf16_t* ACT; bf16_t* UB; const float* ssqx; const float* cw; const float* cb;
    __device__ __forceinline__ void operator()(AccRef acc, const Unit& u, int wr, int wc, int fr, int fq) const {
        const int row0 = u.pm * 256 + wr * 64 + fr, gcol = u.pn * 128 + wc * 32 + 8 * fq;
#pragma unroll
        for (int ai = 0; ai < 2; ++ai) {
#pragma unroll
            for (int m = 0; m < 4; ++m) {
                const float rs = rsqrtf(ssq_sum<16>(ssqx + (size_t)(row0 + ai * 128 + m * 16) * 16) * (1.0f / DM) + EPS);
#pragma unroll
                for (int bj = 0; bj < 2; ++bj) { acc[ai][bj][m][0] = acc[ai][bj][m][0] * rs; acc[ai][bj][m][1] = acc[ai][bj][m][1] * rs; }
            }
            asm volatile("" ::: "memory");
            const int chunk = u.pm * 4 + ai * 2 + wr;
#pragma unroll
            for (int e = 0; e < 2; ++e) {
                const int m = e ? 3 : 0;
                const bool mine = e ? (fr >= 14) : (fr <= 1);
                const int slot = e ? (fr - 12) : fr;
                if (mine) {
#pragma unroll
                    for (int bj = 0; bj < 2; ++bj) {
                        const f32x4 v0 = acc[ai][bj][m][0], v1 = acc[ai][bj][m][1];
                        u32x4 w; w.x = cvtpk(v0[0], v0[1]); w.y = cvtpk(v0[2], v0[3]); w.z = cvtpk(v1[0], v1[1]); w.w = cvtpk(v1[2], v1[3]);
                        *(u32x4*)(UB + ((size_t)chunk * 4 + slot) * NUP + bj * DFF + gcol) = w;
                    }
                }
            }
            asm volatile("" ::: "memory");
#pragma unroll
            for (int n = 0; n < 2; ++n) {
                unsigned wpk[4][2]; float rlo[4];
#pragma unroll
                for (int i = 0; i < 4; ++i) {
                    const int cg_ = gcol + 4 * n + i, cv_ = cg_ + DFF;
                    const float g0 = cw[cg_], g1 = cw[NUP + cg_], g2 = cw[2 * NUP + cg_], gb = cb[cg_];
                    const float h0 = cw[cv_], h1 = cw[NUP + cv_], h2 = cw[2 * NUP + cv_], hb = cb[cv_];
                    float gt[4];
                    {
                        float pg[4], ng[4];
#pragma unroll
                        for (int m = 0; m < 4; ++m) { pg[m] = dpp_rot<0x121>(acc[ai][0][m][n][i]); ng[m] = dpp_rot<0x12F>(acc[ai][0][m][n][i]); }
#pragma unroll
                        for (int m = 0; m < 4; ++m) {
                            const float gp = (fr == 0) ? (m ? pg[m - 1] : 0.f) : pg[m], gn = (fr == 15) ? (m < 3 ? ng[m + 1] : 0.f) : ng[m];
                            const float t = g0 * gp + g1 * acc[ai][0][m][n][i] + g2 * gn + gb;
                            gt[m] = t * fast_rcp(1.f + fast_exp2(-LOG2E * t));
                        }
                    }
                    asm volatile("" : "+v"(gt[0]), "+v"(gt[1]), "+v"(gt[2]), "+v"(gt[3]));
                    {
                        float pv[4], nv[4];
#pragma unroll
                        for (int m = 0; m < 4; ++m) { pv[m] = dpp_rot<0x121>(acc[ai][1][m][n][i]); nv[m] = dpp_rot<0x12F>(acc[ai][1][m][n][i]); }
#pragma unroll
                        for (int m = 0; m < 4; ++m) {
                            const float vp = (fr == 0) ? (m ? pv[m - 1] : 0.f) : pv[m], vn = (fr == 15) ? (m < 3 ? nv[m + 1] : 0.f) : nv[m];
                            const float vl = h0 * vp + h1 * acc[ai][1][m][n][i] + h2 * vn + hb;
                            const float rv = gt[m] * vl;
                            if (i & 1) wpk[m][i >> 1] = cvtpk(rlo[m], rv); else rlo[m] = rv;
                        }
                    }
                    asm volatile("" ::: "memory");
                }
#pragma unroll
                for (int m = 0; m < 4; ++m) { u32x2 w; w.x = wpk[m][0]; w.y = wpk[m][1];
                    st8_wt(ACT + (size_t)(row0 + ai * 128 + m * 16) * DFF + gcol + 4 * n, w); }
                asm volatile("" ::: "memory");
            }
        }
    }
};

constexpr int AT_BUF = 20480, AT_V = 12288, AT_TAB = 3 * AT_BUF;
__device__ __forceinline__ float xmax(float a) { auto rr = __builtin_amdgcn_permlane32_swap(__float_as_uint(a), __float_as_uint(a), false, false); return fmaxf(__uint_as_float(rr[0]), __uint_as_float(rr[1])); }
__device__ __forceinline__ float xsum(float a) { auto rr = __builtin_amdgcn_permlane32_swap(__float_as_uint(a), __float_as_uint(a), false, false); return __uint_as_float(rr[0]) + __uint_as_float(rr[1]); }
typedef short v4i16_t __attribute__((ext_vector_type(4)));
__device__ __forceinline__ s16x4 vtr(const LAS unsigned char* p) { return __builtin_bit_cast(s16x4, __builtin_amdgcn_ds_read_tr16_b64_v4i16((LAS v4i16_t*)p)); }

template <int MODE, int NQ>
__device__ __forceinline__ void attn_unit(LAS unsigned char* lds, const Params& P, int layer, int b, int h, int qb) {
    constexpr int NMAP = (MODE == 1) ? 2 : 1, ND0 = (MODE == 0) ? 6 : (MODE == 1 ? 2 : 4), NC = NQ * NMAP, QROWS = 256 * NQ;
    int tid = threadIdx.x; asm volatile("" : "+v"(tid));
    const int lane = tid & 63, r32 = lane & 31, hi = lane >> 5, wave = __builtin_amdgcn_readfirstlane(tid >> 6);
    const bf16_t* proj = (const bf16_t*)(P.ws + WS_PROJ); const bf16_t* cq = (const bf16_t*)(P.ws + WS_CQ); const bf16_t* ckv = (const bf16_t*)(P.ws + WS_CKV);
    bf16_t* mix = (bf16_t*)(P.ws + WS_MIX);
    const size_t rowbase = (size_t)b * SEQ; const int q0 = qb * QROWS;
    const bf16_t *Qp, *Kp, *Vp; int qpitch, kpitch, vpitch, ocol; float c;
    if (MODE == 0) { Qp = cq + h * 96; qpitch = PCQ; Kp = ckv + h * 128; kpitch = PCKV; Vp = ckv + h * 128 + 64; vpitch = PCKV; ocol = 512 + h * 64; c = 0.10206207261596577f * LOG2E; }
    else if (MODE == 1) { Qp = proj + h * 64; qpitch = NPROJ; Kp = proj + 256 + h * 64; kpitch = NPROJ; Vp = proj + 512 + h * 64; vpitch = NPROJ; ocol = h * 64; c = 0.17677669529663687f * LOG2E; }
    else { Qp = proj + 768 + h * 64; qpitch = NPROJ; Kp = proj + 1024 + h * 64; kpitch = NPROJ; Vp = proj + 1280 + h * 64; vpitch = NPROJ; ocol = 256 + h * 64; c = 0.125f * LOG2E; }
    int kt0 = 0, kt1 = SEQ / 64;
    if (MODE == 2) { kt0 = (q0 - 1024) / 64; if (kt0 < 0) kt0 = 0; kt1 = (q0 + QROWS + 1024) / 64; if (kt1 > SEQ / 64) kt1 = SEQ / 64; }
    LAS float* tab = (LAS float*)(lds + AT_TAB);
    if (MODE != 0) {
        const float slope = (MODE == 1) ? exp2f(-(float)(2 * h + 1)) : exp2f(-(float)(2 * h + 2));
        for (int j = tid; j < 4096; j += 512) {
            const int d = (j > 2047) ? (j - 2047) : (2047 - j);
            float v = -slope * LOG2E * (float)d;
            if (MODE == 2) {
                const int mult = (d <= 64 ? 1 : 0) + (((d & 3) == 0 && d <= 256) ? 1 : 0) + (((d & 15) == 0 && d <= 1024) ? 1 : 0);
                v = (mult == 0) ? -1e30f : (mult == 1 ? v : (mult == 2 ? v + 1.0f : v + 1.5849625007211562f));
            }
            tab[j] = v;
        }
    }
    const int qpos0 = q0 + wave * (32 * NQ) + r32;
    bf16x8 qf[NC][ND0];
#pragma unroll
    for (int jq = 0; jq < NQ; ++jq) {
        const bf16_t* qrow = Qp + (rowbase + qpos0 + 32 * jq) * qpitch + hi * 8;
#pragma unroll
        for (int mp = 0; mp < NMAP; ++mp)
#pragma unroll
            for (int d0 = 0; d0 < ND0; ++d0) qf[jq * NMAP + mp][d0] = *(const bf16x8*)(qrow + mp * 32 + d0 * 16);
    }
    u32x4 kreg, kreg2 = (u32x4){0u, 0u, 0u, 0u}, vreg;
#define AT_GLOADK(kt) do { const size_t r_ = rowbase + (size_t)(kt) * 64; \
        kreg = *(const u32x4*)(Kp + (r_ + lane) * kpitch + wave * 8); \
        if (MODE == 0 && wave < 4) kreg2 = *(const u32x4*)(proj + (r_ + lane) * NPROJ + 1920 + wave * 8); } while (0)
#define AT_GLOADV(kt) do { const size_t r_ = rowbase + (size_t)(kt) * 64; \
        vreg = *(const u32x4*)(Vp + (r_ + 16 * (wave & 3) + (lane >> 2)) * vpitch + (wave >> 2) * 32 + (lane & 3) * 8); } while (0)
#define AT_LSTOREK(buf) do { LAS unsigned char* d_ = lds + (buf) * AT_BUF; \
        *(LAS u32x4*)(d_ + wave * 1024 + lane * 16) = kreg; \
        if (MODE == 0 && wave < 4) *(LAS u32x4*)(d_ + (8 + wave) * 1024 + lane * 16) = kreg2; } while (0)
#define AT_LSTOREV(buf) do { LAS unsigned char* d_ = lds + (buf) * AT_BUF; \
        *(LAS u32x4*)(d_ + AT_V + wave * 1024 + lane * 16) = vreg; } while (0)
    float mrun[NC], lrun[NC]; f32x16 o[NC][2];
#pragma unroll
    for (int cc = 0; cc < NC; ++cc) { mrun[cc] = -1e20f; lrun[cc] = 0.f; o[cc][0] = f32x16{}; o[cc][1] = f32x16{}; }
    constexpr int NK = NMAP * ND0;
    const bf16x8 ones8 = (bf16x8){0x3F80, 0x3F80, 0x3F80, 0x3F80, 0x3F80, 0x3F80, 0x3F80, 0x3F80};
    bf16x8 kf[NK]; s16x4 vlo[4], vhi[4];
#define AT_KLOAD(bufbase, hf) do { _Pragma("unroll") for (int j_ = 0; j_ < NK; ++j_) kf[j_] = *(const LAS bf16x8*)((bufbase) + (2 * j_ + hi) * 1024 + (hf) * 512 + r32 * 16); } while (0)
#define AT_VLOAD(bufbase, hf) do { _Pragma("unroll") for (int dv_ = 0; dv_ < 2; ++dv_) _Pragma("unroll") for (int k2_ = 0; k2_ < 2; ++k2_) { \
        vlo[dv_ * 2 + k2_] = vtr((bufbase) + AT_V + vlane + dv_ * 4096 + (2 * (hf) + k2_) * 1024); vhi[dv_ * 2 + k2_] = vtr((bufbase) + AT_V + vlane + dv_ * 4096 + (2 * (hf) + k2_) * 1024 + 512); } } while (0)
    const int vlane = ((lane >> 4) & 1) * 32 + (lane & 3) * 8 + (4 * hi + ((lane & 15) >> 2)) * 64;
    AT_GLOADK(kt0); AT_GLOADV(kt0); AT_LSTOREK(0); AT_LSTOREV(0);
    if (kt0 + 1 < kt1) { AT_GLOADK(kt0 + 1); AT_GLOADV(kt0 + 1); AT_LSTOREK(1); AT_LSTOREV(1); }
    __syncthreads();
    AT_KLOAD(lds, 0);
    int bcur = 0;
    for (int kt = kt0; kt < kt1; ++kt) {
        const int bnx = (bcur == 2) ? 0 : bcur + 1, bn2 = (bnx == 2) ? 0 : bnx + 1;
        const LAS unsigned char* cur = lds + bcur * AT_BUF;
        const LAS unsigned char* nxt = lds + bnx * AT_BUF;
#pragma unroll
        for (int hf = 0; hf < 2; ++hf) {
            if (kt + 2 < kt1) { if (hf == 0) AT_GLOADK(kt + 2); else AT_GLOADV(kt + 2); }
            f32x16 sc[NC];
#pragma unroll
            for (int cc = 0; cc < NC; ++cc) {
                sc[cc] = f32x16{};
#pragma unroll
                for (int d0 = 0; d0 < ND0; ++d0) sc[cc] = __builtin_amdgcn_mfma_f32_32x32x16_bf16(kf[(cc % NMAP) * ND0 + d0], qf[cc][d0], sc[cc], 0, 0, 0);
            }
            __builtin_amdgcn_sched_barrier(0);
            AT_VLOAD(cur, hf);
            if (hf == 0) AT_KLOAD(cur, 1); else if (kt + 1 < kt1) AT_KLOAD(nxt, 0);
            __builtin_amdgcn_sched_barrier(0);
            bf16x8 pw[NC][2];
#pragma unroll
            for (int cc = 0; cc < NC; ++cc) {
                f32x16& s0 = sc[cc];
                float mn;
                if (MODE != 0) {
                    const LAS float* tp = tab + (kt * 64 + hf * 32 + 4 * hi - (qpos0 + 32 * (cc / NMAP)) + 2047);
                    float rm = -3e38f;
#pragma unroll
                    for (int r = 0; r < 16; ++r) { s0[r] = s0[r] * c + tp[(r & 3) + 8 * (r >> 2)]; rm = fmaxf(rm, s0[r]); }
                    rm = xmax(rm);
                    mn = fmaxf(mrun[cc], rm);
                } else {
                    float rm = -3e38f;
#pragma unroll
                    for (int r = 0; r < 16; ++r) rm = fmaxf(rm, s0[r]);
                    rm = xmax(rm);
                    mn = fmaxf(mrun[cc], rm * c);
                }
                if (__any(mn > mrun[cc])) {
                    const float al = fast_exp2(mrun[cc] - mn); lrun[cc] *= al;
#pragma unroll
                    for (int r = 0; r < 16; ++r) { o[cc][0][r] *= al; o[cc][1][r] *= al; }
                    mrun[cc] = mn;
                }
                if (MODE != 0) {
#pragma unroll
                    for (int r = 0; r < 16; ++r) s0[r] = fast_exp2(s0[r] - mn);
                } else {
                    const float nm = -mn;
#pragma unroll
                    for (int r = 0; r < 16; ++r) s0[r] = fast_exp2(__builtin_fmaf(s0[r], c, nm));
                }
                u32x4 w;
                w.x = cvtpk(s0[0], s0[1]); w.y = cvtpk(s0[2], s0[3]); w.z = cvtpk(s0[4], s0[5]); w.w = cvtpk(s0[6], s0[7]); pw[cc][0] = __builtin_bit_cast(bf16x8, w);
                w.x = cvtpk(s0[8], s0[9]); w.y = cvtpk(s0[10], s0[11]); w.z = cvtpk(s0[12], s0[13]); w.w = cvtpk(s0[14], s0[15]); pw[cc][1] = __builtin_bit_cast(bf16x8, w);
                f32x16 t = __builtin_amdgcn_mfma_f32_32x32x16_bf16(ones8, pw[cc][0], f32x16{}, 0, 0, 0);
                t = __builtin_amdgcn_mfma_f32_32x32x16_bf16(ones8, pw[cc][1], t, 0, 0, 0);
                lrun[cc] += t[0];
            }
#pragma unroll
            for (int dv = 0; dv < 2; ++dv)
#pragma unroll
                for (int k2 = 0; k2 < 2; ++k2) {
                    const s16x4 lo = vlo[dv * 2 + k2], hh = vhi[dv * 2 + k2];
                    const bf16x8 vf = (bf16x8){lo[0], lo[1], lo[2], lo[3], hh[0], hh[1], hh[2], hh[3]};
#pragma unroll
                    for (int cc = 0; cc < NC; ++cc) o[cc][dv] = __builtin_amdgcn_mfma_f32_32x32x16_bf16(vf, pw[cc][k2], o[cc][dv], 0, 0, 0);
                }
            if (kt + 2 < kt1) { if (hf == 0) AT_LSTOREK(bn2); else AT_LSTOREV(bn2); }
        }
        __syncthreads();
        bcur = bnx;
    }
#undef AT_KLOAD
#undef AT_VLOAD
#undef AT_GLOADK
#undef AT_GLOADV
#undef AT_LSTOREK
#undef AT_LSTOREV
    if (MODE != 1) {
#pragma unroll
        for (int jq = 0; jq < NQ; ++jq) {
            bf16_t* orow = mix + (rowbase + qpos0 + 32 * jq) * DM + ocol + 4 * hi;
            const float inv = 1.f / lrun[jq];
#pragma unroll
            for (int d = 0; d < 2; ++d)
#pragma unroll
                for (int g = 0; g < 4; ++g) {
                    u32x2 w; w.x = cvtpk(o[jq][d][4 * g] * inv, o[jq][d][4 * g + 1] * inv); w.y = cvtpk(o[jq][d][4 * g + 2] * inv, o[jq][d][4 * g + 3] * inv);
                    *(u32x2*)(orow + 32 * d + 8 * g) = w;
                }
        }
    } else {
        bf16_t* orow = mix + (rowbase + qpos0) * DM + ocol + 4 * hi;
        const float lam = __hip_atomic_load((const float*)(P.ws + WS_LAM) + layer, __ATOMIC_RELAXED, __HIP_MEMORY_SCOPE_AGENT);
        const float lam_init = 0.8f - 0.6f * expf(-0.3f * (float)layer);
        const float i1 = 1.f / lrun[0], i2 = lam / lrun[NC - 1];
        float ss = 0.f;
#pragma unroll
        for (int d = 0; d < 2; ++d)
#pragma unroll
            for (int r = 0; r < 16; ++r) { const float v = o[0][d][r] * i1 - o[NC - 1][d][r] * i2; o[0][d][r] = v; ss += v * v; }
        ss = xsum(ss);
        const float sc_ = rsqrtf(ss * (1.0f / 64.0f) + EPS) * (1.f - lam_init);
        const float* gn = P.a_subln + layer * 64 + 4 * hi;
#pragma unroll
        for (int d = 0; d < 2; ++d)
#pragma unroll
            for (int g = 0; g < 4; ++g) {
                const f32x4 gv = *(const f32x4*)(gn + 32 * d + 8 * g);
                u32x2 w; w.x = cvtpk(o[0][d][4 * g] * sc_ * gv[0], o[0][d][4 * g + 1] * sc_ * gv[1]); w.y = cvtpk(o[0][d][4 * g + 2] * sc_ * gv[2], o[0][d][4 * g + 3] * sc_ * gv[3]);
                *(u32x2*)(orow + 32 * d + 8 * g) = w;
            }
    }
}

__device__ __forceinline__ void transpose_item(const float* W, int K, int Nsrc, const float* g, bf16_t* WT, int n0_dst, int n0_src, int k0, LAS float* scr, int lane) {
    float tv[32];
#pragma unroll
    for (int i = 0; i < 32; ++i) { const int kk = 2 * i + (lane >> 5); tv[i] = (n0_src >= 0) ? W[(size_t)(k0 + kk) * Nsrc + n0_src + (lane & 31)] : 0.f; }
    if (g) {
#pragma unroll
        for (int i = 0; i < 32; ++i) tv[i] *= g[k0 + 2 * i + (lane >> 5)];
    }
#pragma unroll
    for (int i = 0; i < 32; ++i) scr[(2 * i + (lane >> 5)) * 33 + (lane & 31)] = tv[i];
    asm volatile("s_waitcnt lgkmcnt(0)" ::: "memory");
    const int c = lane & 7;
#pragma unroll
    for (int j = 0; j < 4; ++j) { const int n = (lane >> 3) + 8 * j; const LAS float* s = scr + (8 * c) * 33 + n;
        u32x4 o; o.x = cvtpk(s[0 * 33], s[1 * 33]); o.y = cvtpk(s[2 * 33], s[3 * 33]); o.z = cvtpk(s[4 * 33], s[5 * 33]); o.w = cvtpk(s[6 * 33], s[7 * 33]);
        *(u32x4*)(WT + (size_t)(n0_dst + n) * K + k0 + 8 * c) = o; }
    asm volatile("s_waitcnt lgkmcnt(0)" ::: "memory");
}

__device__ __forceinline__ void zero_f32(float* p, int n) { for (int i = blockIdx.x * 512 + threadIdx.x; i < n; i += gridDim.x * 512) p[i] = 0.f; }

__device__ __forceinline__ void prologue(const Params& P, LAS unsigned char* lds) {
    const int tid = threadIdx.x, lane = tid & 63, wave = tid >> 6;
    const int gw = blockIdx.x * 8 + wave, NGW = gridDim.x * 8;
    LAS float* scr = (LAS float*)(lds + wave * 16384);
    constexpr int I_IN = 16 * 64, I_OUT = 16 * 32, I_UP = 16 * 176, I_DN = 44 * 32, I_UQ = 4 * 24, I_UKV = 2 * 32, I_L = I_IN + I_OUT + I_UP + I_DN + I_UQ + I_UKV;
    for (int it = gw; it < I_L * DEPTH; it += NGW) {
        const int l = it / I_L; int r = it % I_L;
        unsigned char* wl = P.ws + WS_W + (size_t)l * W_LAYER;
        if (r < I_IN) { const int kb = r / 64, nb = r % 64; transpose_item(P.w_in + (size_t)l * DM * NIN, DM, NIN, P.g_attn + l * DM, (bf16_t*)(wl + W_IN), nb * 32, nb < 61 ? nb * 32 : -1, kb * 64, scr, lane); continue; } r -= I_IN;
        if (r < I_OUT) { const int kb = r / 32, nb = r % 32; transpose_item(P.w_out + (size_t)l * DM * DM, DM, DM, nullptr, (bf16_t*)(wl + W_OUT), nb * 32, nb * 32, kb * 64, scr, lane); continue; } r -= I_OUT;
        if (r < I_UP) { const int kb = r / 176, nb = r % 176; const int nd = nb * 32, pn = nd >> 8, wi = nd & 255, src = (wi >> 7) * DFF + pn * 128 + (wi & 127);
            transpose_item(P.w_up + (size_t)l * DM * NUP, DM, NUP, P.g_ffn + l * DM, (bf16_t*)(wl + W_UP), nd, src, kb * 64, scr, lane); continue; } r -= I_UP;
        if (r < I_DN) { const int kb = r / 32, nb = r % 32; transpose_item(P.w_down + (size_t)l * DFF * DM, DFF, DM, nullptr, (bf16_t*)(wl + W_DOWN), nb * 32, nb * 32, kb * 64, scr, lane); continue; } r -= I_DN;
        if (r < I_UQ) { const int kb = r / 24, nb = r % 24; transpose_item(P.c_w_uq + (size_t)l * 256 * NCQ, 256, NCQ, P.c_g_q + l * 256, (bf16_t*)(wl + W_UQ), nb * 32, nb * 32, kb * 64, scr, lane); continue; } r -= I_UQ;
        { const int kb = r / 32, nb = r % 32; transpose_item(P.c_w_ukv + (size_t)l * 128 * NCKV, 128, NCKV, P.c_g_kv + l * 128, (bf16_t*)(wl + W_UKV), nb * 32, nb * 32, kb * 64, scr, lane); }
    }
    float* ssqA = (float*)(P.ws + WS_SSQA); bf16_t* xb = (bf16_t*)(P.ws + WS_XB);
    for (int m = gw; m < T_TOK; m += NGW) {
        const f32x4* xr = (const f32x4*)(P.x + (size_t)m * DM) + lane; u32x2* brow = (u32x2*)(xb + (size_t)m * DM) + lane;
        float s = 0.f;
#pragma unroll
        for (int j = 0; j < 4; ++j) { const f32x4 v = xr[64 * j]; u32x2 w; w.x = cvtpk(v[0], v[1]); w.y = cvtpk(v[2], v[3]); brow[64 * j] = w; s += (v[0] * v[0] + v[1] * v[1]) + (v[2] * v[2] + v[3] * v[3]); }
        s = wave_sum(s);
        if (lane < 16) ssqA[(size_t)m * 16 + lane] = lane ? 0.f : s;
    }
    float* cost = (float*)(P.ws + WS_COS); float* sint = (float*)(P.ws + WS_SIN);
    for (int i = blockIdx.x * 512 + tid; i < SEQ * 16; i += gridDim.x * 512) {
        const int pos = i >> 4, j = i & 15; const float inv = exp2f(-(float)j * (13.287712379549449f / 16.0f)); const float ang = (float)pos * inv;
        cost[i] = cosf(ang); sint[i] = sinf(ang);
    }
    if (blockIdx.x == 0 && tid < DEPTH) {
        float d1 = 0.f, d2 = 0.f;
        for (int j = 0; j < 32; ++j) { d1 += P.a_lq1[tid * 32 + j] * P.a_lk1[tid * 32 + j]; d2 += P.a_lq2[tid * 32 + j] * P.a_lk2[tid * 32 + j]; }
        ((float*)(P.ws + WS_LAM))[tid] = expf(d1) - expf(d2) + (0.8f - 0.6f * expf(-0.3f * (float)tid));
    }
}

__device__ __forceinline__ void ffn_fixup(const Params& P, int layer) {
    const bf16_t* UB = (const bf16_t*)(P.ws + WS_UBND); bf16_t* ACT = (bf16_t*)(P.ws + WS_ACT);
    const float* cw = P.conv_w + (size_t)layer * 3 * NUP; const float* cb = P.conv_b + (size_t)layer * NUP;
    constexpr int CG = DFF / 8;
    for (int it = blockIdx.x * 512 + threadIdx.x; it < 512 * 2 * CG; it += gridDim.x * 512) {
        const int cgi = it % CG, e = (it / CG) & 1, chunk = it / (2 * CG), col = cgi * 8;
        const bf16_t *up, *mid, *dn; bool zu = false, zd = false;
        if (e == 0) { zu = (chunk % 32) == 0; up = UB + ((size_t)(zu ? chunk : chunk - 1) * 4 + 3) * NUP; mid = UB + ((size_t)chunk * 4 + 0) * NUP; dn = UB + ((size_t)chunk * 4 + 1) * NUP; }
        else { zd = (chunk % 32) == 31; up = UB + ((size_t)chunk * 4 + 2) * NUP; mid = UB + ((size_t)chunk * 4 + 3) * NUP; dn = UB + ((size_t)(zd ? chunk : chunk + 1) * 4 + 0) * NUP; }
        const float fu = zu ? 0.f : 1.f, fd = zd ? 0.f : 1.f;
        float res[8];
        bf16_t ug[8], mg[8], dg[8], uv[8], mv[8], dv[8];
        *(u32x4*)ug = *(const u32x4*)(up + col); *(u32x4*)mg = *(const u32x4*)(mid + col); *(u32x4*)dg = *(const u32x4*)(dn + col);
        *(u32x4*)uv = *(const u32x4*)(up + DFF + col); *(u32x4*)mv = *(const u32x4*)(mid + DFF + col); *(u32x4*)dv = *(const u32x4*)(dn + DFF + col);
#pragma unroll
        for (int k = 0; k < 8; ++k) {
            const int cg_ = col + k, cv_ = DFF + col + k;
            const float gt = cw[cg_] * bf2f(ug[k]) * fu + cw[NUP + cg_] * bf2f(mg[k]) + cw[2 * NUP + cg_] * bf2f(dg[k]) * fd + cb[cg_];
            const float vl = cw[cv_] * bf2f(uv[k]) * fu + cw[NUP + cv_] * bf2f(mv[k]) + cw[2 * NUP + cv_] * bf2f(dv[k]) * fd + cb[cv_];
            res[k] = gt * fast_rcp(1.f + fast_exp2(-LOG2E * gt)) * vl;
        }
        u32x4 w; w.x = cvtpk(res[0], res[1]); w.y = cvtpk(res[2], res[3]); w.z = cvtpk(res[4], res[5]); w.w = cvtpk(res[6], res[7]);
        *(u32x4*)(ACT + (size_t)(chunk * 64 + (e ? 63 : 0)) * DFF + col) = w;
    }
}


#define XB_TMO      128
#define XB_XCNT(j)  (256  + 64 * (j))
#define XB_XSUB(j)  (1280 + 64 * (j))
#define XB_XGEN(j)  (2304 + 64 * (j))
#define XB_TOP      3328
#define XB_TOPGEN   3392
#define XCD_BAR_WORDS 3456
#define XB_SPIN_CAP (1u << 22)
__device__ __forceinline__ unsigned xb_ld(unsigned* p)              { return __hip_atomic_load(p, __ATOMIC_RELAXED, __HIP_MEMORY_SCOPE_AGENT); }
__device__ __forceinline__ unsigned xb_add(unsigned* p, unsigned v) { return __hip_atomic_fetch_add(p, v, __ATOMIC_RELAXED, __HIP_MEMORY_SCOPE_AGENT); }
__device__ __forceinline__ unsigned xb_xcc_id() { return (unsigned)__builtin_amdgcn_s_getreg((3 << 11) | 20) & 0xFu; }
#define XB_SPIN(cond, bar) do { unsigned _sp = 0; while (cond) { __builtin_amdgcn_s_sleep(1); \
    if ((++_sp & 255u) == 0u) { if (xb_ld(&(bar)[XB_TMO])) break; if (_sp > XB_SPIN_CAP) { atomicAdd(&(bar)[XB_TMO], 1u); break; } } } } while (0)
struct XcdBarrier { unsigned* bar; unsigned x; volatile LAS unsigned* st; };
__device__ __forceinline__ XcdBarrier xcd_barrier_post(unsigned* bar, volatile LAS unsigned* st) {
    XcdBarrier b; b.bar = bar; b.x = xb_xcc_id(); b.st = st;
    if (threadIdx.x == 0) (void)xb_add(&bar[XB_XCNT(b.x)], 1u);
    return b;
}
__device__ __forceinline__ void xcd_barrier_complete(unsigned* bar, unsigned x, unsigned& nloc, unsigned& nx) {
    const unsigned G = gridDim.x * gridDim.y * gridDim.z;
    unsigned sum, cnt, mine, sp = 0u;
    for (;;) {
        sum = 0u; cnt = 0u; mine = 0u;
#pragma unroll
        for (unsigned j = 0; j < 16; ++j) { const unsigned c = xb_ld(&bar[XB_XCNT(j)]); sum += c; cnt += (c > 0u) ? 1u : 0u; mine = (j == x) ? c : mine; }
        if (sum == G) break;
        __builtin_amdgcn_s_sleep(1);
        if ((++sp & 255u) == 0u) { if (xb_ld(&bar[XB_TMO])) break; if (sp > XB_SPIN_CAP) { atomicAdd(&bar[XB_TMO], 1u); break; } }
    }
    nloc = mine > 0u ? mine : 1u; nx = cnt > 0u ? cnt : 1u;
}
__device__ __forceinline__ void xcd_barrier(const XcdBarrier& b) {
    asm volatile("s_waitcnt vmcnt(0)" ::: "memory");
    __syncthreads();
    if (threadIdx.x == 0) {
        unsigned* bar = b.bar;
        __builtin_amdgcn_s_waitcnt(0);
        unsigned nloc = b.st[0], nx = b.st[1];
        if (nloc == 0u) { xcd_barrier_complete(bar, b.x, nloc, nx); b.st[0] = nloc; b.st[1] = nx; }
        const unsigned old = xb_add(&bar[XB_XSUB(b.x)], 1u);
        const unsigned gen = old / nloc;
        if (old + 1u == (gen + 1u) * nloc) {
            __builtin_amdgcn_fence(__ATOMIC_RELEASE, "agent");
            asm volatile("s_waitcnt vmcnt(0)" ::: "memory");
            const unsigned og = xb_add(&bar[XB_TOP], 1u);
            const unsigned tg = og / nx;
            if (og + 1u == (tg + 1u) * nx) xb_add(&bar[XB_TOPGEN], 1u);
            else XB_SPIN(xb_ld(&bar[XB_TOPGEN]) == tg, bar);
            __builtin_amdgcn_fence(__ATOMIC_ACQUIRE, "agent");
            xb_add(&bar[XB_XGEN(b.x)], 1u);
            asm volatile("s_waitcnt vmcnt(0)" ::: "memory");
        } else {
            XB_SPIN(xb_ld(&bar[XB_XGEN(b.x)]) == gen, bar);
            __builtin_amdgcn_fence(__ATOMIC_ACQUIRE, "agent");
            asm volatile("s_waitcnt vmcnt(0)" ::: "memory");
        }
    }
    __syncthreads();
}

__global__ void __launch_bounds__(512, 2) fwd_megakernel(Params P) {
    extern __shared__ __attribute__((aligned(16))) unsigned char lds_raw[];
    LAS unsigned char* lds = (LAS unsigned char*)lds_raw;
    cg::grid_group grid = cg::this_grid();
#define GRID_SYNC() do { asm volatile("s_waitcnt vmcnt(0) lgkmcnt(0)" ::: "memory"); __syncthreads(); grid.sync(); \
        __builtin_amdgcn_fence(__ATOMIC_ACQUIRE, "agent"); asm volatile("s_waitcnt vmcnt(0)" ::: "memory"); GRID_SYNC2(); } while (0)
#if MK_DUP_SYNC > 1
#define GRID_SYNC2() do { grid.sync(); __builtin_amdgcn_fence(__ATOMIC_ACQUIRE, "agent"); asm volatile("s_waitcnt vmcnt(0)" ::: "memory"); } while (0)
#else
#define GRID_SYNC2() do {} while (0)
#endif
    unsigned char* ws = P.ws;
    float* ssqA = (float*)(ws + WS_SSQA); float* ssqB = (float*)(ws + WS_SSQB); float* ssqQ = (float*)(ws + WS_SSQQ); float* ssqKV = (float*)(ws + WS_SSQKV);
    const float* cost = (const float*)(ws + WS_COS); const float* sint = (const float*)(ws + WS_SIN);
    bf16_t* xb = (bf16_t*)(ws + WS_XB); bf16_t* proj = (bf16_t*)(ws + WS_PROJ); bf16_t* cq = (bf16_t*)(ws + WS_CQ); bf16_t* ckv = (bf16_t*)(ws + WS_CKV);
    bf16_t* mix = (bf16_t*)(ws + WS_MIX); bf16_t* act = (bf16_t*)(ws + WS_ACT); bf16_t* ubnd = (bf16_t*)(ws + WS_UBND);

    volatile LAS unsigned* bst = (volatile LAS unsigned*)(lds + 131072 + 64);
    if (threadIdx.x < 2) bst[threadIdx.x] = 0u;
    __syncthreads();
    const XcdBarrier xbar = xcd_barrier_post((unsigned*)(ws + WS_BAR), bst);
    prologue(P, lds);
#if MK_DUP_PRO > 1
    volatile LAS unsigned* bst = (volatile LAS unsigned*)(lds + 131072 + 64);
    if (threadIdx.x < 2) bst[threadIdx.x] = 0u;
    __syncthreads();
    const XcdBarrier xbar = xcd_barrier_post((unsigned*)(ws + WS_BAR), bst);
    prologue(P, lds);
#endif
    GRID_SYNC();
#if MK_DUP_BAR > 1
#define XBAR() do { xcd_barrier(xbar); xcd_barrier(xbar); } while (0)
#else
#define XBAR() xcd_barrier(xbar)
#endif
    for (int l = 0; l < DEPTH; ++l) {
        const unsigned char* wl = ws + WS_W + (size_t)l * W_LAYER;
#if !(MK_SKIP & 1)
        { pg8::Gemm g{xb, (const bf16_t*)(wl + W_IN), T_TOK, NPROJW, DM, DM}; EpiProj E{proj, ssqA, ssqQ, ssqKV, cost, sint}; pg8::gemm_phase(lds, g, E); }
#if MK_DUP_IN > 1
        { pg8::Gemm g{xb, (const bf16_t*)(wl + W_IN), T_TOK, NPROJW, DM, DM}; EpiProj E{proj, ssqA, ssqQ, ssqKV, cost, sint}; pg8::gemm_phase(lds, g, E); }
#endif
#endif
        XBAR();
#if !(MK_SKIP & 2)
        { pg8::Gemm g{proj + 1536, (const bf16_t*)(wl + W_UQ), T_TOK, NCQ, 256, NPROJ}; EpiMla<true, 8> E{cq, PCQ, ssqQ, 1.0f / 256.0f, cost, sint}; pg8::gemm_phase(lds, g, E); }
        { pg8::Gemm g{proj + 1792, (const bf16_t*)(wl + W_UKV), T_TOK, NCKV, 128, NPROJ}; EpiMla<false, 4> E{ckv, PCKV, ssqKV, 1.0f / 128.0f, cost, sint}; pg8::gemm_phase(lds, g, E); }
#if MK_DUP_MLA > 1
        { pg8::Gemm g{proj + 1536, (const bf16_t*)(wl + W_UQ), T_TOK, NCQ, 256, NPROJ}; EpiMla<true, 8> E{cq, PCQ, ssqQ, 1.0f / 256.0f, cost, sint}; pg8::gemm_phase(lds, g, E); }
        { pg8::Gemm g{proj + 1792, (const bf16_t*)(wl + W_UKV), T_TOK, NCKV, 128, NPROJ}; EpiMla<false, 4> E{ckv, PCKV, ssqKV, 1.0f / 128.0f, cost, sint}; pg8::gemm_phase(lds, g, E); }
#endif
#endif
#if !(MK_SKIP & 4)
        for (int rep_ = 0; rep_ < MK_DUP_AB; ++rep_)
        {
            const bool xm = (gridDim.x == 256); const int x_ = blockIdx.x & 7, j_ = blockIdx.x >> 3;
            for (int u = blockIdx.x, i_ = 0; u < 512; u += gridDim.x, ++i_) {
                int bh = u >> 3, qb = u & 7; if (xm) { bh = x_ * 8 + i_ * 4 + (j_ >> 3); qb = j_ & 7; }
                attn_unit<1, 1>(lds, P, l, bh >> 2, bh & 3, qb);
            }
            for (int u = blockIdx.x, i_ = 0; u < 512; u += gridDim.x, ++i_) {
                int bh = (u >> 3) & 63, qb = u & 7; if (u >= 256) qb = (qb + 4) & 7; if (xm) { bh = x_ * 8 + i_ * 4 + (j_ >> 3); qb = ((j_ & 7) + 4 * i_) & 7; }
                attn_unit<2, 1>(lds, P, l, bh >> 2, bh & 3, qb);
            }
        }
#endif
        XBAR();
#if !(MK_SKIP & 8)
        for (int rep_ = 0; rep_ < MK_DUP_C; ++rep_)
        {
            const bool xm = (gridDim.x == 256); const int x_ = blockIdx.x & 7, j_ = blockIdx.x >> 3;
            for (int u = blockIdx.x, i_ = 0; u < 512; u += gridDim.x, ++i_) {
                int bh = u >> 2, qb = u & 3; if (xm) { bh = x_ * 16 + i_ * 8 + (j_ >> 2); qb = j_ & 3; }
                attn_unit<0, 2>(lds, P, l, bh >> 3, bh & 7, qb);
            }
        }
#endif
        XBAR();
#if !(MK_SKIP & 16)
        { pg8::Gemm g{mix, (const bf16_t*)(wl + W_OUT), T_TOK, DM, DM, DM}; EpiResid E{xb, ssqB}; pg8::gemm_phase(lds, g, E); }
#endif
        XBAR();
#if !(MK_SKIP & 32)
        { pg8::Gemm g{xb, (const bf16_t*)(wl + W_UP), T_TOK, NUP, DM, DM}; EpiUp E{act, ubnd, ssqB, P.conv_w + (size_t)l * 3 * NUP, P.conv_b + (size_t)l * NUP}; pg8::gemm_phase(lds, g, E); }
#if MK_DUP_UP > 1
        { pg8::Gemm g{xb, (const bf16_t*)(wl + W_UP), T_TOK, NUP, DM, DM}; EpiUp E{act, ubnd, ssqB, P.conv_w + (size_t)l * 3 * NUP, P.conv_b + (size_t)l * NUP}; pg8::gemm_phase(lds, g, E); }
#endif
#endif
        XBAR();
        ffn_fixup(P, l);
        XBAR();
#if !(MK_SKIP & 64)
        { pg8::Gemm g{act, (const bf16_t*)(wl + W_DOWN), T_TOK, DM, DFF, DFF}; EpiResid E{xb, ssqA}; pg8::gemm_phase(lds, g, E); }
#endif
        XBAR();
    }
    for (int i = blockIdx.x * 512 + threadIdx.x; i < T_TOK * (DM / 4); i += gridDim.x * 512) {
        const int row = i >> 8, c4 = i & 255;
        const float rs = rsqrtf(ssq_sum<16>(ssqA + (size_t)row * 16) * (1.0f / DM) + EPS);
        const u32x2 xv = ((const u32x2*)xb)[i]; const f32x4 gv = ((const f32x4*)P.g_final)[c4];
        f32x4 v; v[0] = __uint_as_float(xv.x << 16); v[1] = __uint_as_float(xv.x & 0xffff0000u); v[2] = __uint_as_float(xv.y << 16); v[3] = __uint_as_float(xv.y & 0xffff0000u);
        ((f32x4*)P.out)[i] = v * rs * gv;
    }
}

extern "C" void kernel_launch(void* const* d_in, const int* in_sizes, int n_in, void* d_out, int out_size, void* d_ws, size_t ws_size, hipStream_t stream) {
    static int grid_blocks = 0;
    if (!grid_blocks) {
        if (n_in != 19 || ws_size < WS_END) { fprintf(stderr, "kernel_launch: unexpected n_in %d / ws %zu\n", n_in, ws_size); grid_blocks = -1; return; }
        int dev = 0, cus = 0, per_cu = 0;
        hipGetDevice(&dev);
        hipDeviceGetAttribute(&cus, hipDeviceAttributeMultiprocessorCount, dev);
        hipFuncSetAttribute((const void*)fwd_megakernel, hipFuncAttributeMaxDynamicSharedMemorySize, LDS_BYTES);
        hipOccupancyMaxActiveBlocksPerMultiprocessor(&per_cu, (const void*)fwd_megakernel, 512, LDS_BYTES);
        if (per_cu < 1) { fprintf(stderr, "kernel_launch: occupancy query says %d blocks/CU\n", per_cu); per_cu = 1; }
        grid_blocks = cus * per_cu;
    }
    if (grid_blocks < 0) return;
    Params p{};
    const float** f = (const float**)&p;
    for (int i = 0; i < 19; ++i) f[i] = (const float*)d_in[i];
    p.out = (float*)d_out; p.ws = (unsigned char*)d_ws;
    (void)hipMemsetAsync((char*)d_ws + WS_BAR, 0, WS_BAR_BYTES, stream);
    void* args[] = {&p};
    hipError_t e = hipLaunchCooperativeKernel((const void*)fwd_megakernel, dim3(grid_blocks), dim3(512), args, LDS_BYTES, stream);
    if (e != hipSuccess) fprintf(stderr, "cooperative launch failed: %s (grid %d)\n", hipGetErrorString(e), grid_blocks);
}
```

```cpp
#include <hip/hip_runtime.h>
#include <hip/hip_cooperative_groups.h>
#include <cstdint>
#include <cstdio>
namespace cg = cooperative_groups;

#define LAS __attribute__((address_space(3)))
typedef unsigned short bf16_t;
typedef short bf16x8 __attribute__((ext_vector_type(8)));
typedef short s16x4 __attribute__((ext_vector_type(4)));
typedef float f32x4 __attribute__((ext_vector_type(4)));
typedef float f32x2 __attribute__((ext_vector_type(2)));
typedef float f32x16 __attribute__((ext_vector_type(16)));
typedef unsigned u32x4 __attribute__((ext_vector_type(4)));
typedef unsigned u32x2 __attribute__((ext_vector_type(2)));
typedef __bf16 bf16x2_t __attribute__((ext_vector_type(2)));

constexpr int T_TOK = 32768, SEQ = 2048, DM = 1024, DEPTH = 4;
constexpr int NPROJW = 2048, NPROJ = 2112, NIN = 1952, DFF = 2816, NUP = 5632;
constexpr int NCQ = 768, NCKV = 1024, PCQ = 832, PCKV = 1088;
constexpr float EPS = 1e-6f;
constexpr float LOG2E = 1.4426950408889634f;

constexpr size_t MiB = 1u << 20;
constexpr size_t WS_BAR = 0, WS_BAR_BYTES = 16384;
constexpr size_t WS_LAM = 512 * 1024;
constexpr size_t WS_COS = 576 * 1024, WS_SIN = 704 * 1024;
constexpr size_t WS_W = 1 * MiB;
constexpr size_t W_IN = 0, W_OUT = W_IN + (size_t)NPROJW * DM * 2, W_UP = W_OUT + (size_t)DM * DM * 2, W_DOWN = W_UP + (size_t)NUP * DM * 2,
                 W_UQ = W_DOWN + (size_t)DM * DFF * 2, W_UKV = W_UQ + (size_t)NCQ * 256 * 2, W_LAYER = W_UKV + (size_t)NCKV * 128 * 2;
static_assert(W_LAYER * DEPTH <= 93 * MiB, "weights");
constexpr size_t WS_XB = 94 * MiB, WS_PROJ = 158 * MiB, WS_CQ = 290 * MiB, WS_CKV = 342 * MiB, WS_MIX = 410 * MiB;
constexpr size_t WS_SSQA = 474 * MiB, WS_SSQB = 476 * MiB, WS_SSQQ = 478 * MiB, WS_SSQKV = 479 * MiB, WS_END = 480 * MiB;
static_assert(WS_PROJ + (size_t)T_TOK * NPROJ * 2 <= WS_CQ && WS_CQ + (size_t)T_TOK * PCQ * 2 <= WS_CKV && WS_CKV + (size_t)T_TOK * PCKV * 2 <= WS_MIX, "attention tensors");
constexpr size_t WS_ACT = 158 * MiB, WS_UBND = 342 * MiB;
static_assert(WS_ACT + (size_t)T_TOK * DFF * 2 <= WS_UBND && WS_UBND + (size_t)512 * 4 * NUP * 2 <= WS_MIX, "overlay");

constexpr int LDS_BYTES = 147456;
#ifndef MK_SKIP
#define MK_SKIP 0
#endif
#ifndef MK_DUP_PRO
#define MK_DUP_PRO 1
#endif
#ifndef MK_DUP_SYNC
#define MK_DUP_SYNC 1
#endif
#ifndef MK_DUP_MLA
#define MK_DUP_MLA 1
#endif
#ifndef MK_DUP_BAR
#define MK_DUP_BAR 1
#endif
#ifndef MK_DUP_UP
#define MK_DUP_UP 1
#endif
#ifndef MK_DUP_IN
#define MK_DUP_IN 1
#endif
#ifndef MK_DUP_AB
#define MK_DUP_AB 1
#endif
#ifndef MK_DUP_C
#define MK_DUP_C 1
#endif

struct Params {
    const float* x; const float* w_in; const float* g_attn; const float* a_lq1; const float* a_lk1; const float* a_lq2; const float* a_lk2;
    const float* a_subln; const float* c_g_q; const float* c_w_uq; const float* c_g_kv; const float* c_w_ukv; const float* w_out; const float* g_ffn;
    const float* w_up; const float* conv_w; const float* conv_b; const float* w_down; const float* g_final;
    float* out; unsigned char* ws;
};

__device__ __forceinline__ unsigned cvtpk(float lo, float hi) { f32x2 v = {lo, hi}; bf16x2_t b = __builtin_convertvector(v, bf16x2_t); return __builtin_bit_cast(unsigned, b); }
__device__ __forceinline__ void st16_wt(void* p, u32x4 v) { *(u32x4*)p = v; }
__device__ __forceinline__ void st8_wt(void* p, u32x2 v) { *(u32x2*)p = v; }
__device__ __forceinline__ float bf2f(unsigned short b) { return __uint_as_float((unsigned)b << 16); }
__device__ __forceinline__ float wave_sum(float v) {
#pragma unroll
    for (int o = 1; o < 64; o <<= 1) v += __shfl_xor(v, o);
    return v;
}
__device__ __forceinline__ float ld_agent(const float* p) { return __hip_atomic_load(p, __ATOMIC_RELAXED, __HIP_MEMORY_SCOPE_AGENT); }
template <int NS> __device__ __forceinline__ float ssq_sum(const float* p) {
    float t = 0.f;
#pragma unroll
    for (int i = 0; i < NS / 4; ++i) { const f32x4 v = *(const f32x4*)(p + 4 * i); t += (v[0] + v[1]) + (v[2] + v[3]); }
    return t;
}
__device__ __forceinline__ float fast_exp2(float x) { return __builtin_amdgcn_exp2f(x); }
__device__ __forceinline__ float fast_rcp(float x) { return __builtin_amdgcn_rcpf(x); }

namespace pg8 {
constexpr int BM = 256, BK = 64, HALF = 128, HTB = HALF * BK * 2, STAGE_BYTES = 8 * HTB, NXCD = 8, WGM = 8;
__host__ __device__ __forceinline__ int lds_byte(int r, int c) { const int st = (r >> 4) * 2 + (c >> 5), rr = r & 15, cc = c & 31, ob = rr * 64 + cc * 2; return st * 1024 + (ob ^ (((ob >> 9) & 1) << 5)); }
__host__ __device__ __forceinline__ void stage_rc(int b, int& R, int& C) { const int st = b / 1024, sb = b % 1024, swz = sb ^ (((sb >> 9) & 1) << 5); R = (st >> 1) * 16 + swz / 64; C = (st & 1) * 32 + (swz % 64) / 2; }
__host__ __device__ __forceinline__ int perm32(int rho) { const int n = rho >> 4, i = rho & 15; return 8 * (i >> 2) + 4 * n + (i & 3); }
struct Unit { int pm, pn; };
struct Gemm { const bf16_t* A; const bf16_t* Bt; int M, N, K, lda; };
struct StaticOrder {
    int nM, nN, nwg, G, c;
    __device__ void init(int M, int N, int G_, int c_) { nM = M / BM; nN = N / BM; nwg = nM * nN; G = G_; c = c_; }
    __device__ bool next(int i, Unit& u) const {
        const long L = (long)i * G + c; if (L >= nwg) return false;
        int wgid = (int)L; { const int q = nwg / NXCD, r = nwg % NXCD, xcd = wgid % NXCD, off = wgid / NXCD; wgid = (xcd < r ? xcd * (q + 1) : r * (q + 1) + (xcd - r) * q) + off; }
        const int nig = WGM * nN, gid = wgid / nig, fm = gid * WGM, gsz = (nM - fm) < WGM ? (nM - fm) : WGM;
        u.pm = fm + ((wgid % nig) % gsz); u.pn = (wgid % nig) / gsz; return true;
    }
};

template <class Epi>
__device__ __forceinline__ void gemm_phase(LAS unsigned char* lds, const Gemm g, const Epi& E, int cidx = -1) {
    int tid = threadIdx.x; asm volatile("" : "+v"(tid));
    const int wid = __builtin_amdgcn_readfirstlane(tid >> 6), lane = tid & 63, wr = wid >> 2, wc = wid & 3, fr = lane & 15, fq = lane >> 4;
    int K = g.K, lda = g.lda; asm volatile("" : "+s"(K), "+s"(lda));
    const int nt = K / BK;
    StaticOrder S; S.init(g.M, g.N, (int)gridDim.x, cidx < 0 ? (int)blockIdx.x : cidx);
    unsigned voffA[2], voffB[2];
#pragma unroll
    for (int i = 0; i < 2; ++i) { int R, C; stage_rc(tid * 16 + i * 8192, R, C); const int Rb = Epi::PERM ? ((R & ~31) + perm32(R & 31)) : R;
        voffA[i] = (unsigned)(R * lda + C) * 2u; voffB[i] = (unsigned)(Rb * K + C) * 2u; }
    const size_t kstep = (size_t)(BK * 2);
    const size_t hstepA = (size_t)HALF * lda * 2, hstepB = (size_t)HALF * K * 2;
    const size_t tstepA = 2 * hstepA, tstepB = 2 * hstepB;
    const unsigned ldsw = (unsigned)wid * 1024u;
    const int aoff = lds_byte(wr * 64 + fr, fq * 8), boff = lds_byte(wc * 32 + fr, fq * 8);
#define PG8_SA(b, h) (((b) * 2 + (h)) * HTB)
#define PG8_SB(b, h) ((4 + (b) * 2 + (h)) * HTB)
#define PG8_STAGE(bufoff, gbase, voff) do { _Pragma("unroll") for (int _i = 0; _i < 2; ++_i) \
        __builtin_amdgcn_global_load_lds((const unsigned*)((const char*)(gbase) + (voff)[_i]), (LAS unsigned*)(lds + (bufoff) + ldsw + _i * 8192), 16, 0, 0); } while (0)
#define PG8_LDA(dst, b, h) do { _Pragma("unroll") for (int m = 0; m < 4; ++m) _Pragma("unroll") for (int k = 0; k < 2; ++k) dst[m][k] = *(const LAS bf16x8*)(lds + PG8_SA(b, h) + aoff + m * 2048 + k * 1024); } while (0)
#define PG8_LDB(dst, b, h) do { _Pragma("unroll") for (int n = 0; n < 2; ++n) _Pragma("unroll") for (int k = 0; k < 2; ++k) dst[n][k] = *(const LAS bf16x8*)(lds + PG8_SB(b, h) + boff + n * 2048 + k * 1024); } while (0)
#define PG8_MMA(ai, bj, At, Bt) do { __builtin_amdgcn_s_setprio(1); _Pragma("unroll") for (int m = 0; m < 4; ++m) _Pragma("unroll") for (int n = 0; n < 2; ++n) _Pragma("unroll") for (int k = 0; k < 2; ++k) \
        acc[ai][bj][m][n] = __builtin_amdgcn_mfma_f32_16x16x32_bf16(Bt[n][k], At[m][k], acc[ai][bj][m][n], 0, 0, 0); __builtin_amdgcn_s_setprio(0); } while (0)
#define PG8_WAIT_V(n) asm volatile("s_waitcnt vmcnt(" #n ")" ::: "memory")
#define PG8_WAIT_L(n) asm volatile("s_waitcnt lgkmcnt(" #n ")" ::: "memory")
#define PG8_BAR __builtin_amdgcn_s_barrier()
#define PG8_SCHED __builtin_amdgcn_sched_barrier(0)
    Unit cur, nxt; int ui = 0;
    if (!S.next(0, cur)) return;
    f32x4 acc[2][2][4][2];
#pragma unroll
    for (int a = 0; a < 2; ++a)
#pragma unroll
        for (int b = 0; b < 2; ++b)
#pragma unroll
            for (int m = 0; m < 4; ++m)
#pragma unroll
                for (int n = 0; n < 2; ++n) acc[a][b][m][n] = (f32x4){0.f, 0.f, 0.f, 0.f};
    bf16x8 At[4][2], B0[2][2], B1[2][2];
    const char* cA = (const char*)g.A + (size_t)cur.pm * tstepA; const char* cB = (const char*)g.Bt + (size_t)cur.pn * tstepB;
    PG8_STAGE(PG8_SB(0, 0), cB, voffB); PG8_STAGE(PG8_SB(0, 1), cB + hstepB, voffB); PG8_STAGE(PG8_SA(0, 0), cA, voffA); PG8_STAGE(PG8_SA(0, 1), cA + hstepA, voffA);
    if (wr == 1) PG8_BAR;
    PG8_WAIT_V(2); PG8_BAR;
    PG8_STAGE(PG8_SB(1, 0), cB + kstep, voffB); PG8_STAGE(PG8_SA(1, 0), cA + kstep, voffA); PG8_STAGE(PG8_SB(1, 1), cB + hstepB + kstep, voffB);
    PG8_WAIT_V(6); PG8_BAR;
    for (;;) {
        const bool has_next = S.next(ui + 1, nxt);
        const char* nA = has_next ? (const char*)g.A + (size_t)nxt.pm * tstepA : cA; const char* nB = has_next ? (const char*)g.Bt + (size_t)nxt.pn * tstepB : cB;
        for (int t = 0; t < nt; t += 2) {
            const bool last = (t == nt - 2);
            const char* a1 = cA + (size_t)(t + 1) * kstep;
            const char* a2 = last ? nA : cA + (size_t)(t + 2) * kstep; const char* b2 = last ? nB : cB + (size_t)(t + 2) * kstep;
            const char* a3 = a2 + kstep; const char* b3 = b2 + kstep;
            PG8_LDB(B0, 0, 0); PG8_LDB(B1, 0, 1); PG8_SCHED; PG8_LDA(At, 0, 0); PG8_STAGE(PG8_SA(1, 1), a1 + hstepA, voffA);
            PG8_WAIT_V(8); PG8_WAIT_L(0); PG8_BAR; PG8_MMA(0, 0, At, B0); PG8_MMA(0, 1, At, B1); PG8_BAR; PG8_SCHED;
            PG8_LDA(At, 0, 1); PG8_STAGE(PG8_SB(0, 0), b2, voffB); PG8_STAGE(PG8_SB(0, 1), b2 + hstepB, voffB); PG8_STAGE(PG8_SA(0, 0), a2, voffA);
            PG8_WAIT_V(8); PG8_WAIT_L(0); PG8_BAR; PG8_MMA(1, 0, At, B0); PG8_MMA(1, 1, At, B1); PG8_BAR; PG8_SCHED;
            PG8_LDB(B0, 1, 0); PG8_LDB(B1, 1, 1); PG8_SCHED; PG8_LDA(At, 1, 0); PG8_STAGE(PG8_SA(0, 1), a2 + hstepA, voffA);
            PG8_WAIT_V(8); PG8_WAIT_L(0); PG8_BAR; PG8_MMA(0, 0, At, B0); PG8_MMA(0, 1, At, B1); PG8_BAR; PG8_SCHED;
            PG8_LDA(At, 1, 1); PG8_STAGE(PG8_SB(1, 0), b3, voffB); PG8_STAGE(PG8_SB(1, 1), b3 + hstepB, voffB); PG8_STAGE(PG8_SA(1, 0), a3, voffA);
            PG8_WAIT_V(8); PG8_WAIT_L(0); PG8_BAR; PG8_MMA(1, 0, At, B0); PG8_MMA(1, 1, At, B1); PG8_BAR; PG8_SCHED;
        }
        if (wr == 0) PG8_BAR;
        E(acc, cur, wr, wc, fr, fq);
        if (!has_next) break;
#pragma unroll
        for (int a = 0; a < 2; ++a)
#pragma unroll
            for (int b = 0; b < 2; ++b)
#pragma unroll
                for (int m = 0; m < 4; ++m)
#pragma unroll
                    for (int n = 0; n < 2; ++n) acc[a][b][m][n] = (f32x4){0.f, 0.f, 0.f, 0.f};
        cur = nxt; cA = nA; cB = nB; ++ui;
        if (wr == 1) PG8_BAR;
    }
    PG8_WAIT_V(0);
    PG8_BAR;
#undef PG8_SA
#undef PG8_SB
#undef PG8_STAGE
#undef PG8_LDA
#undef PG8_LDB
#undef PG8_MMA
#undef PG8_WAIT_V
#undef PG8_WAIT_L
#undef PG8_BAR
#undef PG8_SCHED
}
}
using pg8::Unit;
typedef f32x4 (&AccRef)[2][2][4][2];

__device__ __forceinline__ void rope8(f32x4& v0, f32x4& v1, const float* cosr, const float* sinr, int fq) {
    const int j0 = 8 * (fq & 1);
    const f32x4 c0 = *(const f32x4*)(cosr + j0), c1 = *(const f32x4*)(cosr + j0 + 4), s0 = *(const f32x4*)(sinr + j0), s1 = *(const f32x4*)(sinr + j0 + 4);
    const float sg = (fq < 2) ? -1.f : 1.f;
#pragma unroll
    for (int i = 0; i < 4; ++i) {
        const float p0 = __shfl_xor(v0[i], 32), p1 = __shfl_xor(v1[i], 32);
        v0[i] = v0[i] * c0[i] + sg * p0 * s0[i]; v1[i] = v1[i] * c1[i] + sg * p1 * s1[i];
    }
}

struct EpiProj {
    static constexpr bool PERM = true;
    bf16_t* O; const float* ssqx; float* ssqq; float* ssqkv; const float* cost; const float* sint;
    __device__ __forceinline__ void operator()(AccRef acc, const Unit& u, int wr, int wc, int fr, int fq) const {
        const int row0 = u.pm * 256 + wr * 64 + fr, col0 = u.pn * 256 + wc * 32 + 8 * fq;
#pragma unroll
        for (int ai = 0; ai < 2; ++ai)
#pragma unroll
            for (int m = 0; m < 4; ++m) {
                const int row = row0 + ai * 128 + m * 16;
                const float rs = rsqrtf(ssq_sum<16>(ssqx + (size_t)row * 16) * (1.0f / DM) + EPS);
                bf16_t* rowp = O + (size_t)row * NPROJ + col0;
#pragma unroll
                for (int bj = 0; bj < 2; ++bj) {
                    f32x4 v0 = acc[ai][bj][m][0] * rs, v1 = acc[ai][bj][m][1] * rs;
                    if (u.pn == 6 || (u.pn == 7 && bj == 0)) {
                        float s = (v0[0] * v0[0] + v0[1] * v0[1]) + (v0[2] * v0[2] + v0[3] * v0[3]) + (v1[0] * v1[0] + v1[1] * v1[1]) + (v1[2] * v1[2] + v1[3] * v1[3]);
                        s += __shfl_xor(s, 16); s += __shfl_xor(s, 32);
                        if (fq == 0) { if (u.pn == 6) ssqq[(size_t)row * 8 + bj * 4 + wc] = s; else ssqkv[(size_t)row * 4 + wc] = s; }
                    }
                    if (u.pn == 7 && bj == 1 && wc == 0) { const int pos = row & (SEQ - 1); rope8(v0, v1, cost + pos * 16, sint + pos * 16, fq); }
                    u32x4 w; w.x = cvtpk(v0[0], v0[1]); w.y = cvtpk(v0[2], v0[3]); w.z = cvtpk(v1[0], v1[1]); w.w = cvtpk(v1[2], v1[3]);
                    st16_wt(rowp + bj * 128, w);
                }
                asm volatile("" ::: "memory");
            }
    }
};
template <bool ROPE, int NS> struct EpiMla {
    static constexpr bool PERM = true;
    bf16_t* O; int ldc; const float* ssq; float inv_n; const float* cost; const float* sint;
    __device__ __forceinline__ void operator()(AccRef acc, const Unit& u, int wr, int wc, int fr, int fq) const {
        const int row0 = u.pm * 256 + wr * 64 + fr, col0 = u.pn * 256 + wc * 32 + 8 * fq;
#pragma unroll
        for (int ai = 0; ai < 2; ++ai)
#pragma unroll
            for (int m = 0; m < 4; ++m) {
                const int row = row0 + ai * 128 + m * 16;
                const float rs = rsqrtf(ssq_sum<NS>(ssq + (size_t)row * NS) * inv_n + EPS);
                bf16_t* rowp = O + (size_t)row * ldc + col0;
#pragma unroll
                for (int bj = 0; bj < 2; ++bj) {
                    f32x4 v0 = acc[ai][bj][m][0] * rs, v1 = acc[ai][bj][m][1] * rs;
                    if (ROPE) { const int g32 = u.pn * 8 + bj * 4 + wc; if (g32 % 3 == 2) { const int pos = row & (SEQ - 1); rope8(v0, v1, cost + pos * 16, sint + pos * 16, fq); } }
                    u32x4 w; w.x = cvtpk(v0[0], v0[1]); w.y = cvtpk(v0[2], v0[3]); w.z = cvtpk(v1[0], v1[1]); w.w = cvtpk(v1[2], v1[3]);
                    st16_wt(rowp + bj * 128, w);
                }
                asm volatile("" ::: "memory");
            }
    }
};
struct EpiResid {
    static constexpr bool PERM = true;
    bf16_t* XB; float* ssq;
    __device__ __forceinline__ void operator()(AccRef acc, const Unit& u, int wr, int wc, int fr, int fq) const {
        const int row0 = u.pm * 256 + wr * 64 + fr, col0 = u.pn * 256 + wc * 32 + 8 * fq;
#pragma unroll
        for (int ai = 0; ai < 2; ++ai)
#pragma unroll
            for (int m = 0; m < 4; ++m) {
                const int row = row0 + ai * 128 + m * 16; bf16_t* rowp = XB + (size_t)row * DM + col0; float s = 0.f;
#pragma unroll
                for (int bj = 0; bj < 2; ++bj) {
                    const u32x4 xo = *(const u32x4*)(rowp + bj * 128);
                    float v[8];
#pragma unroll
                    for (int k = 0; k < 4; ++k) { v[2 * k] = __uint_as_float(xo[k] << 16) + acc[ai][bj][m][k >> 1][(2 * k) & 3]; v[2 * k + 1] = __uint_as_float(xo[k] & 0xffff0000u) + acc[ai][bj][m][k >> 1][(2 * k + 1) & 3]; }
#pragma unroll
                    for (int k = 0; k < 8; ++k) s += v[k] * v[k];
                    u32x4 w; w.x = cvtpk(v[0], v[1]); w.y = cvtpk(v[2], v[3]); w.z = cvtpk(v[4], v[5]); w.w = cvtpk(v[6], v[7]);
                    st16_wt(rowp + bj * 128, w);
                }
                s += __shfl_xor(s, 16); s += __shfl_xor(s, 32);
                if (fq == 0) ssq[(size_t)row * 16 + u.pn * 4 + wc] = s;
                asm volatile("" ::: "memory");
            }
    }
};
template <int CTRL> __device__ __forceinline__ float dpp_rot(float v) { return __int_as_float(__builtin_amdgcn_update_dpp(__float_as_int(v), __float_as_int(v), CTRL, 0xf, 0xf, false)); }
struct EpiUp {
    static constexpr bool PERM = true;
    bf16_t* ACT; bf16_t* UB; const float* ssqx; const float* cw; const float* cb;
    __device__ __forceinline__ void operator()(AccRef acc, const Unit& u, int wr, int wc, int fr, int fq) const {
        const int row0 = u.pm * 256 + wr * 64 + fr, gcol = u.pn * 128 + wc * 32 + 8 * fq;
#pragma unroll
        for (int ai = 0; ai < 2; ++ai) {
#pragma unroll
            for (int m = 0; m < 4; ++m) {
                const float rs = rsqrtf(ssq_sum<16>(ssqx + (size_t)(row0 + ai * 128 + m * 16) * 16) * (1.0f / DM) + EPS);
#pragma unroll
                for (int bj = 0; bj < 2; ++bj) { acc[ai][bj][m][0] = acc[ai][bj][m][0] * rs; acc[ai][bj][m][1] = acc[ai][bj][m][1] * rs; }
            }
            asm volatile("" ::: "memory");
            const int chunk = u.pm * 4 + ai * 2 + wr;
#pragma unroll
            for (int e = 0; e < 2; ++e) {
                const int m = e ? 3 : 0;
                const bool mine = e ? (fr >= 14) : (fr <= 1);
                const int slot = e ? (fr - 12) : fr;
                if (mine) {
#pragma unroll
                    for (int bj = 0; bj < 2; ++bj) {
                        const f32x4 v0 = acc[ai][bj][m][0], v1 = acc[ai][bj][m][1];
                        u32x4 w; w.x = cvtpk(v0[0], v0[1]); w.y = cvtpk(v0[2], v0[3]); w.z = cvtpk(v1[0], v1[1]); w.w = cvtpk(v1[2], v1[3]);
                        *(u32x4*)(UB + ((size_t)chunk * 4 + slot) * NUP + bj * DFF + gcol) = w;
                    }
                }
            }
#define CONV_TAP(t, u, g, ctl) asm("v_fmac_f32_dpp %0, %1, %2 " ctl " row_mask:0xf bank_mask:0xf bound_ctrl:0" : "+v"(t) : "v"(u), "v"(g))
            __builtin_amdgcn_sched_barrier(0);
            asm volatile("s_nop 1" ::: "memory");
#pragma unroll
            for (int n = 0; n < 2; ++n) {
                unsigned wpk[4][2]; float rlo[4];
                const int cg4 = gcol + 4 * n, cv4 = cg4 + DFF;
                const f32x4 g0v = *(const f32x4*)(cw + cg4), g1v = *(const f32x4*)(cw + NUP + cg4), g2v = *(const f32x4*)(cw + 2 * NUP + cg4), gbv = *(const f32x4*)(cb + cg4);
                const f32x4 h0v = *(const f32x4*)(cw + cv4), h1v = *(const f32x4*)(cw + NUP + cv4), h2v = *(const f32x4*)(cw + 2 * NUP + cv4), hbv = *(const f32x4*)(cb + cv4);
#pragma unroll
                for (int i = 0; i < 4; ++i) {
                    const float g0 = g0v[i], g1 = g1v[i], g2 = g2v[i], gb = gbv[i], h0 = h0v[i], h1 = h1v[i], h2 = h2v[i], hb = hbv[i];
                    float gt[4], vl[4];
#pragma unroll
                    for (int m = 0; m < 4; ++m) { gt[m] = __builtin_fmaf(g1, acc[ai][0][m][n][i], gb); vl[m] = __builtin_fmaf(h1, acc[ai][1][m][n][i], hb); }
#pragma unroll
                    for (int m = 0; m < 4; ++m) {
                        CONV_TAP(gt[m], acc[ai][0][m][n][i], g0, "row_shr:1"); CONV_TAP(gt[m], acc[ai][0][m][n][i], g2, "row_shl:1");
                        CONV_TAP(vl[m], acc[ai][1][m][n][i], h0, "row_shr:1"); CONV_TAP(vl[m], acc[ai][1][m][n][i], h2, "row_shl:1");
                        if (m > 0) { CONV_TAP(gt[m], acc[ai][0][m - 1][n][i], g0, "row_shl:15"); CONV_TAP(vl[m], acc[ai][1][m - 1][n][i], h0, "row_shl:15"); }
                        if (m < 3) { CONV_TAP(gt[m], acc[ai][0][m + 1][n][i], g2, "row_shr:15"); CONV_TAP(vl[m], acc[ai][1][m + 1][n][i], h2, "row_shr:15"); }
                    }
#pragma unroll
                    for (int m = 0; m < 4; ++m) {
                        const float sg = gt[m] * fast_rcp(1.f + fast_exp2(-LOG2E * gt[m]));
                        const float rv = sg * vl[m];
                        if (i & 1) wpk[m][i >> 1] = cvtpk(rlo[m], rv); else rlo[m] = rv;
                    }
                    asm volatile("" ::: "memory");
                }
#pragma unroll
                for (int m = 0; m < 4; ++m) { u32x2 w; w.x = wpk[m][0]; w.y = wpk[m][1];
                    *(u32x2*)(ACT + (size_t)(row0 + ai * 128 + m * 16) * DFF + gcol + 4 * n) = w; }
                asm volatile("" ::: "memory");
            }
#undef CONV_TAP
        }
    }
};

constexpr float AT_THR = 8.0f;
constexpr int AT_BUF = 20480, AT_V = 12288, AT_TAB = 3 * AT_BUF, AT_TABC = 16384 + 64;
static_assert(AT_TAB + 4 * AT_TABC <= 131072, "attention LDS");
__device__ __forceinline__ float xmax(float a) { auto rr = __builtin_amdgcn_permlane32_swap(__float_as_uint(a), __float_as_uint(a), false, false); return fmaxf(__uint_as_float(rr[0]), __uint_as_float(rr[1])); }
__device__ __forceinline__ float xsum(float a) { auto rr = __builtin_amdgcn_permlane32_swap(__float_as_uint(a), __float_as_uint(a), false, false); return __uint_as_float(rr[0]) + __uint_as_float(rr[1]); }
__device__ __forceinline__ u32x4 pair_swap(u32x2 a, u32x2 b) {
    auto r0 = __builtin_amdgcn_permlane32_swap(a.x, b.x, false, false);
    auto r1 = __builtin_amdgcn_permlane32_swap(a.y, b.y, false, false);
    return (u32x4){r0[0], r1[0], r0[1], r1[1]};
}
typedef short v4i16_t __attribute__((ext_vector_type(4)));
__device__ __forceinline__ s16x4 vtr(const LAS unsigned char* p) { return __builtin_bit_cast(s16x4, __builtin_amdgcn_ds_read_tr16_b64_v4i16((LAS v4i16_t*)p)); }

template <int MODE, int NQ>
__device__ __forceinline__ void attn_unit(LAS unsigned char* lds, const Params& P, int layer, int b, int h, int qb) {
    constexpr int NMAP = (MODE == 1) ? 2 : 1, ND0 = (MODE == 0) ? 6 : (MODE == 1 ? 2 : 4), NC = NQ * NMAP, QROWS = 256 * NQ;
    int tid = threadIdx.x; asm volatile("" : "+v"(tid));
    const int lane = tid & 63, r32 = lane & 31, hi = lane >> 5, wave = __builtin_amdgcn_readfirstlane(tid >> 6);
    const bf16_t* proj = (const bf16_t*)(P.ws + WS_PROJ); const bf16_t* cq = (const bf16_t*)(P.ws + WS_CQ); const bf16_t* ckv = (const bf16_t*)(P.ws + WS_CKV);
    bf16_t* mix = (bf16_t*)(P.ws + WS_MIX);
    const size_t rowbase = (size_t)b * SEQ; const int q0 = qb * QROWS;
    const bf16_t *Qp, *Kp, *Vp; int qpitch, kpitch, vpitch, ocol; float c;
    if (MODE == 0) { Qp = cq + h * 96; qpitch = PCQ; Kp = ckv + h * 128; kpitch = PCKV; Vp = ckv + h * 128 + 64; vpitch = PCKV; ocol = 512 + h * 64; c = 0.10206207261596577f * LOG2E; }
    else if (MODE == 1) { Qp = proj + h * 64; qpitch = NPROJ; Kp = proj + 256 + h * 64; kpitch = NPROJ; Vp = proj + 512 + h * 64; vpitch = NPROJ; ocol = h * 64; c = 0.17677669529663687f * LOG2E; }
    else { Qp = proj + 768 + h * 64; qpitch = NPROJ; Kp = proj + 1024 + h * 64; kpitch = NPROJ; Vp = proj + 1280 + h * 64; vpitch = NPROJ; ocol = 256 + h * 64; c = 0.125f * LOG2E; }
    int kt0 = 0, kt1 = SEQ / 64;
    if (MODE == 2) { kt0 = (q0 - 1024) / 64; if (kt0 < 0) kt0 = 0; kt1 = (q0 + QROWS + 1024) / 64; if (kt1 > SEQ / 64) kt1 = SEQ / 64; }
    LAS unsigned char* tabb = lds + AT_TAB;
    if (MODE != 0) {
        const float slope = (MODE == 1) ? exp2f(-(float)(2 * h + 1)) : exp2f(-(float)(2 * h + 2));
        for (int jj = tid; jj < 4 * 4096; jj += 512) {
            const int sc_ = jj >> 12, j = (jj & 4095) + sc_;
            const int d = (j > 2047) ? (j - 2047) : (2047 - j);
            float v = -slope * LOG2E * (float)d;
            if (MODE == 2) {
                const int mult = (d <= 64 ? 1 : 0) + (((d & 3) == 0 && d <= 256) ? 1 : 0) + (((d & 15) == 0 && d <= 1024) ? 1 : 0);
                v = (mult == 0) ? -1e30f : (mult == 1 ? v : (mult == 2 ? v + 1.0f : v + 1.5849625007211562f));
            }
            *(LAS float*)(tabb + sc_ * AT_TABC + (jj & 4095) * 4) = v;
        }
    }
    const int qpos0 = q0 + wave * (32 * NQ) + r32;
    const int tb0_ = 4 * hi - qpos0 + 2047, ts_ = tb0_ & 3;
    const LAS unsigned char* tlane = tabb + ts_ * AT_TABC + (tb0_ - ts_) * 4;
    bf16x8 qf[NC][ND0];
#pragma unroll
    for (int jq = 0; jq < NQ; ++jq) {
        const bf16_t* qrow = Qp + (rowbase + qpos0 + 32 * jq) * qpitch + hi * 8;
#pragma unroll
        for (int mp = 0; mp < NMAP; ++mp)
#pragma unroll
            for (int d0 = 0; d0 < ND0; ++d0) qf[jq * NMAP + mp][d0] = *(const bf16x8*)(qrow + mp * 32 + d0 * 16);
    }
    u32x4 kreg, kreg2 = (u32x4){0u, 0u, 0u, 0u}, vreg;
#define AT_GLOADK(kt) do { const size_t r_ = rowbase + (size_t)(kt) * 64; \
        kreg = *(const u32x4*)(Kp + (r_ + lane) * kpitch + wave * 8); \
        if (MODE == 0 && wave < 4) kreg2 = *(const u32x4*)(proj + (r_ + lane) * NPROJ + 1920 + wave * 8); } while (0)
#define AT_GLOADV(kt) do { const size_t r_ = rowbase + (size_t)(kt) * 64; \
        vreg = *(const u32x4*)(Vp + (r_ + 16 * (wave & 3) + (lane >> 2)) * vpitch + (wave >> 2) * 32 + (lane & 3) * 8); } while (0)
#define AT_LSTOREK(buf) do { LAS unsigned char* d_ = lds + (buf) * AT_BUF; \
        *(LAS u32x4*)(d_ + wave * 1024 + lane * 16) = kreg; \
        if (MODE == 0 && wave < 4) *(LAS u32x4*)(d_ + (8 + wave) * 1024 + lane * 16) = kreg2; } while (0)
#define AT_LSTOREV(buf) do { LAS unsigned char* d_ = lds + (buf) * AT_BUF; \
        *(LAS u32x4*)(d_ + AT_V + wave * 1024 + lane * 16) = vreg; } while (0)
    float mrun[NC], lrun[NC]; f32x16 o[NC][2];
#pragma unroll
    for (int cc = 0; cc < NC; ++cc) { mrun[cc] = -1e20f; lrun[cc] = 0.f; o[cc][0] = f32x16{}; o[cc][1] = f32x16{}; }
    constexpr int NK = NMAP * ND0;
    const bf16x8 ones8 = (bf16x8){0x3F80, 0x3F80, 0x3F80, 0x3F80, 0x3F80, 0x3F80, 0x3F80, 0x3F80};
    const bf16x8 zero8 = (bf16x8){0, 0, 0, 0, 0, 0, 0, 0};
    bf16x8 kf[NK]; s16x4 vlo[4], vhi[4];
#define AT_KLOAD(bufbase, hf) do { _Pragma("unroll") for (int j_ = 0; j_ < NK; ++j_) kf[j_] = *(const LAS bf16x8*)((bufbase) + (2 * j_ + hi) * 1024 + (hf) * 512 + r32 * 16); } while (0)
#define AT_VLOAD(bufbase, hf) do { _Pragma("unroll") for (int dv_ = 0; dv_ < 2; ++dv_) _Pragma("unroll") for (int k2_ = 0; k2_ < 2; ++k2_) { \
        vlo[dv_ * 2 + k2_] = vtr((bufbase) + AT_V + vlane + dv_ * 4096 + (2 * (hf) + k2_) * 1024); vhi[dv_ * 2 + k2_] = vtr((bufbase) + AT_V + vlane + dv_ * 4096 + (2 * (hf) + k2_) * 1024 + 512); } } while (0)
    const int vlane = ((lane >> 4) & 1) * 32 + (lane & 3) * 8 + (4 * hi + ((lane & 15) >> 2)) * 64;
    const int NT = kt1 - kt0, ks = (MODE != 0) ? (q0 / 64 - kt0) : 0;
#define AT_TILE(i) (kt0 + (((ks + (i)) >= NT) ? (ks + (i) - NT) : (ks + (i))))
    AT_GLOADK(AT_TILE(0)); AT_GLOADV(AT_TILE(0)); AT_LSTOREK(0); AT_LSTOREV(0);
    if (1 < NT) { AT_GLOADK(AT_TILE(1)); AT_GLOADV(AT_TILE(1)); AT_LSTOREK(1); AT_LSTOREV(1); }
    __syncthreads();
    AT_KLOAD(lds, 0);
    if (wave >= 4) __builtin_amdgcn_s_setprio(1);
    int bcur = 0;
    for (int it = 0; it < NT; ++it) {
        const int kt = AT_TILE(it);
        const int bnx = (bcur == 2) ? 0 : bcur + 1, bn2 = (bnx == 2) ? 0 : bnx + 1;
        const LAS unsigned char* cur = lds + bcur * AT_BUF;
        const LAS unsigned char* nxt = lds + bnx * AT_BUF;
#pragma unroll
        for (int hf = 0; hf < 2; ++hf) {
            if (it + 2 < NT) { if (hf == 0) AT_GLOADK(AT_TILE(it + 2)); else AT_GLOADV(AT_TILE(it + 2)); }
            f32x16 sc[NC];
#pragma unroll
            for (int cc = 0; cc < NC; ++cc) {
                sc[cc] = f32x16{};
#pragma unroll
                for (int d0 = 0; d0 < ND0; ++d0) sc[cc] = __builtin_amdgcn_mfma_f32_32x32x16_bf16(kf[(cc % NMAP) * ND0 + d0], qf[cc][d0], sc[cc], 0, 0, 0);
            }
            __builtin_amdgcn_sched_barrier(0);
            AT_VLOAD(cur, hf);
            if (hf == 0) AT_KLOAD(cur, 1); else if (it + 1 < NT) AT_KLOAD(nxt, 0);
            __builtin_amdgcn_sched_barrier(0);
            bf16x8 pw[NC][2]; float rmrel[NC]; bool alive = false;
#pragma unroll
            for (int cc = 0; cc < NC; ++cc) {
                f32x16& s0 = sc[cc];
                float mn;
                if (MODE != 0) {
                    const LAS f32x4* tp4 = (const LAS f32x4*)(tlane + (kt * 64 + hf * 32) * 4);
                    float rm = -3e38f;
#pragma unroll
                    for (int g = 0; g < 4; ++g) { const f32x4 t4 = tp4[2 * g];
#pragma unroll
                        for (int i = 0; i < 4; ++i) { s0[4 * g + i] = s0[4 * g + i] * c + t4[i]; rm = fmaxf(rm, s0[4 * g + i]); } }
                    rm = xmax(rm);
                    mn = fmaxf(mrun[cc], rm);
                    rmrel[cc] = rm;
                } else {
                    float rm = -3e38f;
#pragma unroll
                    for (int r = 0; r < 16; ++r) rm = fmaxf(rm, s0[r]);
                    rm = xmax(rm);
                    mn = fmaxf(mrun[cc], rm * c);
                }
                if (__any(mn > mrun[cc] + AT_THR)) {
                    const float al = fast_exp2(mrun[cc] - mn); lrun[cc] *= al;
#pragma unroll
                    for (int r = 0; r < 16; ++r) { o[cc][0][r] *= al; o[cc][1][r] *= al; }
                    mrun[cc] = mn;
                }
                mn = mrun[cc];
                if (MODE != 0) rmrel[cc] -= mn;
                const bool dead = (MODE != 0) && __all(rmrel[cc] < -136.f);
                if (dead) { pw[cc][0] = zero8; pw[cc][1] = zero8; }
                else {
                    alive = true;
                    if (MODE != 0) {
#pragma unroll
                        for (int r = 0; r < 16; ++r) s0[r] = fast_exp2(s0[r] - mn);
                    } else {
                        const float nm = -mn;
#pragma unroll
                        for (int r = 0; r < 16; ++r) s0[r] = fast_exp2(__builtin_fmaf(s0[r], c, nm));
                    }
                    u32x4 w;
                    w.x = cvtpk(s0[0], s0[1]); w.y = cvtpk(s0[2], s0[3]); w.z = cvtpk(s0[4], s0[5]); w.w = cvtpk(s0[6], s0[7]); pw[cc][0] = __builtin_bit_cast(bf16x8, w);
                    w.x = cvtpk(s0[8], s0[9]); w.y = cvtpk(s0[10], s0[11]); w.z = cvtpk(s0[12], s0[13]); w.w = cvtpk(s0[14], s0[15]); pw[cc][1] = __builtin_bit_cast(bf16x8, w);
                    f32x16 t = __builtin_amdgcn_mfma_f32_32x32x16_bf16(ones8, pw[cc][0], f32x16{}, 0, 0, 0);
                    t = __builtin_amdgcn_mfma_f32_32x32x16_bf16(ones8, pw[cc][1], t, 0, 0, 0);
                    lrun[cc] += t[0];
                }
            }
            if (alive)
#pragma unroll
            for (int dv = 0; dv < 2; ++dv)
#pragma unroll
                for (int k2 = 0; k2 < 2; ++k2) {
                    const s16x4 lo = vlo[dv * 2 + k2], hh = vhi[dv * 2 + k2];
                    const bf16x8 vf = (bf16x8){lo[0], lo[1], lo[2], lo[3], hh[0], hh[1], hh[2], hh[3]};
#pragma unroll
                    for (int cc = 0; cc < NC; ++cc) o[cc][dv] = __builtin_amdgcn_mfma_f32_32x32x16_bf16(vf, pw[cc][k2], o[cc][dv], 0, 0, 0);
                }
            if (it + 2 < NT) { if (hf == 0) AT_LSTOREK(bn2); else AT_LSTOREV(bn2); }
        }
        __syncthreads();
        bcur = bnx;
    }
    __builtin_amdgcn_s_setprio(0);
#undef AT_KLOAD
#undef AT_VLOAD
#undef AT_TILE
#undef AT_GLOADK
#undef AT_GLOADV
#undef AT_LSTOREK
#undef AT_LSTOREV
    if (MODE != 1) {
#pragma unroll
        for (int jq = 0; jq < NQ; ++jq) {
            bf16_t* orow = mix + (rowbase + qpos0 + 32 * jq) * DM + ocol + 8 * hi;
            const float inv = 1.f / lrun[jq];
#pragma unroll
            for (int d = 0; d < 2; ++d)
#pragma unroll
                for (int gp = 0; gp < 2; ++gp) {
                    u32x2 a, b; const int g0 = 2 * gp, g1 = 2 * gp + 1;
                    a.x = cvtpk(o[jq][d][4 * g0] * inv, o[jq][d][4 * g0 + 1] * inv); a.y = cvtpk(o[jq][d][4 * g0 + 2] * inv, o[jq][d][4 * g0 + 3] * inv);
                    b.x = cvtpk(o[jq][d][4 * g1] * inv, o[jq][d][4 * g1 + 1] * inv); b.y = cvtpk(o[jq][d][4 * g1 + 2] * inv, o[jq][d][4 * g1 + 3] * inv);
                    *(u32x4*)(orow + 32 * d + 16 * gp) = pair_swap(a, b);
                }
        }
    } else {
        bf16_t* orow = mix + (rowbase + qpos0) * DM + ocol + 8 * hi;
        const float lam = __hip_atomic_load((const float*)(P.ws + WS_LAM) + layer, __ATOMIC_RELAXED, __HIP_MEMORY_SCOPE_AGENT);
        const float lam_init = 0.8f - 0.6f * expf(-0.3f * (float)layer);
        const float i1 = 1.f / lrun[0], i2 = lam / lrun[NC - 1];
        float ss = 0.f;
#pragma unroll
        for (int d = 0; d < 2; ++d)
#pragma unroll
            for (int r = 0; r < 16; ++r) { const float v = o[0][d][r] * i1 - o[NC - 1][d][r] * i2; o[0][d][r] = v; ss += v * v; }
        ss = xsum(ss);
        const float sc_ = rsqrtf(ss * (1.0f / 64.0f) + EPS) * (1.f - lam_init);
        const float* gn = P.a_subln + layer * 64 + 4 * hi;
#pragma unroll
        for (int d = 0; d < 2; ++d)
#pragma unroll
            for (int gp = 0; gp < 2; ++gp) {
                u32x2 ab[2];
#pragma unroll
                for (int e = 0; e < 2; ++e) { const int g = 2 * gp + e;
                    const f32x4 gv = *(const f32x4*)(gn + 32 * d + 8 * g);
                    ab[e].x = cvtpk(o[0][d][4 * g] * sc_ * gv[0], o[0][d][4 * g + 1] * sc_ * gv[1]); ab[e].y = cvtpk(o[0][d][4 * g + 2] * sc_ * gv[2], o[0][d][4 * g + 3] * sc_ * gv[3]); }
                *(u32x4*)(orow + 32 * d + 16 * gp) = pair_swap(ab[0], ab[1]);
            }
    }
}

constexpr int TT_PITCH = 272;
__device__ __forceinline__ void transpose_tile(const float* W, int K, int Nsrc, const float* g, bf16_t* WT, int n0_dst, int n0_src, int nvalid, int k0, LAS unsigned char* lds, int tid) {
    const int kgrp = tid >> 5, c4 = tid & 31;
    f32x4 v[8];
#pragma unroll
    for (int r = 0; r < 8; ++r) v[r] = (4 * c4 < nvalid) ? *(const f32x4*)(W + (size_t)(k0 + kgrp * 8 + r) * Nsrc + n0_src + 4 * c4) : (f32x4){0.f, 0.f, 0.f, 0.f};
    if (g) {
#pragma unroll
        for (int r = 0; r < 8; ++r) v[r] = v[r] * g[k0 + kgrp * 8 + r];
    }
#pragma unroll
    for (int j = 0; j < 4; ++j) {
        u32x4 w; w.x = cvtpk(v[0][j], v[1][j]); w.y = cvtpk(v[2][j], v[3][j]); w.z = cvtpk(v[4][j], v[5][j]); w.w = cvtpk(v[6][j], v[7][j]);
        *(LAS u32x4*)(lds + (4 * c4 + j) * TT_PITCH + kgrp * 16) = w;
    }
    __syncthreads();
    const int n = tid >> 2, q = tid & 3;
    bf16_t* dst = WT + (size_t)(n0_dst + n) * K + k0 + q * 32;
#pragma unroll
    for (int e = 0; e < 4; ++e) *(u32x4*)(dst + e * 8) = *(const LAS u32x4*)(lds + n * TT_PITCH + q * 64 + e * 16);
    __syncthreads();
}

__device__ __forceinline__ void zero_f32(float* p, int n) { for (int i = blockIdx.x * 512 + threadIdx.x; i < n; i += gridDim.x * 512) p[i] = 0.f; }

__device__ __forceinline__ void prologue(const Params& P, LAS unsigned char* lds) {
    const int tid = threadIdx.x, lane = tid & 63, wave = tid >> 6;
    const int gw = blockIdx.x * 8 + wave, NGW = gridDim.x * 8;
    constexpr int I_IN = 8 * 16, I_OUT = 8 * 8, I_UP = 8 * 44, I_DN = 22 * 8, I_UQ = 2 * 6, I_UKV = 8, I_L = I_IN + I_OUT + I_UP + I_DN + I_UQ + I_UKV;
    for (int it = blockIdx.x; it < I_L * DEPTH; it += gridDim.x) {
        const int l = it / I_L; int r = it % I_L;
        unsigned char* wl = P.ws + WS_W + (size_t)l * W_LAYER;
        if (r < I_IN) { const int kb = r / 16, nb = r % 16; transpose_tile(P.w_in + (size_t)l * DM * NIN, DM, NIN, P.g_attn + l * DM, (bf16_t*)(wl + W_IN), nb * 128, nb * 128, (nb < 15) ? 128 : 32, kb * 128, lds, tid); continue; } r -= I_IN;
        if (r < I_OUT) { const int kb = r / 8, nb = r % 8; transpose_tile(P.w_out + (size_t)l * DM * DM, DM, DM, nullptr, (bf16_t*)(wl + W_OUT), nb * 128, nb * 128, 128, kb * 128, lds, tid); continue; } r -= I_OUT;
        if (r < I_UP) { const int kb = r / 44, nb = r % 44; transpose_tile(P.w_up + (size_t)l * DM * NUP, DM, NUP, P.g_ffn + l * DM, (bf16_t*)(wl + W_UP), nb * 128, (nb & 1) * DFF + (nb >> 1) * 128, 128, kb * 128, lds, tid); continue; } r -= I_UP;
        if (r < I_DN) { const int kb = r / 8, nb = r % 8; transpose_tile(P.w_down + (size_t)l * DFF * DM, DFF, DM, nullptr, (bf16_t*)(wl + W_DOWN), nb * 128, nb * 128, 128, kb * 128, lds, tid); continue; } r -= I_DN;
        if (r < I_UQ) { const int kb = r / 6, nb = r % 6; transpose_tile(P.c_w_uq + (size_t)l * 256 * NCQ, 256, NCQ, P.c_g_q + l * 256, (bf16_t*)(wl + W_UQ), nb * 128, nb * 128, 128, kb * 128, lds, tid); continue; } r -= I_UQ;
        { const int nb = r; transpose_tile(P.c_w_ukv + (size_t)l * 128 * NCKV, 128, NCKV, P.c_g_kv + l * 128, (bf16_t*)(wl + W_UKV), nb * 128, nb * 128, 128, 0, lds, tid); }
    }
    float* ssqA = (float*)(P.ws + WS_SSQA); bf16_t* xb = (bf16_t*)(P.ws + WS_XB);
    for (int m = gw; m < T_TOK; m += NGW) {
        const f32x4* xr = (const f32x4*)(P.x + (size_t)m * DM) + lane; u32x2* brow = (u32x2*)(xb + (size_t)m * DM) + lane;
        float s = 0.f;
#pragma unroll
        for (int j = 0; j < 4; ++j) { const f32x4 v = xr[64 * j]; u32x2 w; w.x = cvtpk(v[0], v[1]); w.y = cvtpk(v[2], v[3]); brow[64 * j] = w; s += (v[0] * v[0] + v[1] * v[1]) + (v[2] * v[2] + v[3] * v[3]); }
        s = wave_sum(s);
        if (lane < 16) ssqA[(size_t)m * 16 + lane] = lane ? 0.f : s;
    }
    float* cost = (float*)(P.ws + WS_COS); float* sint = (float*)(P.ws + WS_SIN);
    for (int i = blockIdx.x * 512 + tid; i < SEQ * 16; i += gridDim.x * 512) {
        const int pos = i >> 4, j = i & 15; const float inv = exp2f(-(float)j * (13.287712379549449f / 16.0f)); const float ang = (float)pos * inv;
        cost[i] = cosf(ang); sint[i] = sinf(ang);
    }
    if (blockIdx.x == 0 && tid < DEPTH) {
        float d1 = 0.f, d2 = 0.f;
        for (int j = 0; j < 32; ++j) { d1 += P.a_lq1[tid * 32 + j] * P.a_lk1[tid * 32 + j]; d2 += P.a_lq2[tid * 32 + j] * P.a_lk2[tid * 32 + j]; }
        ((float*)(P.ws + WS_LAM))[tid] = expf(d1) - expf(d2) + (0.8f - 0.6f * expf(-0.3f * (float)tid));
    }
}

__device__ __forceinline__ void ffn_fixup(const Params& P, int layer) {
    const bf16_t* UB = (const bf16_t*)(P.ws + WS_UBND); bf16_t* ACT = (bf16_t*)(P.ws + WS_ACT);
    const float* cw = P.conv_w + (size_t)layer * 3 * NUP; const float* cb = P.conv_b + (size_t)layer * NUP;
    constexpr int CG = DFF / 8;
    for (int it = blockIdx.x * 512 + threadIdx.x; it < 512 * 2 * CG; it += gridDim.x * 512) {
        const int cgi = it % CG, e = (it / CG) & 1, chunk = it / (2 * CG), col = cgi * 8;
        const bf16_t *up, *mid, *dn; bool zu = false, zd = false;
        if (e == 0) { zu = (chunk % 32) == 0; up = UB + ((size_t)(zu ? chunk : chunk - 1) * 4 + 3) * NUP; mid = UB + ((size_t)chunk * 4 + 0) * NUP; dn = UB + ((size_t)chunk * 4 + 1) * NUP; }
        else { zd = (chunk % 32) == 31; up = UB + ((size_t)chunk * 4 + 2) * NUP; mid = UB + ((size_t)chunk * 4 + 3) * NUP; dn = UB + ((size_t)(zd ? chunk : chunk + 1) * 4 + 0) * NUP; }
        const float fu = zu ? 0.f : 1.f, fd = zd ? 0.f : 1.f;
        float res[8];
        bf16_t ug[8], mg[8], dg[8], uv[8], mv[8], dv[8];
        *(u32x4*)ug = *(const u32x4*)(up + col); *(u32x4*)mg = *(const u32x4*)(mid + col); *(u32x4*)dg = *(const u32x4*)(dn + col);
        *(u32x4*)uv = *(const u32x4*)(up + DFF + col); *(u32x4*)mv = *(const u32x4*)(mid + DFF + col); *(u32x4*)dv = *(const u32x4*)(dn + DFF + col);
#pragma unroll
        for (int k = 0; k < 8; ++k) {
            const int cg_ = col + k, cv_ = DFF + col + k;
            const float gt = cw[cg_] * bf2f(ug[k]) * fu + cw[NUP + cg_] * bf2f(mg[k]) + cw[2 * NUP + cg_] * bf2f(dg[k]) * fd + cb[cg_];
            const float vl = cw[cv_] * bf2f(uv[k]) * fu + cw[NUP + cv_] * bf2f(mv[k]) + cw[2 * NUP + cv_] * bf2f(dv[k]) * fd + cb[cv_];
            res[k] = gt * fast_rcp(1.f + fast_exp2(-LOG2E * gt)) * vl;
        }
        u32x4 w; w.x = cvtpk(res[0], res[1]); w.y = cvtpk(res[2], res[3]); w.z = cvtpk(res[4], res[5]); w.w = cvtpk(res[6], res[7]);
        *(u32x4*)(ACT + (size_t)(chunk * 64 + (e ? 63 : 0)) * DFF + col) = w;
    }
}


#define XB_TMO      128
#define XB_XCNT(j)  (256  + 64 * (j))
#define XB_XSUB(j)  (1280 + 64 * (j))
#define XB_XGEN(j)  (2304 + 64 * (j))
#define XB_TOP      3328
#define XB_TOPGEN   3392
#define XCD_BAR_WORDS 3456
#define XB_SPIN_CAP (1u << 22)
__device__ __forceinline__ unsigned xb_ld(unsigned* p)              { return __hip_atomic_load(p, __ATOMIC_RELAXED, __HIP_MEMORY_SCOPE_AGENT); }
__device__ __forceinline__ unsigned xb_add(unsigned* p, unsigned v) { return __hip_atomic_fetch_add(p, v, __ATOMIC_RELAXED, __HIP_MEMORY_SCOPE_AGENT); }
__device__ __forceinline__ unsigned xb_xcc_id() { return (unsigned)__builtin_amdgcn_s_getreg((3 << 11) | 20) & 0xFu; }
#define XB_SPIN(cond, bar) do { unsigned _sp = 0; while (cond) { __builtin_amdgcn_s_sleep(1); \
    if ((++_sp & 255u) == 0u) { if (xb_ld(&(bar)[XB_TMO])) break; if (_sp > XB_SPIN_CAP) { atomicAdd(&(bar)[XB_TMO], 1u); break; } } } } while (0)
struct XcdBarrier { unsigned* bar; unsigned x; volatile LAS unsigned* st; };
__device__ __forceinline__ XcdBarrier xcd_barrier_post(unsigned* bar, volatile LAS unsigned* st) {
    XcdBarrier b; b.bar = bar; b.x = xb_xcc_id(); b.st = st;
    if (threadIdx.x == 0) (void)xb_add(&bar[XB_XCNT(b.x)], 1u);
    return b;
}
__device__ __forceinline__ void xcd_barrier_complete(unsigned* bar, unsigned x, unsigned& nloc, unsigned& nx) {
    const unsigned G = gridDim.x * gridDim.y * gridDim.z;
    unsigned sum, cnt, mine, sp = 0u;
    for (;;) {
        sum = 0u; cnt = 0u; mine = 0u;
#pragma unroll
        for (unsigned j = 0; j < 16; ++j) { const unsigned c = xb_ld(&bar[XB_XCNT(j)]); sum += c; cnt += (c > 0u) ? 1u : 0u; mine = (j == x) ? c : mine; }
        if (sum == G) break;
        __builtin_amdgcn_s_sleep(1);
        if ((++sp & 255u) == 0u) { if (xb_ld(&bar[XB_TMO])) break; if (sp > XB_SPIN_CAP) { atomicAdd(&bar[XB_TMO], 1u); break; } }
    }
    nloc = mine > 0u ? mine : 1u; nx = cnt > 0u ? cnt : 1u;
}
__device__ __forceinline__ void xcd_barrier(const XcdBarrier& b) {
    asm volatile("s_waitcnt vmcnt(0)" ::: "memory");
    __syncthreads();
    if (threadIdx.x == 0) {
        unsigned* bar = b.bar;
        __builtin_amdgcn_s_waitcnt(0);
        unsigned nloc = b.st[0], nx = b.st[1];
        if (nloc == 0u) { xcd_barrier_complete(bar, b.x, nloc, nx); b.st[0] = nloc; b.st[1] = nx; }
        const unsigned old = xb_add(&bar[XB_XSUB(b.x)], 1u);
        const unsigned gen = old / nloc;
        if (old + 1u == (gen + 1u) * nloc) {
            __builtin_amdgcn_fence(__ATOMIC_RELEASE, "agent");
            asm volatile("s_waitcnt vmcnt(0)" ::: "memory");
            const unsigned og = xb_add(&bar[XB_TOP], 1u);
            const unsigned tg = og / nx;
            if (og + 1u == (tg + 1u) * nx) xb_add(&bar[XB_TOPGEN], 1u);
            else XB_SPIN(xb_ld(&bar[XB_TOPGEN]) == tg, bar);
            __builtin_amdgcn_fence(__ATOMIC_ACQUIRE, "agent");
            xb_add(&bar[XB_XGEN(b.x)], 1u);
            asm volatile("s_waitcnt vmcnt(0)" ::: "memory");
        } else {
            XB_SPIN(xb_ld(&bar[XB_XGEN(b.x)]) == gen, bar);
            __builtin_amdgcn_fence(__ATOMIC_ACQUIRE, "agent");
            asm volatile("s_waitcnt vmcnt(0)" ::: "memory");
        }
    }
    __syncthreads();
}

__global__ void __launch_bounds__(512, 2) fwd_megakernel(Params P) {
    extern __shared__ __attribute__((aligned(16))) unsigned char lds_raw[];
    LAS unsigned char* lds = (LAS unsigned char*)lds_raw;
    cg::grid_group grid = cg::this_grid();
#define GRID_SYNC() do { asm volatile("s_waitcnt vmcnt(0) lgkmcnt(0)" ::: "memory"); __syncthreads(); grid.sync(); \
        __builtin_amdgcn_fence(__ATOMIC_ACQUIRE, "agent"); asm volatile("s_waitcnt vmcnt(0)" ::: "memory"); GRID_SYNC2(); } while (0)
#if MK_DUP_SYNC > 1
#define GRID_SYNC2() do { grid.sync(); __builtin_amdgcn_fence(__ATOMIC_ACQUIRE, "agent"); asm volatile("s_waitcnt vmcnt(0)" ::: "memory"); } while (0)
#else
#define GRID_SYNC2() do {} while (0)
#endif
    unsigned char* ws = P.ws;
    if (ws == nullptr) grid.sync();
    float* ssqA = (float*)(ws + WS_SSQA); float* ssqB = (float*)(ws + WS_SSQB); float* ssqQ = (float*)(ws + WS_SSQQ); float* ssqKV = (float*)(ws + WS_SSQKV);
    const float* cost = (const float*)(ws + WS_COS); const float* sint = (const float*)(ws + WS_SIN);
    bf16_t* xb = (bf16_t*)(ws + WS_XB); bf16_t* proj = (bf16_t*)(ws + WS_PROJ); bf16_t* cq = (bf16_t*)(ws + WS_CQ); bf16_t* ckv = (bf16_t*)(ws + WS_CKV);
    bf16_t* mix = (bf16_t*)(ws + WS_MIX); bf16_t* act = (bf16_t*)(ws + WS_ACT); bf16_t* ubnd = (bf16_t*)(ws + WS_UBND);

    volatile LAS unsigned* bst = (volatile LAS unsigned*)(lds + 131072 + 64);
    if (threadIdx.x < 2) bst[threadIdx.x] = 0u;
    __syncthreads();
    const XcdBarrier xbar = xcd_barrier_post((unsigned*)(ws + WS_BAR), bst);
    prologue(P, lds);
#if MK_DUP_BAR > 1
#define XBAR() do { xcd_barrier(xbar); xcd_barrier(xbar); } while (0)
#else
#define XBAR() xcd_barrier(xbar)
#endif
    for (int l = 0; l <= DEPTH; ++l) {
        XBAR();
        if (l == DEPTH) break;
        const unsigned char* wl = ws + WS_W + (size_t)l * W_LAYER;
#if !(MK_SKIP & 1)
        { pg8::Gemm g{xb, (const bf16_t*)(wl + W_IN), T_TOK, NPROJW, DM, DM}; EpiProj E{proj, ssqA, ssqQ, ssqKV, cost, sint}; pg8::gemm_phase(lds, g, E); }
#if MK_DUP_IN > 1
        { pg8::Gemm g{xb, (const bf16_t*)(wl + W_IN), T_TOK, NPROJW, DM, DM}; EpiProj E{proj, ssqA, ssqQ, ssqKV, cost, sint}; pg8::gemm_phase(lds, g, E); }
#endif
#endif
        XBAR();
#if !(MK_SKIP & 2)
        { pg8::Gemm g{proj + 1536, (const bf16_t*)(wl + W_UQ), T_TOK, NCQ, 256, NPROJ}; EpiMla<true, 8> E{cq, PCQ, ssqQ, 1.0f / 256.0f, cost, sint};
          int cq_ = -1; if (gridDim.x == 256) { const int t_ = (int)blockIdx.x >> 6, tp_ = (t_ == 0) ? 0 : (t_ == 3) ? 1 : (t_ == 1) ? 2 : 3; cq_ = (tp_ << 6) | ((int)blockIdx.x & 63); }
          pg8::gemm_phase(lds, g, E, cq_); }
        { pg8::Gemm g{proj + 1792, (const bf16_t*)(wl + W_UKV), T_TOK, NCKV, 128, NPROJ}; EpiMla<false, 4> E{ckv, PCKV, ssqKV, 1.0f / 128.0f, cost, sint}; pg8::gemm_phase(lds, g, E); }
#if MK_DUP_MLA > 1
        { pg8::Gemm g{proj + 1536, (const bf16_t*)(wl + W_UQ), T_TOK, NCQ, 256, NPROJ}; EpiMla<true, 8> E{cq, PCQ, ssqQ, 1.0f / 256.0f, cost, sint};
          int cq_ = -1; if (gridDim.x == 256) { const int t_ = (int)blockIdx.x >> 6, tp_ = (t_ == 0) ? 0 : (t_ == 3) ? 1 : (t_ == 1) ? 2 : 3; cq_ = (tp_ << 6) | ((int)blockIdx.x & 63); }
          pg8::gemm_phase(lds, g, E, cq_); }
        { pg8::Gemm g{proj + 1792, (const bf16_t*)(wl + W_UKV), T_TOK, NCKV, 128, NPROJ}; EpiMla<false, 4> E{ckv, PCKV, ssqKV, 1.0f / 128.0f, cost, sint}; pg8::gemm_phase(lds, g, E); }
#endif
#endif
#if !(MK_SKIP & 4)
        for (int rep_ = 0; rep_ < MK_DUP_AB; ++rep_)
        {
            const bool xm = (gridDim.x == 256); const int x_ = blockIdx.x & 7, j_ = blockIdx.x >> 3;
            for (int u = blockIdx.x, i_ = 0; u < 512; u += gridDim.x, ++i_) {
                int bh = u >> 3, qb = u & 7;
                if (xm) { const int hh_ = i_ ? 3 - (j_ >> 3) : (j_ >> 3); bh = (x_ * 2 + i_) * 4 + hh_; qb = j_ & 7; }
                attn_unit<1, 1>(lds, P, l, bh >> 2, bh & 3, qb);
            }
            for (int u = blockIdx.x, i_ = 0; u < 512; u += gridDim.x, ++i_) {
                int bh = (u >> 3) & 63, qb = u & 7; if (u >= 256) qb = (qb + 4) & 7;
                if (xm) { const int hb_ = (j_ >> 3) ^ 1, hh_ = i_ ? 3 - hb_ : hb_; bh = (x_ * 2 + i_) * 4 + hh_; qb = ((j_ & 7) + 4 * i_) & 7; }
                attn_unit<2, 1>(lds, P, l, bh >> 2, bh & 3, qb);
            }
        }
#endif
        XBAR();
#if !(MK_SKIP & 8)
        for (int rep_ = 0; rep_ < MK_DUP_C; ++rep_)
        {
            const bool xm = (gridDim.x == 256); const int x_ = blockIdx.x & 7, j_ = blockIdx.x >> 3;
            for (int u = blockIdx.x, i_ = 0; u < 512; u += gridDim.x, ++i_) {
                int bh = u >> 2, qb = u & 3; if (xm) { bh = x_ * 16 + i_ * 8 + (j_ >> 2); qb = j_ & 3; }
                attn_unit<0, 2>(lds, P, l, bh >> 3, bh & 7, qb);
            }
        }
#endif
        XBAR();
#if !(MK_SKIP & 16)
        { pg8::Gemm g{mix, (const bf16_t*)(wl + W_OUT), T_TOK, DM, DM, DM}; EpiResid E{xb, ssqB}; pg8::gemm_phase(lds, g, E); }
#endif
        XBAR();
#if !(MK_SKIP & 32)
        { pg8::Gemm g{xb, (const bf16_t*)(wl + W_UP), T_TOK, NUP, DM, DM}; EpiUp E{act, ubnd, ssqB, P.conv_w + (size_t)l * 3 * NUP, P.conv_b + (size_t)l * NUP}; pg8::gemm_phase(lds, g, E); }
#if MK_DUP_UP > 1
        { pg8::Gemm g{xb, (const bf16_t*)(wl + W_UP), T_TOK, NUP, DM, DM}; EpiUp E{act, ubnd, ssqB, P.conv_w + (size_t)l * 3 * NUP, P.conv_b + (size_t)l * NUP}; pg8::gemm_phase(lds, g, E); }
#endif
#endif
        XBAR();
        ffn_fixup(P, l);
        XBAR();
#if !(MK_SKIP & 64)
        { pg8::Gemm g{act, (const bf16_t*)(wl + W_DOWN), T_TOK, DM, DFF, DFF}; EpiResid E{xb, ssqA}; pg8::gemm_phase(lds, g, E); }
#endif
    }
    for (int i = blockIdx.x * 512 + threadIdx.x; i < T_TOK * (DM / 4); i += gridDim.x * 512) {
        const int row = i >> 8, c4 = i & 255;
        const float rs = rsqrtf(ssq_sum<16>(ssqA + (size_t)row * 16) * (1.0f / DM) + EPS);
        const u32x2 xv = ((const u32x2*)xb)[i]; const f32x4 gv = ((const f32x4*)P.g_final)[c4];
        f32x4 v; v[0] = __uint_as_float(xv.x << 16); v[1] = __uint_as_float(xv.x & 0xffff0000u); v[2] = __uint_as_float(xv.y << 16); v[3] = __uint_as_float(xv.y & 0xffff0000u);
        ((f32x4*)P.out)[i] = v * rs * gv;
    }
}

extern "C" void kernel_launch(void* const* d_in, const int* in_sizes, int n_in, void* d_out, int out_size, void* d_ws, size_t ws_size, hipStream_t stream) {
    static int grid_blocks = 0;
    if (!grid_blocks) {
        if (n_in != 19 || ws_size < WS_END) { fprintf(stderr, "kernel_launch: unexpected n_in %d / ws %zu\n", n_in, ws_size); grid_blocks = -1; return; }
        int dev = 0, cus = 0, per_cu = 0;
        hipGetDevice(&dev);
        hipDeviceGetAttribute(&cus, hipDeviceAttributeMultiprocessorCount, dev);
        hipFuncSetAttribute((const void*)fwd_megakernel, hipFuncAttributeMaxDynamicSharedMemorySize, LDS_BYTES);
        hipOccupancyMaxActiveBlocksPerMultiprocessor(&per_cu, (const void*)fwd_megakernel, 512, LDS_BYTES);
        if (per_cu < 1) { fprintf(stderr, "kernel_launch: occupancy query says %d blocks/CU\n", per_cu); per_cu = 1; }
        grid_blocks = cus * per_cu;
    }
    if (grid_blocks < 0) return;
    Params p{};
    const float** f = (const float**)&p;
    for (int i = 0; i < 19; ++i) f[i] = (const float*)d_in[i];
    p.out = (float*)d_out; p.ws = (unsigned char*)d_ws;
    (void)hipMemsetAsync((char*)d_ws + WS_BAR, 0, WS_BAR_BYTES, stream);
    void* args[] = {&p};
    hipError_t e = hipLaunchCooperativeKernel((const void*)fwd_megakernel, dim3(grid_blocks), dim3(512), args, LDS_BYTES, stream);
    if (e != hipSuccess) fprintf(stderr, "cooperative launch failed: %s (grid %d)\n", hipGetErrorString(e), grid_blocks);
}
```

```cpp
#include <hip/hip_runtime.h>
#include <hip/hip_cooperative_groups.h>
#include <cstdint>
#include <cstdio>
namespace cg = cooperative_groups;

#define LAS __attribute__((address_space(3)))
typedef unsigned short bf16_t;
typedef short bf16x8 __attribute__((ext_vector_type(8)));
typedef short s16x4 __attribute__((ext_vector_type(4)));
typedef float f32x4 __attribute__((ext_vector_type(4)));
typedef float f32x2 __attribute__((ext_vector_type(2)));
typedef float f32x16 __attribute__((ext_vector_type(16)));
typedef unsigned u32x4 __attribute__((ext_vector_type(4)));
typedef unsigned u32x2 __attribute__((ext_vector_type(2)));
typedef __bf16 bf16x2_t __attribute__((ext_vector_type(2)));

constexpr int T_TOK = 32768, SEQ = 2048, DM = 1024, DEPTH = 4;
constexpr int NPROJW = 2048, NPROJ = 2112, NIN = 1952, DFF = 2816, NUP = 5632;
constexpr int NCQ = 768, NCKV = 1024, PCQ = 832, PCKV = 1088;
constexpr float EPS = 1e-6f;
constexpr float LOG2E = 1.4426950408889634f;

constexpr size_t MiB = 1u << 20;
constexpr size_t WS_BAR = 0, WS_BAR_BYTES = 16384;
constexpr size_t WS_LAM = 512 * 1024;
constexpr size_t WS_COS = 576 * 1024, WS_SIN = 704 * 1024;
constexpr size_t WS_W = 1 * MiB;
constexpr size_t W_IN = 0, W_OUT = W_IN + (size_t)NPROJW * DM * 2, W_UP = W_OUT + (size_t)DM * DM * 2, W_DOWN = W_UP + (size_t)NUP * DM * 2,
                 W_UQ = W_DOWN + (size_t)DM * DFF * 2, W_UKV = W_UQ + (size_t)NCQ * 256 * 2, W_LAYER = W_UKV + (size_t)NCKV * 128 * 2;
static_assert(W_LAYER * DEPTH <= 93 * MiB, "weights");
constexpr size_t WS_XB = 94 * MiB, WS_PROJ = 158 * MiB, WS_CQ = 290 * MiB, WS_CKV = 342 * MiB, WS_MIX = 410 * MiB;
constexpr size_t WS_SSQA = 474 * MiB, WS_SSQB = 476 * MiB, WS_SSQQ = 478 * MiB, WS_SSQKV = 479 * MiB, WS_END = 480 * MiB;
static_assert(WS_PROJ + (size_t)T_TOK * NPROJ * 2 <= WS_CQ && WS_CQ + (size_t)T_TOK * PCQ * 2 <= WS_CKV && WS_CKV + (size_t)T_TOK * PCKV * 2 <= WS_MIX, "attention tensors");
constexpr size_t WS_ACT = 158 * MiB, WS_UBND = 342 * MiB;
static_assert(WS_ACT + (size_t)T_TOK * DFF * 2 <= WS_UBND && WS_UBND + (size_t)512 * 4 * NUP * 2 <= WS_MIX, "overlay");

constexpr int LDS_BYTES = 147456;
#ifndef MK_SKIP
#define MK_SKIP 0
#endif
#ifndef MK_DUP_PRO
#define MK_DUP_PRO 1
#endif
#ifndef MK_DUP_SYNC
#define MK_DUP_SYNC 1
#endif
#ifndef MK_DUP_MLA
#define MK_DUP_MLA 1
#endif
#ifndef MK_DUP_BAR
#define MK_DUP_BAR 1
#endif
#ifndef MK_DUP_UP
#define MK_DUP_UP 1
#endif
#ifndef MK_DUP_IN
#define MK_DUP_IN 1
#endif
#ifndef MK_DUP_AB
#define MK_DUP_AB 1
#endif
#ifndef MK_DUP_C
#define MK_DUP_C 1
#endif

struct Params {
    const float* x; const float* w_in; const float* g_attn; const float* a_lq1; const float* a_lk1; const float* a_lq2; const float* a_lk2;
    const float* a_subln; const float* c_g_q; const float* c_w_uq; const float* c_g_kv; const float* c_w_ukv; const float* w_out; const float* g_ffn;
    const float* w_up; const float* conv_w; const float* conv_b; const float* w_down; const float* g_final;
    float* out; unsigned char* ws;
};

__device__ __forceinline__ unsigned cvtpk(float lo, float hi) { f32x2 v = {lo, hi}; bf16x2_t b = __builtin_convertvector(v, bf16x2_t); return __builtin_bit_cast(unsigned, b); }
__device__ __forceinline__ void st16_wt(void* p, u32x4 v) { *(u32x4*)p = v; }
__device__ __forceinline__ void st8_wt(void* p, u32x2 v) { *(u32x2*)p = v; }
__device__ __forceinline__ float bf2f(unsigned short b) { return __uint_as_float((unsigned)b << 16); }
__device__ __forceinline__ float wave_sum(float v) {
#pragma unroll
    for (int o = 1; o < 64; o <<= 1) v += __shfl_xor(v, o);
    return v;
}
__device__ __forceinline__ float ld_agent(const float* p) { return __hip_atomic_load(p, __ATOMIC_RELAXED, __HIP_MEMORY_SCOPE_AGENT); }
template <int NS> __device__ __forceinline__ float ssq_sum(const float* p) {
    float t = 0.f;
#pragma unroll
    for (int i = 0; i < NS / 4; ++i) { const f32x4 v = *(const f32x4*)(p + 4 * i); t += (v[0] + v[1]) + (v[2] + v[3]); }
    return t;
}
__device__ __forceinline__ float fast_exp2(float x) { return __builtin_amdgcn_exp2f(x); }
__device__ __forceinline__ float fast_rcp(float x) { return __builtin_amdgcn_rcpf(x); }

namespace pg8 {
constexpr int BM = 256, BK = 64, HALF = 128, HTB = HALF * BK * 2, STAGE_BYTES = 8 * HTB, NXCD = 8, WGM = 8;
__host__ __device__ __forceinline__ int lds_byte(int r, int c) { const int st = (r >> 4) * 2 + (c >> 5), rr = r & 15, cc = c & 31, ob = rr * 64 + cc * 2; return st * 1024 + (ob ^ (((ob >> 9) & 1) << 5)); }
__host__ __device__ __forceinline__ void stage_rc(int b, int& R, int& C) { const int st = b / 1024, sb = b % 1024, swz = sb ^ (((sb >> 9) & 1) << 5); R = (st >> 1) * 16 + swz / 64; C = (st & 1) * 32 + (swz % 64) / 2; }
__host__ __device__ __forceinline__ int perm32(int rho) { const int n = rho >> 4, i = rho & 15; return 8 * (i >> 2) + 4 * n + (i & 3); }
struct Unit { int pm, pn; };
struct Gemm { const bf16_t* A; const bf16_t* Bt; int M, N, K, lda; };
struct StaticOrder {
    int nM, nN, nwg, G, c;
    __device__ void init(int M, int N, int G_, int c_) { nM = M / BM; nN = N / BM; nwg = nM * nN; G = G_; c = c_; }
    __device__ bool next(int i, Unit& u) const {
        const long L = (long)i * G + c; if (L >= nwg) return false;
        int wgid = (int)L; { const int q = nwg / NXCD, r = nwg % NXCD, xcd = wgid % NXCD, off = wgid / NXCD; wgid = (xcd < r ? xcd * (q + 1) : r * (q + 1) + (xcd - r) * q) + off; }
        const int nig = WGM * nN, gid = wgid / nig, fm = gid * WGM, gsz = (nM - fm) < WGM ? (nM - fm) : WGM;
        u.pm = fm + ((wgid % nig) % gsz); u.pn = (wgid % nig) / gsz; return true;
    }
};

template <class Epi>
__device__ __forceinline__ void gemm_phase(LAS unsigned char* lds, const Gemm g, const Epi& E) {
    int tid = threadIdx.x; asm volatile("" : "+v"(tid));
    const int wid = __builtin_amdgcn_readfirstlane(tid >> 6), lane = tid & 63, wr = wid >> 2, wc = wid & 3, fr = lane & 15, fq = lane >> 4;
    int K = g.K, lda = g.lda; asm volatile("" : "+s"(K), "+s"(lda));
    const int nt = K / BK;
    StaticOrder S; S.init(g.M, g.N, (int)gridDim.x, (int)blockIdx.x);
    unsigned voffA[2], voffB[2];
#pragma unroll
    for (int i = 0; i < 2; ++i) { int R, C; stage_rc(tid * 16 + i * 8192, R, C); const int Rb = Epi::PERM ? ((R & ~31) + perm32(R & 31)) : R;
        voffA[i] = (unsigned)(R * lda + C) * 2u; voffB[i] = (unsigned)(Rb * K + C) * 2u; }
    const size_t kstep = (size_t)(BK * 2);
    const size_t hstepA = (size_t)HALF * lda * 2, hstepB = (size_t)HALF * K * 2;
    const size_t tstepA = 2 * hstepA, tstepB = 2 * hstepB;
    const unsigned ldsw = (unsigned)wid * 1024u;
    const int aoff = lds_byte(wr * 64 + fr, fq * 8), boff = lds_byte(wc * 32 + fr, fq * 8);
#define PG8_SA(b, h) (((b) * 2 + (h)) * HTB)
#define PG8_SB(b, h) ((4 + (b) * 2 + (h)) * HTB)
#define PG8_STAGE(bufoff, gbase, voff) do { _Pragma("unroll") for (int _i = 0; _i < 2; ++_i) \
        __builtin_amdgcn_global_load_lds((const unsigned*)((const char*)(gbase) + (voff)[_i]), (LAS unsigned*)(lds + (bufoff) + ldsw + _i * 8192), 16, 0, 0); } while (0)
#define PG8_LDA(dst, b, h) do { _Pragma("unroll") for (int m = 0; m < 4; ++m) _Pragma("unroll") for (int k = 0; k < 2; ++k) dst[m][k] = *(const LAS bf16x8*)(lds + PG8_SA(b, h) + aoff + m * 2048 + k * 1024); } while (0)
#define PG8_LDB(dst, b, h) do { _Pragma("unroll") for (int n = 0; n < 2; ++n) _Pragma("unroll") for (int k = 0; k < 2; ++k) dst[n][k] = *(const LAS bf16x8*)(lds + PG8_SB(b, h) + boff + n * 2048 + k * 1024); } while (0)
#define PG8_MMA(ai, bj, At, Bt) do { __builtin_amdgcn_s_setprio(1); _Pragma("unroll") for (int m = 0; m < 4; ++m) _Pragma("unroll") for (int n = 0; n < 2; ++n) _Pragma("unroll") for (int k = 0; k < 2; ++k) \
        acc[ai][bj][m][n] = __builtin_amdgcn_mfma_f32_16x16x32_bf16(Bt[n][k], At[m][k], acc[ai][bj][m][n], 0, 0, 0); __builtin_amdgcn_s_setprio(0); } while (0)
#define PG8_WAIT_V(n) asm volatile("s_waitcnt vmcnt(" #n ")" ::: "memory")
#define PG8_WAIT_L(n) asm volatile("s_waitcnt lgkmcnt(" #n ")" ::: "memory")
#define PG8_BAR __builtin_amdgcn_s_barrier()
#define PG8_SCHED __builtin_amdgcn_sched_barrier(0)
    Unit cur, nxt; int ui = 0;
    if (!S.next(0, cur)) return;
    f32x4 acc[2][2][4][2];
#pragma unroll
    for (int a = 0; a < 2; ++a)
#pragma unroll
        for (int b = 0; b < 2; ++b)
#pragma unroll
            for (int m = 0; m < 4; ++m)
#pragma unroll
                for (int n = 0; n < 2; ++n) acc[a][b][m][n] = (f32x4){0.f, 0.f, 0.f, 0.f};
    bf16x8 At[4][2], B0[2][2], B1[2][2];
    const char* cA = (const char*)g.A + (size_t)cur.pm * tstepA; const char* cB = (const char*)g.Bt + (size_t)cur.pn * tstepB;
    PG8_STAGE(PG8_SB(0, 0), cB, voffB); PG8_STAGE(PG8_SB(0, 1), cB + hstepB, voffB); PG8_STAGE(PG8_SA(0, 0), cA, voffA); PG8_STAGE(PG8_SA(0, 1), cA + hstepA, voffA);
    if (wr == 1) PG8_BAR;
    PG8_WAIT_V(2); PG8_BAR;
    PG8_STAGE(PG8_SB(1, 0), cB + kstep, voffB); PG8_STAGE(PG8_SA(1, 0), cA + kstep, voffA); PG8_STAGE(PG8_SB(1, 1), cB + hstepB + kstep, voffB);
    PG8_WAIT_V(6); PG8_BAR;
    for (;;) {
        const bool has_next = S.next(ui + 1, nxt);
        const char* nA = has_next ? (const char*)g.A + (size_t)nxt.pm * tstepA : cA; const char* nB = has_next ? (const char*)g.Bt + (size_t)nxt.pn * tstepB : cB;
        for (int t = 0; t < nt; t += 2) {
            const bool last = (t == nt - 2);
            const char* a1 = cA + (size_t)(t + 1) * kstep;
            const char* a2 = last ? nA : cA + (size_t)(t + 2) * kstep; const char* b2 = last ? nB : cB + (size_t)(t + 2) * kstep;
            const char* a3 = a2 + kstep; const char* b3 = b2 + kstep;
            PG8_LDB(B0, 0, 0); PG8_LDB(B1, 0, 1); PG8_SCHED; PG8_LDA(At, 0, 0); PG8_STAGE(PG8_SA(1, 1), a1 + hstepA, voffA);
            PG8_WAIT_V(8); PG8_WAIT_L(0); PG8_BAR; PG8_MMA(0, 0, At, B0); PG8_MMA(0, 1, At, B1); PG8_BAR; PG8_SCHED;
            PG8_LDA(At, 0, 1); PG8_STAGE(PG8_SB(0, 0), b2, voffB); PG8_STAGE(PG8_SB(0, 1), b2 + hstepB, voffB); PG8_STAGE(PG8_SA(0, 0), a2, voffA);
            PG8_WAIT_V(8); PG8_WAIT_L(0); PG8_BAR; PG8_MMA(1, 0, At, B0); PG8_MMA(1, 1, At, B1); PG8_BAR; PG8_SCHED;
            PG8_LDB(B0, 1, 0); PG8_LDB(B1, 1, 1); PG8_SCHED; PG8_LDA(At, 1, 0); PG8_STAGE(PG8_SA(0, 1), a2 + hstepA, voffA);
            PG8_WAIT_V(8); PG8_WAIT_L(0); PG8_BAR; PG8_MMA(0, 0, At, B0); PG8_MMA(0, 1, At, B1); PG8_BAR; PG8_SCHED;
            PG8_LDA(At, 1, 1); PG8_STAGE(PG8_SB(1, 0), b3, voffB); PG8_STAGE(PG8_SB(1, 1), b3 + hstepB, voffB); PG8_STAGE(PG8_SA(1, 0), a3, voffA);
            PG8_WAIT_V(8); PG8_WAIT_L(0); PG8_BAR; PG8_MMA(1, 0, At, B0); PG8_MMA(1, 1, At, B1); PG8_BAR; PG8_SCHED;
        }
        if (wr == 0) PG8_BAR;
        E(acc, cur, wr, wc, fr, fq);
        if (!has_next) break;
#pragma unroll
        for (int a = 0; a < 2; ++a)
#pragma unroll
            for (int b = 0; b < 2; ++b)
#pragma unroll
                for (int m = 0; m < 4; ++m)
#pragma unroll
                    for (int n = 0; n < 2; ++n) acc[a][b][m][n] = (f32x4){0.f, 0.f, 0.f, 0.f};
        cur = nxt; cA = nA; cB = nB; ++ui;
        if (wr == 1) PG8_BAR;
    }
    PG8_WAIT_V(0);
    PG8_BAR;
#undef PG8_SA
#undef PG8_SB
#undef PG8_STAGE
#undef PG8_LDA
#undef PG8_LDB
#undef PG8_MMA
#undef PG8_WAIT_V
#undef PG8_WAIT_L
#undef PG8_BAR
#undef PG8_SCHED
}
}
using pg8::Unit;
typedef f32x4 (&AccRef)[2][2][4][2];

__device__ __forceinline__ void rope8(f32x4& v0, f32x4& v1, const float* cosr, const float* sinr, int fq) {
    const int j0 = 8 * (fq & 1);
    const f32x4 c0 = *(const f32x4*)(cosr + j0), c1 = *(const f32x4*)(cosr + j0 + 4), s0 = *(const f32x4*)(sinr + j0), s1 = *(const f32x4*)(sinr + j0 + 4);
    const float sg = (fq < 2) ? -1.f : 1.f;
#pragma unroll
    for (int i = 0; i < 4; ++i) {
        const float p0 = __shfl_xor(v0[i], 32), p1 = __shfl_xor(v1[i], 32);
        v0[i] = v0[i] * c0[i] + sg * p0 * s0[i]; v1[i] = v1[i] * c1[i] + sg * p1 * s1[i];
    }
}

struct EpiProj {
    static constexpr bool PERM = true;
    bf16_t* O; const float* ssqx; float* ssqq; float* ssqkv; const float* cost; const float* sint;
    __device__ __forceinline__ void operator()(AccRef acc, const Unit& u, int wr, int wc, int fr, int fq) const {
        const int row0 = u.pm * 256 + wr * 64 + fr, col0 = u.pn * 256 + wc * 32 + 8 * fq;
#pragma unroll
        for (int ai = 0; ai < 2; ++ai)
#pragma unroll
            for (int m = 0; m < 4; ++m) {
                const int row = row0 + ai * 128 + m * 16;
                const float rs = rsqrtf(ssq_sum<4>(ssqx + (size_t)row * 4) * (1.0f / DM) + EPS);
                bf16_t* rowp = O + (size_t)row * NPROJ + col0;
#pragma unroll
                for (int bj = 0; bj < 2; ++bj) {
                    f32x4 v0 = acc[ai][bj][m][0] * rs, v1 = acc[ai][bj][m][1] * rs;
                    if (u.pn == 6 || (u.pn == 7 && bj == 0)) {
                        float s = (v0[0] * v0[0] + v0[1] * v0[1]) + (v0[2] * v0[2] + v0[3] * v0[3]) + (v1[0] * v1[0] + v1[1] * v1[1]) + (v1[2] * v1[2] + v1[3] * v1[3]);
                        s += __shfl_xor(s, 16); s += __shfl_xor(s, 32);
                        if (fq == 0) { if (u.pn == 6) ssqq[(size_t)row * 8 + bj * 4 + wc] = s; else ssqkv[(size_t)row * 4 + wc] = s; }
                    }
                    if (u.pn == 7 && bj == 1 && wc == 0) { const int pos = row & (SEQ - 1); rope8(v0, v1, cost + pos * 16, sint + pos * 16, fq); }
                    u32x4 w; w.x = cvtpk(v0[0], v0[1]); w.y = cvtpk(v0[2], v0[3]); w.z = cvtpk(v1[0], v1[1]); w.w = cvtpk(v1[2], v1[3]);
                    st16_wt(rowp + bj * 128, w);
                }
                asm volatile("" ::: "memory");
            }
    }
};
template <bool ROPE, int NS> struct EpiMla {
    static constexpr bool PERM = true;
    bf16_t* O; int ldc; const float* ssq; float inv_n; const float* cost; const float* sint;
    __device__ __forceinline__ void operator()(AccRef acc, const Unit& u, int wr, int wc, int fr, int fq) const {
        const int row0 = u.pm * 256 + wr * 64 + fr, col0 = u.pn * 256 + wc * 32 + 8 * fq;
#pragma unroll
        for (int ai = 0; ai < 2; ++ai)
#pragma unroll
            for (int m = 0; m < 4; ++m) {
                const int row = row0 + ai * 128 + m * 16;
                const float rs = rsqrtf(ssq_sum<NS>(ssq + (size_t)row * NS) * inv_n + EPS);
                bf16_t* rowp = O + (size_t)row * ldc + col0;
#pragma unroll
                for (int bj = 0; bj < 2; ++bj) {
                    f32x4 v0 = acc[ai][bj][m][0] * rs, v1 = acc[ai][bj][m][1] * rs;
                    if (ROPE) { const int g32 = u.pn * 8 + bj * 4 + wc; if (g32 % 3 == 2) { const int pos = row & (SEQ - 1); rope8(v0, v1, cost + pos * 16, sint + pos * 16, fq); } }
                    u32x4 w; w.x = cvtpk(v0[0], v0[1]); w.y = cvtpk(v0[2], v0[3]); w.z = cvtpk(v1[0], v1[1]); w.w = cvtpk(v1[2], v1[3]);
                    st16_wt(rowp + bj * 128, w);
                }
                asm volatile("" ::: "memory");
            }
    }
};
struct EpiResid {
    static constexpr bool PERM = true;
    bf16_t* XB; float* ssq; LAS float* red;
    __device__ __forceinline__ void operator()(AccRef acc, const Unit& u, int wr, int wc, int fr, int fq) const {
        const int row0 = u.pm * 256 + wr * 64 + fr, col0 = u.pn * 256 + wc * 32 + 8 * fq;
#pragma unroll
        for (int ai = 0; ai < 2; ++ai)
#pragma unroll
            for (int m = 0; m < 4; ++m) {
                const int row = row0 + ai * 128 + m * 16; bf16_t* rowp = XB + (size_t)row * DM + col0; float s = 0.f;
#pragma unroll
                for (int bj = 0; bj < 2; ++bj) {
                    const u32x4 xo = *(const u32x4*)(rowp + bj * 128);
                    float v[8];
#pragma unroll
                    for (int k = 0; k < 4; ++k) { v[2 * k] = __uint_as_float(xo[k] << 16) + acc[ai][bj][m][k >> 1][(2 * k) & 3]; v[2 * k + 1] = __uint_as_float(xo[k] & 0xffff0000u) + acc[ai][bj][m][k >> 1][(2 * k + 1) & 3]; }
#pragma unroll
                    for (int k = 0; k < 8; ++k) s += v[k] * v[k];
                    u32x4 w; w.x = cvtpk(v[0], v[1]); w.y = cvtpk(v[2], v[3]); w.z = cvtpk(v[4], v[5]); w.w = cvtpk(v[6], v[7]);
                    st16_wt(rowp + bj * 128, w);
                }
                s += __shfl_xor(s, 16); s += __shfl_xor(s, 32);
                if (fq == 0) red[(ai * 128 + wr * 64 + m * 16 + fr) * 4 + wc] = s;
                asm volatile("" ::: "memory");
            }
        asm volatile("s_waitcnt lgkmcnt(0)" ::: "memory"); __builtin_amdgcn_s_barrier(); asm volatile("" ::: "memory");
        const int t = (wr * 4 + wc) * 64 + fq * 16 + fr;
        if (t < 256) { const f32x4 p = *(const LAS f32x4*)(red + t * 4); ssq[(size_t)(u.pm * 256 + t) * 4 + u.pn] = (p[0] + p[1]) + (p[2] + p[3]); }
    }
};
template <int CTRL> __device__ __forceinline__ float dpp_rot(float v) { return __int_as_float(__builtin_amdgcn_update_dpp(__float_as_int(v), __float_as_int(v), CTRL, 0xf, 0xf, false)); }
struct EpiUp {
    static constexpr bool PERM = true;
    bf16_t* ACT; bf16_t* UB; const float* ssqx; const float* cw; const float* cb;
    __device__ __forceinline__ void operator()(AccRef acc, const Unit& u, int wr, int wc, int fr, int fq) const {
        const int row0 = u.pm * 256 + wr * 64 + fr, gcol = u.pn * 128 + wc * 32 + 8 * fq;
#pragma unroll
        for (int ai = 0; ai < 2; ++ai) {
#pragma unroll
            for (int m = 0; m < 4; ++m) {
                const float rs = rsqrtf(ssq_sum<4>(ssqx + (size_t)(row0 + ai * 128 + m * 16) * 4) * (1.0f / DM) + EPS);
#pragma unroll
                for (int bj = 0; bj < 2; ++bj) { acc[ai][bj][m][0] = acc[ai][bj][m][0] * rs; acc[ai][bj][m][1] = acc[ai][bj][m][1] * rs; }
            }
            asm volatile("" ::: "memory");
            const int chunk = u.pm * 4 + ai * 2 + wr;
#pragma unroll
            for (int e = 0; e < 2; ++e) {
                const int m = e ? 3 : 0;
                const bool mine = e ? (fr >= 14) : (fr <= 1);
                const int slot = e ? (fr - 12) : fr;
                if (mine) {
#pragma unroll
                    for (int bj = 0; bj < 2; ++bj) {
                        const f32x4 v0 = acc[ai][bj][m][0], v1 = acc[ai][bj][m][1];
                        u32x4 w; w.x = cvtpk(v0[0], v0[1]); w.y = cvtpk(v0[2], v0[3]); w.z = cvtpk(v1[0], v1[1]); w.w = cvtpk(v1[2], v1[3]);
                        *(u32x4*)(UB + ((size_t)chunk * 4 + slot) * NUP + bj * DFF + gcol) = w;
                    }
                }
            }
#define CONV_TAP(t, u, g, ctl) asm("v_fmac_f32_dpp %0, %1, %2 " ctl " row_mask:0xf bank_mask:0xf bound_ctrl:0" : "+v"(t) : "v"(u), "v"(g))
            __builtin_amdgcn_sched_barrier(0);
            asm volatile("s_nop 1" ::: "memory");
#pragma unroll
            for (int n = 0; n < 2; ++n) {
                unsigned wpk[4][2]; float rlo[4];
                const int cg4 = gcol + 4 * n, cv4 = cg4 + DFF;
                const f32x4 g0v = *(const f32x4*)(cw + cg4), g1v = *(const f32x4*)(cw + NUP + cg4), g2v = *(const f32x4*)(cw + 2 * NUP + cg4), gbv = *(const f32x4*)(cb + cg4);
                const f32x4 h0v = *(const f32x4*)(cw + cv4), h1v = *(const f32x4*)(cw + NUP + cv4), h2v = *(const f32x4*)(cw + 2 * NUP + cv4), hbv = *(const f32x4*)(cb + cv4);
#pragma unroll
                for (int i = 0; i < 4; ++i) {
                    const float g0 = g0v[i], g1 = g1v[i], g2 = g2v[i], gb = gbv[i], h0 = h0v[i], h1 = h1v[i], h2 = h2v[i], hb = hbv[i];
                    float gt[4], vl[4];
#pragma unroll
                    for (int m = 0; m < 4; ++m) { gt[m] = __builtin_fmaf(g1, acc[ai][0][m][n][i], gb); vl[m] = __builtin_fmaf(h1, acc[ai][1][m][n][i], hb); }
#pragma unroll
                    for (int m = 0; m < 4; ++m) {
                        CONV_TAP(gt[m], acc[ai][0][m][n][i], g0, "row_shr:1"); CONV_TAP(gt[m], acc[ai][0][m][n][i], g2, "row_shl:1");
                        CONV_TAP(vl[m], acc[ai][1][m][n][i], h0, "row_shr:1"); CONV_TAP(vl[m], acc[ai][1][m][n][i], h2, "row_shl:1");
                        if (m > 0) { CONV_TAP(gt[m], acc[ai][0][m - 1][n][i], g0, "row_shl:15"); CONV_TAP(vl[m], acc[ai][1][m - 1][n][i], h0, "row_shl:15"); }
                        if (m < 3) { CONV_TAP(gt[m], acc[ai][0][m + 1][n][i], g2, "row_shr:15"); CONV_TAP(vl[m], acc[ai][1][m + 1][n][i], h2, "row_shr:15"); }
                    }
#pragma unroll
                    for (int m = 0; m < 4; ++m) {
                        const float sg = gt[m] * fast_rcp(1.f + fast_exp2(-LOG2E * gt[m]));
                        const float rv = sg * vl[m];
                        if (i & 1) wpk[m][i >> 1] = cvtpk(rlo[m], rv); else rlo[m] = rv;
                    }
                    asm volatile("" ::: "memory");
                }
#pragma unroll
                for (int m = 0; m < 4; ++m) { u32x2 w; w.x = wpk[m][0]; w.y = wpk[m][1];
                    *(u32x2*)(ACT + (size_t)(row0 + ai * 128 + m * 16) * DFF + gcol + 4 * n) = w; }
                asm volatile("" ::: "memory");
            }
#undef CONV_TAP
        }
    }
};

constexpr float AT_THR = 8.0f;
constexpr int AT_BUF = 20480, AT_V = 12288, AT_TAB = 3 * AT_BUF, AT_TABC = 16384 + 64;
static_assert(AT_TAB + 4 * AT_TABC <= 131072, "attention LDS");
__device__ __forceinline__ float xmax(float a) { auto rr = __builtin_amdgcn_permlane32_swap(__float_as_uint(a), __float_as_uint(a), false, false); return fmaxf(__uint_as_float(rr[0]), __uint_as_float(rr[1])); }
__device__ __forceinline__ float xsum(float a) { auto rr = __builtin_amdgcn_permlane32_swap(__float_as_uint(a), __float_as_uint(a), false, false); return __uint_as_float(rr[0]) + __uint_as_float(rr[1]); }
__device__ __forceinline__ u32x4 pair_swap(u32x2 a, u32x2 b) {
    auto r0 = __builtin_amdgcn_permlane32_swap(a.x, b.x, false, false);
    auto r1 = __builtin_amdgcn_permlane32_swap(a.y, b.y, false, false);
    return (u32x4){r0[0], r1[0], r0[1], r1[1]};
}
typedef short v4i16_t __attribute__((ext_vector_type(4)));
__device__ __forceinline__ s16x4 vtr(const LAS unsigned char* p) { return __builtin_bit_cast(s16x4, __builtin_amdgcn_ds_read_tr16_b64_v4i16((LAS v4i16_t*)p)); }

template <int MODE, int NQ>
__device__ __forceinline__ void attn_unit(LAS unsigned char* lds, const Params& P, int layer, int b, int h, int qb) {
    constexpr int NMAP = (MODE == 1) ? 2 : 1, ND0 = (MODE == 0) ? 6 : (MODE == 1 ? 2 : 4), NC = NQ * NMAP, QROWS = 256 * NQ;
    int tid = threadIdx.x; asm volatile("" : "+v"(tid));
    const int lane = tid & 63, r32 = lane & 31, hi = lane >> 5, wave = __builtin_amdgcn_readfirstlane(tid >> 6);
    const bf16_t* proj = (const bf16_t*)(P.ws + WS_PROJ); const bf16_t* cq = (const bf16_t*)(P.ws + WS_CQ); const bf16_t* ckv = (const bf16_t*)(P.ws + WS_CKV);
    bf16_t* mix = (bf16_t*)(P.ws + WS_MIX);
    const size_t rowbase = (size_t)b * SEQ; const int q0 = qb * QROWS;
    const bf16_t *Qp, *Kp, *Vp; int qpitch, kpitch, vpitch, ocol; float c;
    if (MODE == 0) { Qp = cq + h * 96; qpitch = PCQ; Kp = ckv + h * 128; kpitch = PCKV; Vp = ckv + h * 128 + 64; vpitch = PCKV; ocol = 512 + h * 64; c = 0.10206207261596577f * LOG2E; }
    else if (MODE == 1) { Qp = proj + h * 64; qpitch = NPROJ; Kp = proj + 256 + h * 64; kpitch = NPROJ; Vp = proj + 512 + h * 64; vpitch = NPROJ; ocol = h * 64; c = 0.17677669529663687f * LOG2E; }
    else { Qp = proj + 768 + h * 64; qpitch = NPROJ; Kp = proj + 1024 + h * 64; kpitch = NPROJ; Vp = proj + 1280 + h * 64; vpitch = NPROJ; ocol = 256 + h * 64; c = 0.125f * LOG2E; }
    int kt0 = 0, kt1 = SEQ / 64;
    if (MODE == 2) { kt0 = (q0 - 1024) / 64; if (kt0 < 0) kt0 = 0; kt1 = (q0 + QROWS + 1024) / 64; if (kt1 > SEQ / 64) kt1 = SEQ / 64; }
    LAS unsigned char* tabb = lds + AT_TAB;
    if (MODE != 0) {
        const float slope = (MODE == 1) ? exp2f(-(float)(2 * h + 1)) : exp2f(-(float)(2 * h + 2));
        for (int jj = tid; jj < 4 * 4096; jj += 512) {
            const int sc_ = jj >> 12, j = (jj & 4095) + sc_;
            const int d = (j > 2047) ? (j - 2047) : (2047 - j);
            float v = -slope * LOG2E * (float)d;
            if (MODE == 2) {
                const int mult = (d <= 64 ? 1 : 0) + (((d & 3) == 0 && d <= 256) ? 1 : 0) + (((d & 15) == 0 && d <= 1024) ? 1 : 0);
                v = (mult == 0) ? -1e30f : (mult == 1 ? v : (mult == 2 ? v + 1.0f : v + 1.5849625007211562f));
            }
            *(LAS float*)(tabb + sc_ * AT_TABC + (jj & 4095) * 4) = v;
        }
    }
    const int qpos0 = q0 + wave * (32 * NQ) + r32;
    const int tb0_ = 4 * hi - qpos0 + 2047, ts_ = tb0_ & 3;
    const LAS unsigned char* tlane = tabb + ts_ * AT_TABC + (tb0_ - ts_) * 4;
    bf16x8 qf[NC][ND0];
#pragma unroll
    for (int jq = 0; jq < NQ; ++jq) {
        const bf16_t* qrow = Qp + (rowbase + qpos0 + 32 * jq) * qpitch + hi * 8;
#pragma unroll
        for (int mp = 0; mp < NMAP; ++mp)
#pragma unroll
            for (int d0 = 0; d0 < ND0; ++d0) qf[jq * NMAP + mp][d0] = *(const bf16x8*)(qrow + mp * 32 + d0 * 16);
    }
    u32x4 kreg, kreg2 = (u32x4){0u, 0u, 0u, 0u}, vreg;
#define AT_GLOADK(kt) do { const size_t r_ = rowbase + (size_t)(kt) * 64; \
        kreg = *(const u32x4*)(Kp + (r_ + lane) * kpitch + wave * 8); \
        if (MODE == 0 && wave < 4) kreg2 = *(const u32x4*)(proj + (r_ + lane) * NPROJ + 1920 + wave * 8); } while (0)
#define AT_GLOADV(kt) do { const size_t r_ = rowbase + (size_t)(kt) * 64; \
        vreg = *(const u32x4*)(Vp + (r_ + 16 * (wave & 3) + (lane >> 2)) * vpitch + (wave >> 2) * 32 + (lane & 3) * 8); } while (0)
#define AT_LSTOREK(buf) do { LAS unsigned char* d_ = lds + (buf) * AT_BUF; \
        *(LAS u32x4*)(d_ + wave * 1024 + lane * 16) = kreg; \
        if (MODE == 0 && wave < 4) *(LAS u32x4*)(d_ + (8 + wave) * 1024 + lane * 16) = kreg2; } while (0)
#define AT_LSTOREV(buf) do { LAS unsigned char* d_ = lds + (buf) * AT_BUF; \
        *(LAS u32x4*)(d_ + AT_V + wave * 1024 + lane * 16) = vreg; } while (0)
    float mrun[NC], lrun[NC]; f32x16 o[NC][2];
#pragma unroll
    for (int cc = 0; cc < NC; ++cc) { mrun[cc] = -1e20f; lrun[cc] = 0.f; o[cc][0] = f32x16{}; o[cc][1] = f32x16{}; }
    constexpr int NK = NMAP * ND0;
    const bf16x8 ones8 = (bf16x8){0x3F80, 0x3F80, 0x3F80, 0x3F80, 0x3F80, 0x3F80, 0x3F80, 0x3F80};
    const bf16x8 zero8 = (bf16x8){0, 0, 0, 0, 0, 0, 0, 0};
    bf16x8 kf[NK]; s16x4 vlo[4], vhi[4];
#define AT_KLOAD(bufbase, hf) do { _Pragma("unroll") for (int j_ = 0; j_ < NK; ++j_) kf[j_] = *(const LAS bf16x8*)((bufbase) + (2 * j_ + hi) * 1024 + (hf) * 512 + r32 * 16); } while (0)
#define AT_VLOAD(bufbase, hf) do { _Pragma("unroll") for (int dv_ = 0; dv_ < 2; ++dv_) _Pragma("unroll") for (int k2_ = 0; k2_ < 2; ++k2_) { \
        vlo[dv_ * 2 + k2_] = vtr((bufbase) + AT_V + vlane + dv_ * 4096 + (2 * (hf) + k2_) * 1024); vhi[dv_ * 2 + k2_] = vtr((bufbase) + AT_V + vlane + dv_ * 4096 + (2 * (hf) + k2_) * 1024 + 512); } } while (0)
    const int vlane = ((lane >> 4) & 1) * 32 + (lane & 3) * 8 + (4 * hi + ((lane & 15) >> 2)) * 64;
    const int NT = kt1 - kt0, ks = (MODE != 0) ? (q0 / 64 - kt0) : 0;
#define AT_TILE(i) (kt0 + (((ks + (i)) >= NT) ? (ks + (i) - NT) : (ks + (i))))
    AT_GLOADK(AT_TILE(0)); AT_GLOADV(AT_TILE(0)); AT_LSTOREK(0); AT_LSTOREV(0);
    if (1 < NT) { AT_GLOADK(AT_TILE(1)); AT_GLOADV(AT_TILE(1)); AT_LSTOREK(1); AT_LSTOREV(1); }
    __syncthreads();
    AT_KLOAD(lds, 0);
    if (wave >= 4) __builtin_amdgcn_s_setprio(1);
    int bcur = 0;
    for (int it = 0; it < NT; ++it) {
        const int kt = AT_TILE(it);
        const int bnx = (bcur == 2) ? 0 : bcur + 1, bn2 = (bnx == 2) ? 0 : bnx + 1;
        const LAS unsigned char* cur = lds + bcur * AT_BUF;
        const LAS unsigned char* nxt = lds + bnx * AT_BUF;
#pragma unroll
        for (int hf = 0; hf < 2; ++hf) {
            if (it + 2 < NT) { if (hf == 0) AT_GLOADK(AT_TILE(it + 2)); else AT_GLOADV(AT_TILE(it + 2)); }
            f32x16 sc[NC];
#pragma unroll
            for (int cc = 0; cc < NC; ++cc) {
                sc[cc] = f32x16{};
#pragma unroll
                for (int d0 = 0; d0 < ND0; ++d0) sc[cc] = __builtin_amdgcn_mfma_f32_32x32x16_bf16(kf[(cc % NMAP) * ND0 + d0], qf[cc][d0], sc[cc], 0, 0, 0);
            }
            __builtin_amdgcn_sched_barrier(0);
            AT_VLOAD(cur, hf);
            if (hf == 0) AT_KLOAD(cur, 1); else if (it + 1 < NT) AT_KLOAD(nxt, 0);
            __builtin_amdgcn_sched_barrier(0);
            bf16x8 pw[NC][2]; float rmrel[NC]; bool alive = false;
#pragma unroll
            for (int cc = 0; cc < NC; ++cc) {
                f32x16& s0 = sc[cc];
                float mn;
                if (MODE != 0) {
                    const LAS f32x4* tp4 = (const LAS f32x4*)(tlane + (kt * 64 + hf * 32) * 4);
                    float rm = -3e38f;
#pragma unroll
                    for (int g = 0; g < 4; ++g) { const f32x4 t4 = tp4[2 * g];
#pragma unroll
                        for (int i = 0; i < 4; ++i) { s0[4 * g + i] = s0[4 * g + i] * c + t4[i]; rm = fmaxf(rm, s0[4 * g + i]); } }
                    rm = xmax(rm);
                    mn = fmaxf(mrun[cc], rm);
                    rmrel[cc] = rm;
                } else {
                    float rm = -3e38f;
#pragma unroll
                    for (int r = 0; r < 16; ++r) rm = fmaxf(rm, s0[r]);
                    rm = xmax(rm);
                    mn = fmaxf(mrun[cc], rm * c);
                }
                if (__any(mn > mrun[cc] + AT_THR)) {
                    const float al = fast_exp2(mrun[cc] - mn); lrun[cc] *= al;
#pragma unroll
                    for (int r = 0; r < 16; ++r) { o[cc][0][r] *= al; o[cc][1][r] *= al; }
                    mrun[cc] = mn;
                }
                mn = mrun[cc];
                if (MODE != 0) rmrel[cc] -= mn;
                const bool dead = (MODE != 0) && __all(rmrel[cc] < -136.f);
                if (dead) { pw[cc][0] = zero8; pw[cc][1] = zero8; }
                else {
                    alive = true;
                    if (MODE != 0) {
#pragma unroll
                        for (int r = 0; r < 16; ++r) s0[r] = fast_exp2(s0[r] - mn);
                    } else {
                        const float nm = -mn;
#pragma unroll
                        for (int r = 0; r < 16; ++r) s0[r] = fast_exp2(__builtin_fmaf(s0[r], c, nm));
                    }
                    u32x4 w;
                    w.x = cvtpk(s0[0], s0[1]); w.y = cvtpk(s0[2], s0[3]); w.z = cvtpk(s0[4], s0[5]); w.w = cvtpk(s0[6], s0[7]); pw[cc][0] = __builtin_bit_cast(bf16x8, w);
                    w.x = cvtpk(s0[8], s0[9]); w.y = cvtpk(s0[10], s0[11]); w.z = cvtpk(s0[12], s0[13]); w.w = cvtpk(s0[14], s0[15]); pw[cc][1] = __builtin_bit_cast(bf16x8, w);
                    f32x16 t = __builtin_amdgcn_mfma_f32_32x32x16_bf16(ones8, pw[cc][0], f32x16{}, 0, 0, 0);
                    t = __builtin_amdgcn_mfma_f32_32x32x16_bf16(ones8, pw[cc][1], t, 0, 0, 0);
                    lrun[cc] += t[0];
                }
            }
            if (alive)
#pragma unroll
            for (int dv = 0; dv < 2; ++dv)
#pragma unroll
                for (int k2 = 0; k2 < 2; ++k2) {
                    const s16x4 lo = vlo[dv * 2 + k2], hh = vhi[dv * 2 + k2];
                    const bf16x8 vf = (bf16x8){lo[0], lo[1], lo[2], lo[3], hh[0], hh[1], hh[2], hh[3]};
#pragma unroll
                    for (int cc = 0; cc < NC; ++cc) o[cc][dv] = __builtin_amdgcn_mfma_f32_32x32x16_bf16(vf, pw[cc][k2], o[cc][dv], 0, 0, 0);
                }
            if (it + 2 < NT) { if (hf == 0) AT_LSTOREK(bn2); else AT_LSTOREV(bn2); }
        }
        __syncthreads();
        bcur = bnx;
    }
    __builtin_amdgcn_s_setprio(0);
#undef AT_KLOAD
#undef AT_VLOAD
#undef AT_TILE
#undef AT_GLOADK
#undef AT_GLOADV
#undef AT_LSTOREK
#undef AT_LSTOREV
    if (MODE != 1) {
#pragma unroll
        for (int jq = 0; jq < NQ; ++jq) {
            bf16_t* orow = mix + (rowbase + qpos0 + 32 * jq) * DM + ocol + 8 * hi;
            const float inv = 1.f / lrun[jq];
#pragma unroll
            for (int d = 0; d < 2; ++d)
#pragma unroll
                for (int gp = 0; gp < 2; ++gp) {
                    u32x2 a, b; const int g0 = 2 * gp, g1 = 2 * gp + 1;
                    a.x = cvtpk(o[jq][d][4 * g0] * inv, o[jq][d][4 * g0 + 1] * inv); a.y = cvtpk(o[jq][d][4 * g0 + 2] * inv, o[jq][d][4 * g0 + 3] * inv);
                    b.x = cvtpk(o[jq][d][4 * g1] * inv, o[jq][d][4 * g1 + 1] * inv); b.y = cvtpk(o[jq][d][4 * g1 + 2] * inv, o[jq][d][4 * g1 + 3] * inv);
                    *(u32x4*)(orow + 32 * d + 16 * gp) = pair_swap(a, b);
                }
        }
    } else {
        bf16_t* orow = mix + (rowbase + qpos0) * DM + ocol + 8 * hi;
        const float lam = __hip_atomic_load((const float*)(P.ws + WS_LAM) + layer, __ATOMIC_RELAXED, __HIP_MEMORY_SCOPE_AGENT);
        const float lam_init = 0.8f - 0.6f * expf(-0.3f * (float)layer);
        const float i1 = 1.f / lrun[0], i2 = lam / lrun[NC - 1];
        float ss = 0.f;
#pragma unroll
        for (int d = 0; d < 2; ++d)
#pragma unroll
            for (int r = 0; r < 16; ++r) { const float v = o[0][d][r] * i1 - o[NC - 1][d][r] * i2; o[0][d][r] = v; ss += v * v; }
        ss = xsum(ss);
        const float sc_ = rsqrtf(ss * (1.0f / 64.0f) + EPS) * (1.f - lam_init);
        const float* gn = P.a_subln + layer * 64 + 4 * hi;
#pragma unroll
        for (int d = 0; d < 2; ++d)
#pragma unroll
            for (int gp = 0; gp < 2; ++gp) {
                u32x2 ab[2];
#pragma unroll
                for (int e = 0; e < 2; ++e) { const int g = 2 * gp + e;
                    const f32x4 gv = *(const f32x4*)(gn + 32 * d + 8 * g);
                    ab[e].x = cvtpk(o[0][d][4 * g] * sc_ * gv[0], o[0][d][4 * g + 1] * sc_ * gv[1]); ab[e].y = cvtpk(o[0][d][4 * g + 2] * sc_ * gv[2], o[0][d][4 * g + 3] * sc_ * gv[3]); }
                *(u32x4*)(orow + 32 * d + 16 * gp) = pair_swap(ab[0], ab[1]);
            }
    }
}

constexpr int TT_PITCH = 272;
__device__ __forceinline__ void transpose_tile(const float* W, int K, int Nsrc, const float* g, bf16_t* WT, int n0_dst, int n0_src, int nvalid, int k0, LAS unsigned char* lds, int tid) {
    const int kgrp = tid >> 5, c4 = tid & 31;
    f32x4 v[8];
#pragma unroll
    for (int r = 0; r < 8; ++r) v[r] = (4 * c4 < nvalid) ? *(const f32x4*)(W + (size_t)(k0 + kgrp * 8 + r) * Nsrc + n0_src + 4 * c4) : (f32x4){0.f, 0.f, 0.f, 0.f};
    if (g) {
#pragma unroll
        for (int r = 0; r < 8; ++r) v[r] = v[r] * g[k0 + kgrp * 8 + r];
    }
#pragma unroll
    for (int j = 0; j < 4; ++j) {
        u32x4 w; w.x = cvtpk(v[0][j], v[1][j]); w.y = cvtpk(v[2][j], v[3][j]); w.z = cvtpk(v[4][j], v[5][j]); w.w = cvtpk(v[6][j], v[7][j]);
        *(LAS u32x4*)(lds + (4 * c4 + j) * TT_PITCH + kgrp * 16) = w;
    }
    __syncthreads();
    const int n = tid >> 2, q = tid & 3;
    bf16_t* dst = WT + (size_t)(n0_dst + n) * K + k0 + q * 32;
#pragma unroll
    for (int e = 0; e < 4; ++e) *(u32x4*)(dst + e * 8) = *(const LAS u32x4*)(lds + n * TT_PITCH + q * 64 + e * 16);
    __syncthreads();
}

__device__ __forceinline__ void zero_f32(float* p, int n) { for (int i = blockIdx.x * 512 + threadIdx.x; i < n; i += gridDim.x * 512) p[i] = 0.f; }

__device__ __forceinline__ void prologue(const Params& P, LAS unsigned char* lds) {
    const int tid = threadIdx.x, lane = tid & 63, wave = tid >> 6;
    const int gw = blockIdx.x * 8 + wave, NGW = gridDim.x * 8;
    constexpr int I_IN = 8 * 16, I_OUT = 8 * 8, I_UP = 8 * 44, I_DN = 22 * 8, I_UQ = 2 * 6, I_UKV = 8, I_L = I_IN + I_OUT + I_UP + I_DN + I_UQ + I_UKV;
    for (int it = blockIdx.x; it < I_L * DEPTH; it += gridDim.x) {
        const int l = it / I_L; int r = it % I_L;
        unsigned char* wl = P.ws + WS_W + (size_t)l * W_LAYER;
        if (r < I_IN) { const int kb = r / 16, nb = r % 16; transpose_tile(P.w_in + (size_t)l * DM * NIN, DM, NIN, P.g_attn + l * DM, (bf16_t*)(wl + W_IN), nb * 128, nb * 128, (nb < 15) ? 128 : 32, kb * 128, lds, tid); continue; } r -= I_IN;
        if (r < I_OUT) { const int kb = r / 8, nb = r % 8; transpose_tile(P.w_out + (size_t)l * DM * DM, DM, DM, nullptr, (bf16_t*)(wl + W_OUT), nb * 128, nb * 128, 128, kb * 128, lds, tid); continue; } r -= I_OUT;
        if (r < I_UP) { const int kb = r / 44, nb = r % 44; transpose_tile(P.w_up + (size_t)l * DM * NUP, DM, NUP, P.g_ffn + l * DM, (bf16_t*)(wl + W_UP), nb * 128, (nb & 1) * DFF + (nb >> 1) * 128, 128, kb * 128, lds, tid); continue; } r -= I_UP;
        if (r < I_DN) { const int kb = r / 8, nb = r % 8; transpose_tile(P.w_down + (size_t)l * DFF * DM, DFF, DM, nullptr, (bf16_t*)(wl + W_DOWN), nb * 128, nb * 128, 128, kb * 128, lds, tid); continue; } r -= I_DN;
        if (r < I_UQ) { const int kb = r / 6, nb = r % 6; transpose_tile(P.c_w_uq + (size_t)l * 256 * NCQ, 256, NCQ, P.c_g_q + l * 256, (bf16_t*)(wl + W_UQ), nb * 128, nb * 128, 128, kb * 128, lds, tid); continue; } r -= I_UQ;
        { const int nb = r; transpose_tile(P.c_w_ukv + (size_t)l * 128 * NCKV, 128, NCKV, P.c_g_kv + l * 128, (bf16_t*)(wl + W_UKV), nb * 128, nb * 128, 128, 0, lds, tid); }
    }
    float* ssqA = (float*)(P.ws + WS_SSQA); bf16_t* xb = (bf16_t*)(P.ws + WS_XB);
    for (int m = gw; m < T_TOK; m += NGW) {
        const f32x4* xr = (const f32x4*)(P.x + (size_t)m * DM) + lane; u32x2* brow = (u32x2*)(xb + (size_t)m * DM) + lane;
        float s = 0.f;
#pragma unroll
        for (int j = 0; j < 4; ++j) { const f32x4 v = xr[64 * j]; u32x2 w; w.x = cvtpk(v[0], v[1]); w.y = cvtpk(v[2], v[3]); brow[64 * j] = w; s += (v[0] * v[0] + v[1] * v[1]) + (v[2] * v[2] + v[3] * v[3]); }
        s = wave_sum(s);
        if (lane < 4) ssqA[(size_t)m * 4 + lane] = lane ? 0.f : s;
    }
    float* cost = (float*)(P.ws + WS_COS); float* sint = (float*)(P.ws + WS_SIN);
    for (int i = blockIdx.x * 512 + tid; i < SEQ * 16; i += gridDim.x * 512) {
        const int pos = i >> 4, j = i & 15; const float inv = exp2f(-(float)j * (13.287712379549449f / 16.0f)); const float ang = (float)pos * inv;
        cost[i] = cosf(ang); sint[i] = sinf(ang);
    }
    if (blockIdx.x == 0 && tid < DEPTH) {
        float d1 = 0.f, d2 = 0.f;
        for (int j = 0; j < 32; ++j) { d1 += P.a_lq1[tid * 32 + j] * P.a_lk1[tid * 32 + j]; d2 += P.a_lq2[tid * 32 + j] * P.a_lk2[tid * 32 + j]; }
        ((float*)(P.ws + WS_LAM))[tid] = expf(d1) - expf(d2) + (0.8f - 0.6f * expf(-0.3f * (float)tid));
    }
}

__device__ __forceinline__ void ffn_fixup(const Params& P, int layer) {
    const bf16_t* UB = (const bf16_t*)(P.ws + WS_UBND); bf16_t* ACT = (bf16_t*)(P.ws + WS_ACT);
    const float* cw = P.conv_w + (size_t)layer * 3 * NUP; const float* cb = P.conv_b + (size_t)layer * NUP;
    constexpr int CG = DFF / 8;
    for (int it = blockIdx.x * 512 + threadIdx.x; it < 512 * 2 * CG; it += gridDim.x * 512) {
        const int cgi = it % CG, e = (it / CG) & 1, chunk = it / (2 * CG), col = cgi * 8;
        const bf16_t *up, *mid, *dn; bool zu = false, zd = false;
        if (e == 0) { zu = (chunk % 32) == 0; up = UB + ((size_t)(zu ? chunk : chunk - 1) * 4 + 3) * NUP; mid = UB + ((size_t)chunk * 4 + 0) * NUP; dn = UB + ((size_t)chunk * 4 + 1) * NUP; }
        else { zd = (chunk % 32) == 31; up = UB + ((size_t)chunk * 4 + 2) * NUP; mid = UB + ((size_t)chunk * 4 + 3) * NUP; dn = UB + ((size_t)(zd ? chunk : chunk + 1) * 4 + 0) * NUP; }
        const float fu = zu ? 0.f : 1.f, fd = zd ? 0.f : 1.f;
        float res[8];
        bf16_t ug[8], mg[8], dg[8], uv[8], mv[8], dv[8];
        *(u32x4*)ug = *(const u32x4*)(up + col); *(u32x4*)mg = *(const u32x4*)(mid + col); *(u32x4*)dg = *(const u32x4*)(dn + col);
        *(u32x4*)uv = *(const u32x4*)(up + DFF + col); *(u32x4*)mv = *(const u32x4*)(mid + DFF + col); *(u32x4*)dv = *(const u32x4*)(dn + DFF + col);
#pragma unroll
        for (int k = 0; k < 8; ++k) {
            const int cg_ = col + k, cv_ = DFF + col + k;
            const float gt = cw[cg_] * bf2f(ug[k]) * fu + cw[NUP + cg_] * bf2f(mg[k]) + cw[2 * NUP + cg_] * bf2f(dg[k]) * fd + cb[cg_];
            const float vl = cw[cv_] * bf2f(uv[k]) * fu + cw[NUP + cv_] * bf2f(mv[k]) + cw[2 * NUP + cv_] * bf2f(dv[k]) * fd + cb[cv_];
            res[k] = gt * fast_rcp(1.f + fast_exp2(-LOG2E * gt)) * vl;
        }
        u32x4 w; w.x = cvtpk(res[0], res[1]); w.y = cvtpk(res[2], res[3]); w.z = cvtpk(res[4], res[5]); w.w = cvtpk(res[6], res[7]);
        *(u32x4*)(ACT + (size_t)(chunk * 64 + (e ? 63 : 0)) * DFF + col) = w;
    }
}


#define XB_TMO      128
#define XB_XCNT(j)  (256  + 64 * (j))
#define XB_XSUB(j)  (1280 + 64 * (j))
#define XB_XGEN(j)  (2304 + 64 * (j))
#define XB_TOP      3328
#define XB_TOPGEN   3392
#define XCD_BAR_WORDS 3456
#define XB_SPIN_CAP (1u << 22)
__device__ __forceinline__ unsigned xb_ld(unsigned* p)              { return __hip_atomic_load(p, __ATOMIC_RELAXED, __HIP_MEMORY_SCOPE_AGENT); }
__device__ __forceinline__ unsigned xb_add(unsigned* p, unsigned v) { return __hip_atomic_fetch_add(p, v, __ATOMIC_RELAXED, __HIP_MEMORY_SCOPE_AGENT); }
__device__ __forceinline__ unsigned xb_xcc_id() { return (unsigned)__builtin_amdgcn_s_getreg((3 << 11) | 20) & 0xFu; }
#define XB_SPIN(cond, bar) do { unsigned _sp = 0; while (cond) { __builtin_amdgcn_s_sleep(1); \
    if ((++_sp & 255u) == 0u) { if (xb_ld(&(bar)[XB_TMO])) break; if (_sp > XB_SPIN_CAP) { atomicAdd(&(bar)[XB_TMO], 1u); break; } } } } while (0)
struct XcdBarrier { unsigned* bar; unsigned x; volatile LAS unsigned* st; };
__device__ __forceinline__ XcdBarrier xcd_barrier_post(unsigned* bar, volatile LAS unsigned* st) {
    XcdBarrier b; b.bar = bar; b.x = xb_xcc_id(); b.st = st;
    if (threadIdx.x == 0) (void)xb_add(&bar[XB_XCNT(b.x)], 1u);
    return b;
}
__device__ __forceinline__ void xcd_barrier_complete(unsigned* bar, unsigned x, unsigned& nloc, unsigned& nx) {
    const unsigned G = gridDim.x * gridDim.y * gridDim.z;
    unsigned sum, cnt, mine, sp = 0u;
    for (;;) {
        sum = 0u; cnt = 0u; mine = 0u;
#pragma unroll
        for (unsigned j = 0; j < 16; ++j) { const unsigned c = xb_ld(&bar[XB_XCNT(j)]); sum += c; cnt += (c > 0u) ? 1u : 0u; mine = (j == x) ? c : mine; }
        if (sum == G) break;
        __builtin_amdgcn_s_sleep(1);
        if ((++sp & 255u) == 0u) { if (xb_ld(&bar[XB_TMO])) break; if (sp > XB_SPIN_CAP) { atomicAdd(&bar[XB_TMO], 1u); break; } }
    }
    nloc = mine > 0u ? mine : 1u; nx = cnt > 0u ? cnt : 1u;
}
__device__ __forceinline__ void xcd_barrier(const XcdBarrier& b) {
    asm volatile("s_waitcnt vmcnt(0)" ::: "memory");
    __syncthreads();
    if (threadIdx.x == 0) {
        unsigned* bar = b.bar;
        __builtin_amdgcn_s_waitcnt(0);
        unsigned nloc = b.st[0], nx = b.st[1];
        if (nloc == 0u) { xcd_barrier_complete(bar, b.x, nloc, nx); b.st[0] = nloc; b.st[1] = nx; }
        const unsigned old = xb_add(&bar[XB_XSUB(b.x)], 1u);
        const unsigned gen = old / nloc;
        if (old + 1u == (gen + 1u) * nloc) {
            __builtin_amdgcn_fence(__ATOMIC_RELEASE, "agent");
            asm volatile("s_waitcnt vmcnt(0)" ::: "memory");
            const unsigned og = xb_add(&bar[XB_TOP], 1u);
            const unsigned tg = og / nx;
            if (og + 1u == (tg + 1u) * nx) xb_add(&bar[XB_TOPGEN], 1u);
            else XB_SPIN(xb_ld(&bar[XB_TOPGEN]) == tg, bar);
            __builtin_amdgcn_fence(__ATOMIC_ACQUIRE, "agent");
            xb_add(&bar[XB_XGEN(b.x)], 1u);
            asm volatile("s_waitcnt vmcnt(0)" ::: "memory");
        } else {
            XB_SPIN(xb_ld(&bar[XB_XGEN(b.x)]) == gen, bar);
            __builtin_amdgcn_fence(__ATOMIC_ACQUIRE, "agent");
            asm volatile("s_waitcnt vmcnt(0)" ::: "memory");
        }
    }
    __syncthreads();
}

__global__ void __launch_bounds__(512, 2) fwd_megakernel(Params P) {
    extern __shared__ __attribute__((aligned(16))) unsigned char lds_raw[];
    LAS unsigned char* lds = (LAS unsigned char*)lds_raw;
    cg::grid_group grid = cg::this_grid();
#define GRID_SYNC() do { asm volatile("s_waitcnt vmcnt(0) lgkmcnt(0)" ::: "memory"); __syncthreads(); grid.sync(); \
        __builtin_amdgcn_fence(__ATOMIC_ACQUIRE, "agent"); asm volatile("s_waitcnt vmcnt(0)" ::: "memory"); GRID_SYNC2(); } while (0)
#if MK_DUP_SYNC > 1
#define GRID_SYNC2() do { grid.sync(); __builtin_amdgcn_fence(__ATOMIC_ACQUIRE, "agent"); asm volatile("s_waitcnt vmcnt(0)" ::: "memory"); } while (0)
#else
#define GRID_SYNC2() do {} while (0)
#endif
    unsigned char* ws = P.ws;
    if (ws == nullptr) grid.sync();
    float* ssqA = (float*)(ws + WS_SSQA); float* ssqB = (float*)(ws + WS_SSQB); float* ssqQ = (float*)(ws + WS_SSQQ); float* ssqKV = (float*)(ws + WS_SSQKV);
    const float* cost = (const float*)(ws + WS_COS); const float* sint = (const float*)(ws + WS_SIN);
    bf16_t* xb = (bf16_t*)(ws + WS_XB); bf16_t* proj = (bf16_t*)(ws + WS_PROJ); bf16_t* cq = (bf16_t*)(ws + WS_CQ); bf16_t* ckv = (bf16_t*)(ws + WS_CKV);
    bf16_t* mix = (bf16_t*)(ws + WS_MIX); bf16_t* act = (bf16_t*)(ws + WS_ACT); bf16_t* ubnd = (bf16_t*)(ws + WS_UBND);

    volatile LAS unsigned* bst = (volatile LAS unsigned*)(lds + 131072 + 64);
    if (threadIdx.x < 2) bst[threadIdx.x] = 0u;
    __syncthreads();
    const XcdBarrier xbar = xcd_barrier_post((unsigned*)(ws + WS_BAR), bst);
    prologue(P, lds);
#if MK_DUP_BAR > 1
#define XBAR() do { xcd_barrier(xbar); xcd_barrier(xbar); } while (0)
#else
#define XBAR() xcd_barrier(xbar)
#endif
    for (int l = 0; l <= DEPTH; ++l) {
        XBAR();
        if (l == DEPTH) break;
        const unsigned char* wl = ws + WS_W + (size_t)l * W_LAYER;
#if !(MK_SKIP & 1)
        { pg8::Gemm g{xb, (const bf16_t*)(wl + W_IN), T_TOK, NPROJW, DM, DM}; EpiProj E{proj, ssqA, ssqQ, ssqKV, cost, sint}; pg8::gemm_phase(lds, g, E); }
#if MK_DUP_IN > 1
        { pg8::Gemm g{xb, (const bf16_t*)(wl + W_IN), T_TOK, NPROJW, DM, DM}; EpiProj E{proj, ssqA, ssqQ, ssqKV, cost, sint}; pg8::gemm_phase(lds, g, E); }
#endif
#endif
        XBAR();
#if !(MK_SKIP & 2)
        { pg8::Gemm g{proj + 1536, (const bf16_t*)(wl + W_UQ), T_TOK, NCQ, 256, NPROJ}; EpiMla<true, 8> E{cq, PCQ, ssqQ, 1.0f / 256.0f, cost, sint}; pg8::gemm_phase(lds, g, E); }
        { pg8::Gemm g{proj + 1792, (const bf16_t*)(wl + W_UKV), T_TOK, NCKV, 128, NPROJ}; EpiMla<false, 4> E{ckv, PCKV, ssqKV, 1.0f / 128.0f, cost, sint}; pg8::gemm_phase(lds, g, E); }
#if MK_DUP_MLA > 1
        { pg8::Gemm g{proj + 1536, (const bf16_t*)(wl + W_UQ), T_TOK, NCQ, 256, NPROJ}; EpiMla<true, 8> E{cq, PCQ, ssqQ, 1.0f / 256.0f, cost, sint}; pg8::gemm_phase(lds, g, E); }
        { pg8::Gemm g{proj + 1792, (const bf16_t*)(wl + W_UKV), T_TOK, NCKV, 128, NPROJ}; EpiMla<false, 4> E{ckv, PCKV, ssqKV, 1.0f / 128.0f, cost, sint}; pg8::gemm_phase(lds, g, E); }
#endif
#endif
#if !(MK_SKIP & 4)
        for (int rep_ = 0; rep_ < MK_DUP_AB; ++rep_)
        {
            const bool xm = (gridDim.x == 256); const int x_ = blockIdx.x & 7, j_ = blockIdx.x >> 3;
            for (int u = blockIdx.x, i_ = 0; u < 512; u += gridDim.x, ++i_) {
                int bh = u >> 3, qb = u & 7;
                if (xm) { const int hh_ = i_ ? 3 - (j_ >> 3) : (j_ >> 3); bh = (x_ * 2 + i_) * 4 + hh_; qb = j_ & 7; }
                attn_unit<1, 1>(lds, P, l, bh >> 2, bh & 3, qb);
            }
            for (int u = blockIdx.x, i_ = 0; u < 512; u += gridDim.x, ++i_) {
                int bh = (u >> 3) & 63, qb = u & 7; if (u >= 256) qb = (qb + 4) & 7;
                if (xm) { const int hb_ = (j_ >> 3) ^ 1, hh_ = i_ ? 3 - hb_ : hb_; bh = (x_ * 2 + i_) * 4 + hh_; qb = ((j_ & 7) + 4 * i_) & 7; }
                attn_unit<2, 1>(lds, P, l, bh >> 2, bh & 3, qb);
            }
        }
#endif
        XBAR();
#if !(MK_SKIP & 8)
        for (int rep_ = 0; rep_ < MK_DUP_C; ++rep_)
        {
            const bool xm = (gridDim.x == 256); const int x_ = blockIdx.x & 7, j_ = blockIdx.x >> 3;
            for (int u = blockIdx.x, i_ = 0; u < 512; u += gridDim.x, ++i_) {
                int bh = u >> 2, qb = u & 3; if (xm) { bh = x_ * 16 + i_ * 8 + (j_ >> 2); qb = j_ & 3; }
                attn_unit<0, 2>(lds, P, l, bh >> 3, bh & 7, qb);
            }
        }
#endif
        XBAR();
#if !(MK_SKIP & 16)
        { pg8::Gemm g{mix, (const bf16_t*)(wl + W_OUT), T_TOK, DM, DM, DM}; EpiResid E{xb, ssqB, (LAS float*)(lds + 131072 + 1024)}; pg8::gemm_phase(lds, g, E); }
#endif
        XBAR();
#if !(MK_SKIP & 32)
        { pg8::Gemm g{xb, (const bf16_t*)(wl + W_UP), T_TOK, NUP, DM, DM}; EpiUp E{act, ubnd, ssqB, P.conv_w + (size_t)l * 3 * NUP, P.conv_b + (size_t)l * NUP}; pg8::gemm_phase(lds, g, E); }
#if MK_DUP_UP > 1
        { pg8::Gemm g{xb, (const bf16_t*)(wl + W_UP), T_TOK, NUP, DM, DM}; EpiUp E{act, ubnd, ssqB, P.conv_w + (size_t)l * 3 * NUP, P.conv_b + (size_t)l * NUP}; pg8::gemm_phase(lds, g, E); }
#endif
#endif
        XBAR();
        ffn_fixup(P, l);
        XBAR();
#if !(MK_SKIP & 64)
        { pg8::Gemm g{act, (const bf16_t*)(wl + W_DOWN), T_TOK, DM, DFF, DFF}; EpiResid E{xb, ssqA, (LAS float*)(lds + 131072 + 1024)}; pg8::gemm_phase(lds, g, E); }
#endif
    }
    for (int i = blockIdx.x * 512 + threadIdx.x; i < T_TOK * (DM / 4); i += gridDim.x * 512) {
        const int row = i >> 8, c4 = i & 255;
        const float rs = rsqrtf(ssq_sum<4>(ssqA + (size_t)row * 4) * (1.0f / DM) + EPS);
        const u32x2 xv = ((const u32x2*)xb)[i]; const f32x4 gv = ((const f32x4*)P.g_final)[c4];
        f32x4 v; v[0] = __uint_as_float(xv.x << 16); v[1] = __uint_as_float(xv.x & 0xffff0000u); v[2] = __uint_as_float(xv.y << 16); v[3] = __uint_as_float(xv.y & 0xffff0000u);
        ((f32x4*)P.out)[i] = v * rs * gv;
    }
}

extern "C" void kernel_launch(void* const* d_in, const int* in_sizes, int n_in, void* d_out, int out_size, void* d_ws, size_t ws_size, hipStream_t stream) {
    static int grid_blocks = 0;
    if (!grid_blocks) {
        if (n_in != 19 || ws_size < WS_END) { fprintf(stderr, "kernel_launch: unexpected n_in %d / ws %zu\n", n_in, ws_size); grid_blocks = -1; return; }
        int dev = 0, cus = 0, per_cu = 0;
        hipGetDevice(&dev);
        hipDeviceGetAttribute(&cus, hipDeviceAttributeMultiprocessorCount, dev);
        hipFuncSetAttribute((const void*)fwd_megakernel, hipFuncAttributeMaxDynamicSharedMemorySize, LDS_BYTES);
        hipOccupancyMaxActiveBlocksPerMultiprocessor(&per_cu, (const void*)fwd_megakernel, 512, LDS_BYTES);
        if (per_cu < 1) { fprintf(stderr, "kernel_launch: occupancy query says %d blocks/CU\n", per_cu); per_cu = 1; }
        grid_blocks = cus * per_cu;
    }
    if (grid_blocks < 0) return;
    Params p{};
    const float** f = (const float**)&p;
    for (int i = 0; i < 19; ++i) f[i] = (const float*)d_in[i];
    p.out = (float*)d_out; p.ws = (unsigned char*)d_ws;
    (void)hipMemsetAsync((char*)d_ws + WS_BAR, 0, WS_BAR_BYTES, stream);
    void* args[] = {&p};
    hipError_t e = hipLaunchCooperativeKernel((const void*)fwd_megakernel, dim3(grid_blocks), dim3(512), args, LDS_BYTES, stream);
    if (e != hipSuccess) fprintf(stderr, "cooperative launch failed: %s (grid %d)\n", hipGetErrorString(e), grid_blocks);
}
```

```cpp
#include <hip/hip_runtime.h>
#include <hip/hip_cooperative_groups.h>
#include <cstdint>
#include <cstdio>
namespace cg = cooperative_groups;

#define LAS __attribute__((address_space(3)))
typedef unsigned short bf16_t;
typedef short bf16x8 __attribute__((ext_vector_type(8)));
typedef short s16x4 __attribute__((ext_vector_type(4)));
typedef float f32x4 __attribute__((ext_vector_type(4)));
typedef float f32x2 __attribute__((ext_vector_type(2)));
typedef float f32x16 __attribute__((ext_vector_type(16)));
typedef unsigned u32x4 __attribute__((ext_vector_type(4)));
typedef unsigned u32x2 __attribute__((ext_vector_type(2)));
typedef __bf16 bf16x2_t __attribute__((ext_vector_type(2)));

constexpr int T_TOK = 32768, SEQ = 2048, DM = 1024, DEPTH = 4;
constexpr int NPROJW = 2048, NPROJ = 2112, NIN = 1952, DFF = 2816, NUP = 5632;
constexpr int NCQ = 768, NCKV = 1024, PCQ = 832, PCKV = 1088;
constexpr float EPS = 1e-6f;
constexpr float LOG2E = 1.4426950408889634f;

constexpr size_t MiB = 1u << 20;
constexpr size_t WS_BAR = 0, WS_BAR_BYTES = 16384;
constexpr size_t WS_LAM = 512 * 1024;
constexpr size_t WS_COS = 576 * 1024, WS_SIN = 704 * 1024;
constexpr size_t WS_W = 1 * MiB;
constexpr size_t W_IN = 0, W_OUT = W_IN + (size_t)NPROJW * DM * 2, W_UP = W_OUT + (size_t)DM * DM * 2, W_DOWN = W_UP + (size_t)NUP * DM * 2,
                 W_UQ = W_DOWN + (size_t)DM * DFF * 2, W_UKV = W_UQ + (size_t)NCQ * 256 * 2, W_LAYER = W_UKV + (size_t)NCKV * 128 * 2;
static_assert(W_LAYER * DEPTH <= 93 * MiB, "weights");
constexpr size_t WS_XB = 94 * MiB, WS_PROJ = 158 * MiB, WS_CQ = 290 * MiB, WS_CKV = 342 * MiB, WS_MIX = 410 * MiB;
constexpr size_t WS_SSQA = 474 * MiB, WS_SSQB = 476 * MiB, WS_SSQQ = 478 * MiB, WS_SSQKV = 479 * MiB, WS_END = 480 * MiB;
static_assert(WS_PROJ + (size_t)T_TOK * NPROJ * 2 <= WS_CQ && WS_CQ + (size_t)T_TOK * PCQ * 2 <= WS_CKV && WS_CKV + (size_t)T_TOK * PCKV * 2 <= WS_MIX, "attention tensors");
constexpr size_t WS_ACT = 158 * MiB, WS_UBND = 342 * MiB;
static_assert(WS_ACT + (size_t)T_TOK * DFF * 2 <= WS_UBND && WS_UBND + (size_t)512 * 4 * NUP * 2 <= WS_MIX, "overlay");

constexpr int LDS_BYTES = 147456;
#ifndef MK_SKIP
#define MK_SKIP 0
#endif
#ifndef MK_DUP_PRO
#define MK_DUP_PRO 1
#endif
#ifndef MK_DUP_SYNC
#define MK_DUP_SYNC 1
#endif
#ifndef MK_DUP_MLA
#define MK_DUP_MLA 1
#endif
#ifndef MK_DUP_BAR
#define MK_DUP_BAR 1
#endif
#ifndef MK_DUP_UP
#define MK_DUP_UP 1
#endif
#ifndef MK_DUP_IN
#define MK_DUP_IN 1
#endif
#ifndef MK_DUP_AB
#define MK_DUP_AB 1
#endif
#ifndef MK_DUP_C
#define MK_DUP_C 1
#endif

struct Params {
    const float* x; const float* w_in; const float* g_attn; const float* a_lq1; const float* a_lk1; const float* a_lq2; const float* a_lk2;
    const float* a_subln; const float* c_g_q; const float* c_w_uq; const float* c_g_kv; const float* c_w_ukv; const float* w_out; const float* g_ffn;
    const float* w_up; const float* conv_w; const float* conv_b; const float* w_down; const float* g_final;
    float* out; unsigned char* ws;
};

__device__ __forceinline__ unsigned cvtpk(float lo, float hi) { f32x2 v = {lo, hi}; bf16x2_t b = __builtin_convertvector(v, bf16x2_t); return __builtin_bit_cast(unsigned, b); }
__device__ __forceinline__ void st16_wt(void* p, u32x4 v) { *(u32x4*)p = v; }
__device__ __forceinline__ void st8_wt(void* p, u32x2 v) { *(u32x2*)p = v; }
__device__ __forceinline__ float bf2f(unsigned short b) { return __uint_as_float((unsigned)b << 16); }
__device__ __forceinline__ float wave_sum(float v) {
#pragma unroll
    for (int o = 1; o < 64; o <<= 1) v += __shfl_xor(v, o);
    return v;
}
__device__ __forceinline__ float ld_agent(const float* p) { return __hip_atomic_load(p, __ATOMIC_RELAXED, __HIP_MEMORY_SCOPE_AGENT); }
template <int NS> __device__ __forceinline__ float ssq_sum(const float* p) {
    float t = 0.f;
#pragma unroll
    for (int i = 0; i < NS / 4; ++i) { const f32x4 v = *(const f32x4*)(p + 4 * i); t += (v[0] + v[1]) + (v[2] + v[3]); }
    return t;
}
__device__ __forceinline__ float fast_exp2(float x) { return __builtin_amdgcn_exp2f(x); }
__device__ __forceinline__ float fast_rcp(float x) { return __builtin_amdgcn_rcpf(x); }

namespace pg8 {
constexpr int BM = 256, BK = 64, HALF = 128, HTB = HALF * BK * 2, STAGE_BYTES = 8 * HTB, NXCD = 8, WGM = 8;
__host__ __device__ __forceinline__ int lds_byte(int r, int c) { const int st = (r >> 4) * 2 + (c >> 5), rr = r & 15, cc = c & 31, ob = rr * 64 + cc * 2; return st * 1024 + (ob ^ (((ob >> 9) & 1) << 5)); }
__host__ __device__ __forceinline__ void stage_rc(int b, int& R, int& C) { const int st = b / 1024, sb = b % 1024, swz = sb ^ (((sb >> 9) & 1) << 5); R = (st >> 1) * 16 + swz / 64; C = (st & 1) * 32 + (swz % 64) / 2; }
__host__ __device__ __forceinline__ int perm32(int rho) { const int n = rho >> 4, i = rho & 15; return 8 * (i >> 2) + 4 * n + (i & 3); }
struct Unit { int pm, pn; };
struct Gemm { const bf16_t* A; const bf16_t* Bt; int M, N, K, lda; };
struct StaticOrder {
    int nM, nN, nwg, G, c;
    __device__ void init(int M, int N, int G_, int c_) { nM = M / BM; nN = N / BM; nwg = nM * nN; G = G_; c = c_; }
    __device__ bool next(int i, Unit& u) const {
        const long L = (long)i * G + c; if (L >= nwg) return false;
        int wgid = (int)L; { const int q = nwg / NXCD, r = nwg % NXCD, xcd = wgid % NXCD, off = wgid / NXCD; wgid = (xcd < r ? xcd * (q + 1) : r * (q + 1) + (xcd - r) * q) + off; }
        const int nig = WGM * nN, gid = wgid / nig, fm = gid * WGM, gsz = (nM - fm) < WGM ? (nM - fm) : WGM;
        u.pm = fm + ((wgid % nig) % gsz); u.pn = (wgid % nig) / gsz; return true;
    }
};

template <class Epi>
__device__ __forceinline__ void gemm_phase(LAS unsigned char* lds, const Gemm g, const Epi& E) {
    int tid = threadIdx.x; asm volatile("" : "+v"(tid));
    const int wid = __builtin_amdgcn_readfirstlane(tid >> 6), lane = tid & 63, wr = wid >> 2, wc = wid & 3, fr = lane & 15, fq = lane >> 4;
    int K = g.K, lda = g.lda; asm volatile("" : "+s"(K), "+s"(lda));
    const int nt = K / BK;
    StaticOrder S; S.init(g.M, g.N, (int)gridDim.x, (int)blockIdx.x);
    unsigned voffA[2], voffB[2];
#pragma unroll
    for (int i = 0; i < 2; ++i) { int R, C; stage_rc(tid * 16 + i * 8192, R, C); const int Rb = Epi::PERM ? ((R & ~31) + perm32(R & 31)) : R;
        voffA[i] = (unsigned)(R * lda + C) * 2u; voffB[i] = (unsigned)(Rb * K + C) * 2u; }
    const size_t kstep = (size_t)(BK * 2);
    const size_t hstepA = (size_t)HALF * lda * 2, hstepB = (size_t)HALF * K * 2;
    const size_t tstepA = 2 * hstepA, tstepB = 2 * hstepB;
    const unsigned ldsw = (unsigned)wid * 1024u;
    const int aoff = lds_byte(wr * 64 + fr, fq * 8), boff = lds_byte(wc * 32 + fr, fq * 8);
#define PG8_SA(b, h) (((b) * 2 + (h)) * HTB)
#define PG8_SB(b, h) ((4 + (b) * 2 + (h)) * HTB)
#define PG8_STAGE(bufoff, gbase, voff) do { _Pragma("unroll") for (int _i = 0; _i < 2; ++_i) \
        __builtin_amdgcn_global_load_lds((const unsigned*)((const char*)(gbase) + (voff)[_i]), (LAS unsigned*)(lds + (bufoff) + ldsw + _i * 8192), 16, 0, 0); } while (0)
#define PG8_LDA(dst, b, h) do { _Pragma("unroll") for (int m = 0; m < 4; ++m) _Pragma("unroll") for (int k = 0; k < 2; ++k) dst[m][k] = *(const LAS bf16x8*)(lds + PG8_SA(b, h) + aoff + m * 2048 + k * 1024); } while (0)
#define PG8_LDB(dst, b, h) do { _Pragma("unroll") for (int n = 0; n < 2; ++n) _Pragma("unroll") for (int k = 0; k < 2; ++k) dst[n][k] = *(const LAS bf16x8*)(lds + PG8_SB(b, h) + boff + n * 2048 + k * 1024); } while (0)
#define PG8_MMA(ai, bj, At, Bt) do { __builtin_amdgcn_s_setprio(1); _Pragma("unroll") for (int m = 0; m < 4; ++m) _Pragma("unroll") for (int n = 0; n < 2; ++n) _Pragma("unroll") for (int k = 0; k < 2; ++k) \
        acc[ai][bj][m][n] = __builtin_amdgcn_mfma_f32_16x16x32_bf16(Bt[n][k], At[m][k], acc[ai][bj][m][n], 0, 0, 0); __builtin_amdgcn_s_setprio(0); } while (0)
#define PG8_WAIT_V(n) asm volatile("s_waitcnt vmcnt(" #n ")" ::: "memory")
#define PG8_WAIT_L(n) asm volatile("s_waitcnt lgkmcnt(" #n ")" ::: "memory")
#define PG8_BAR __builtin_amdgcn_s_barrier()
#define PG8_SCHED __builtin_amdgcn_sched_barrier(0)
    Unit cur, nxt; int ui = 0;
    if (!S.next(0, cur)) return;
    f32x4 acc[2][2][4][2];
#pragma unroll
    for (int a = 0; a < 2; ++a)
#pragma unroll
        for (int b = 0; b < 2; ++b)
#pragma unroll
            for (int m = 0; m < 4; ++m)
#pragma unroll
                for (int n = 0; n < 2; ++n) acc[a][b][m][n] = (f32x4){0.f, 0.f, 0.f, 0.f};
    bf16x8 At[4][2], B0[2][2], B1[2][2];
    const char* cA = (const char*)g.A + (size_t)cur.pm * tstepA; const char* cB = (const char*)g.Bt + (size_t)cur.pn * tstepB;
    PG8_STAGE(PG8_SB(0, 0), cB, voffB); PG8_STAGE(PG8_SB(0, 1), cB + hstepB, voffB); PG8_STAGE(PG8_SA(0, 0), cA, voffA); PG8_STAGE(PG8_SA(0, 1), cA + hstepA, voffA);
    if (wr == 1) PG8_BAR;
    PG8_WAIT_V(2); PG8_BAR;
    PG8_STAGE(PG8_SB(1, 0), cB + kstep, voffB); PG8_STAGE(PG8_SA(1, 0), cA + kstep, voffA); PG8_STAGE(PG8_SB(1, 1), cB + hstepB + kstep, voffB);
    PG8_WAIT_V(6); PG8_BAR;
    for (;;) {
        const bool has_next = S.next(ui + 1, nxt);
        const char* nA = has_next ? (const char*)g.A + (size_t)nxt.pm * tstepA : cA; const char* nB = has_next ? (const char*)g.Bt + (size_t)nxt.pn * tstepB : cB;
        for (int t = 0; t < nt; t += 2) {
            const bool last = (t == nt - 2);
            const char* a1 = cA + (size_t)(t + 1) * kstep;
            const char* a2 = last ? nA : cA + (size_t)(t + 2) * kstep; const char* b2 = last ? nB : cB + (size_t)(t + 2) * kstep;
            const char* a3 = a2 + kstep; const char* b3 = b2 + kstep;
            PG8_LDB(B0, 0, 0); PG8_LDB(B1, 0, 1); PG8_SCHED; PG8_LDA(At, 0, 0); PG8_STAGE(PG8_SA(1, 1), a1 + hstepA, voffA);
            PG8_WAIT_V(8); PG8_WAIT_L(0); PG8_BAR; PG8_MMA(0, 0, At, B0); PG8_MMA(0, 1, At, B1); PG8_BAR; PG8_SCHED;
            PG8_LDA(At, 0, 1); PG8_STAGE(PG8_SB(0, 0), b2, voffB); PG8_STAGE(PG8_SB(0, 1), b2 + hstepB, voffB); PG8_STAGE(PG8_SA(0, 0), a2, voffA);
            PG8_WAIT_V(8); PG8_WAIT_L(0); PG8_BAR; PG8_MMA(1, 0, At, B0); PG8_MMA(1, 1, At, B1); PG8_BAR; PG8_SCHED;
            PG8_LDB(B0, 1, 0); PG8_LDB(B1, 1, 1); PG8_SCHED; PG8_LDA(At, 1, 0); PG8_STAGE(PG8_SA(0, 1), a2 + hstepA, voffA);
            PG8_WAIT_V(8); PG8_WAIT_L(0); PG8_BAR; PG8_MMA(0, 0, At, B0); PG8_MMA(0, 1, At, B1); PG8_BAR; PG8_SCHED;
            PG8_LDA(At, 1, 1); PG8_STAGE(PG8_SB(1, 0), b3, voffB); PG8_STAGE(PG8_SB(1, 1), b3 + hstepB, voffB); PG8_STAGE(PG8_SA(1, 0), a3, voffA);
            PG8_WAIT_V(8); PG8_WAIT_L(0); PG8_BAR; PG8_MMA(1, 0, At, B0); PG8_MMA(1, 1, At, B1); PG8_BAR; PG8_SCHED;
        }
        if (wr == 0) PG8_BAR;
        E(acc, cur, wr, wc, fr, fq);
        if (!has_next) break;
#pragma unroll
        for (int a = 0; a < 2; ++a)
#pragma unroll
            for (int b = 0; b < 2; ++b)
#pragma unroll
                for (int m = 0; m < 4; ++m)
#pragma unroll
                    for (int n = 0; n < 2; ++n) acc[a][b][m][n] = (f32x4){0.f, 0.f, 0.f, 0.f};
        cur = nxt; cA = nA; cB = nB; ++ui;
        if (wr == 1) PG8_BAR;
    }
    PG8_WAIT_V(0);
    PG8_BAR;
#undef PG8_SA
#undef PG8_SB
#undef PG8_STAGE
#undef PG8_LDA
#undef PG8_LDB
#undef PG8_MMA
#undef PG8_WAIT_V
#undef PG8_WAIT_L
#undef PG8_BAR
#undef PG8_SCHED
}
}
using pg8::Unit;
typedef f32x4 (&AccRef)[2][2][4][2];

__device__ __forceinline__ void rope8(f32x4& v0, f32x4& v1, const float* cosr, const float* sinr, int fq) {
    const int j0 = 8 * (fq & 1);
    const f32x4 c0 = *(const f32x4*)(cosr + j0), c1 = *(const f32x4*)(cosr + j0 + 4), s0 = *(const f32x4*)(sinr + j0), s1 = *(const f32x4*)(sinr + j0 + 4);
    const float sg = (fq < 2) ? -1.f : 1.f;
#pragma unroll
    for (int i = 0; i < 4; ++i) {
        const float p0 = __shfl_xor(v0[i], 32), p1 = __shfl_xor(v1[i], 32);
        v0[i] = v0[i] * c0[i] + sg * p0 * s0[i]; v1[i] = v1[i] * c1[i] + sg * p1 * s1[i];
    }
}

struct EpiProj {
    static constexpr bool PERM = true;
    bf16_t* O; const float* ssqx; float* ssqq; float* ssqkv; const float* cost; const float* sint;
    __device__ __forceinline__ void operator()(AccRef acc, const Unit& u, int wr, int wc, int fr, int fq) const {
        const int row0 = u.pm * 256 + wr * 64 + fr, col0 = u.pn * 256 + wc * 32 + 8 * fq;
#pragma unroll
        for (int ai = 0; ai < 2; ++ai)
#pragma unroll
            for (int m = 0; m < 4; ++m) {
                const int row = row0 + ai * 128 + m * 16;
                const float rs = rsqrtf(ssq_sum<4>(ssqx + (size_t)row * 4) * (1.0f / DM) + EPS);
                bf16_t* rowp = O + (size_t)row * NPROJ + col0;
#pragma unroll
                for (int bj = 0; bj < 2; ++bj) {
                    f32x4 v0 = acc[ai][bj][m][0] * rs, v1 = acc[ai][bj][m][1] * rs;
                    if (u.pn == 6 || (u.pn == 7 && bj == 0)) {
                        float s = (v0[0] * v0[0] + v0[1] * v0[1]) + (v0[2] * v0[2] + v0[3] * v0[3]) + (v1[0] * v1[0] + v1[1] * v1[1]) + (v1[2] * v1[2] + v1[3] * v1[3]);
                        s += __shfl_xor(s, 16); s += __shfl_xor(s, 32);
                        if (fq == 0) { if (u.pn == 6) ssqq[(size_t)row * 8 + bj * 4 + wc] = s; else ssqkv[(size_t)row * 4 + wc] = s; }
                    }
                    if (u.pn == 7 && bj == 1 && wc == 0) { const int pos = row & (SEQ - 1); rope8(v0, v1, cost + pos * 16, sint + pos * 16, fq); }
                    u32x4 w; w.x = cvtpk(v0[0], v0[1]); w.y = cvtpk(v0[2], v0[3]); w.z = cvtpk(v1[0], v1[1]); w.w = cvtpk(v1[2], v1[3]);
                    st16_wt(rowp + bj * 128, w);
                }
                asm volatile("" ::: "memory");
            }
    }
};
template <bool ROPE, int NS> struct EpiMla {
    static constexpr bool PERM = true;
    bf16_t* O; int ldc; const float* ssq; float inv_n; const float* cost; const float* sint;
    __device__ __forceinline__ void operator()(AccRef acc, const Unit& u, int wr, int wc, int fr, int fq) const {
        const int row0 = u.pm * 256 + wr * 64 + fr, col0 = u.pn * 256 + wc * 32 + 8 * fq;
#pragma unroll
        for (int ai = 0; ai < 2; ++ai)
#pragma unroll
            for (int m = 0; m < 4; ++m) {
                const int row = row0 + ai * 128 + m * 16;
                const float rs = rsqrtf(ssq_sum<NS>(ssq + (size_t)row * NS) * inv_n + EPS);
                bf16_t* rowp = O + (size_t)row * ldc + col0;
#pragma unroll
                for (int bj = 0; bj < 2; ++bj) {
                    f32x4 v0 = acc[ai][bj][m][0] * rs, v1 = acc[ai][bj][m][1] * rs;
                    if (ROPE) { const int g32 = u.pn * 8 + bj * 4 + wc; if (g32 % 3 == 2) { const int pos = row & (SEQ - 1); rope8(v0, v1, cost + pos * 16, sint + pos * 16, fq); } }
                    u32x4 w; w.x = cvtpk(v0[0], v0[1]); w.y = cvtpk(v0[2], v0[3]); w.z = cvtpk(v1[0], v1[1]); w.w = cvtpk(v1[2], v1[3]);
                    st16_wt(rowp + bj * 128, w);
                }
                asm volatile("" ::: "memory");
            }
    }
};
struct EpiResid {
    static constexpr bool PERM = true;
    bf16_t* XB; float* ssq; LAS float* red;
    __device__ __forceinline__ void operator()(AccRef acc, const Unit& u, int wr, int wc, int fr, int fq) const {
        const int row0 = u.pm * 256 + wr * 64 + fr, col0 = u.pn * 256 + wc * 32 + 8 * fq;
#pragma unroll
        for (int ai = 0; ai < 2; ++ai)
#pragma unroll
            for (int m = 0; m < 4; ++m) {
                const int row = row0 + ai * 128 + m * 16; bf16_t* rowp = XB + (size_t)row * DM + col0; float s = 0.f;
#pragma unroll
                for (int bj = 0; bj < 2; ++bj) {
                    const u32x4 xo = *(const u32x4*)(rowp + bj * 128);
                    float v[8];
#pragma unroll
                    for (int k = 0; k < 4; ++k) { v[2 * k] = __uint_as_float(xo[k] << 16) + acc[ai][bj][m][k >> 1][(2 * k) & 3]; v[2 * k + 1] = __uint_as_float(xo[k] & 0xffff0000u) + acc[ai][bj][m][k >> 1][(2 * k + 1) & 3]; }
#pragma unroll
                    for (int k = 0; k < 8; ++k) s += v[k] * v[k];
                    u32x4 w; w.x = cvtpk(v[0], v[1]); w.y = cvtpk(v[2], v[3]); w.z = cvtpk(v[4], v[5]); w.w = cvtpk(v[6], v[7]);
                    st16_wt(rowp + bj * 128, w);
                }
                s += __shfl_xor(s, 16); s += __shfl_xor(s, 32);
                if (fq == 0) red[(ai * 128 + wr * 64 + m * 16 + fr) * 4 + wc] = s;
                asm volatile("" ::: "memory");
            }
        asm volatile("s_waitcnt lgkmcnt(0)" ::: "memory"); __builtin_amdgcn_s_barrier(); asm volatile("" ::: "memory");
        const int t = (wr * 4 + wc) * 64 + fq * 16 + fr;
        if (t < 256) { const f32x4 p = *(const LAS f32x4*)(red + t * 4); ssq[(size_t)(u.pm * 256 + t) * 4 + u.pn] = (p[0] + p[1]) + (p[2] + p[3]); }
    }
};
template <int CTRL> __device__ __forceinline__ float dpp_rot(float v) { return __int_as_float(__builtin_amdgcn_update_dpp(__float_as_int(v), __float_as_int(v), CTRL, 0xf, 0xf, false)); }
struct EpiUp {
    static constexpr bool PERM = true;
    bf16_t* ACT; bf16_t* UB; const float* ssqx; const float* cw; const float* cb;
    __device__ __forceinline__ void operator()(AccRef acc, const Unit& u, int wr, int wc, int fr, int fq) const {
        const int row0 = u.pm * 256 + wr * 64 + fr, gcol = u.pn * 128 + wc * 32 + 8 * fq;
#pragma unroll
        for (int ai = 0; ai < 2; ++ai) {
#pragma unroll
            for (int m = 0; m < 4; ++m) {
                const float rs = rsqrtf(ssq_sum<4>(ssqx + (size_t)(row0 + ai * 128 + m * 16) * 4) * (1.0f / DM) + EPS);
#pragma unroll
                for (int bj = 0; bj < 2; ++bj) { acc[ai][bj][m][0] = acc[ai][bj][m][0] * rs; acc[ai][bj][m][1] = acc[ai][bj][m][1] * rs; }
            }
            asm volatile("" ::: "memory");
            const int chunk = u.pm * 4 + ai * 2 + wr;
#pragma unroll
            for (int e = 0; e < 2; ++e) {
                const int m = e ? 3 : 0;
                const bool mine = e ? (fr >= 14) : (fr <= 1);
                const int slot = e ? (fr - 12) : fr;
                if (mine) {
#pragma unroll
                    for (int bj = 0; bj < 2; ++bj) {
                        const f32x4 v0 = acc[ai][bj][m][0], v1 = acc[ai][bj][m][1];
                        u32x4 w; w.x = cvtpk(v0[0], v0[1]); w.y = cvtpk(v0[2], v0[3]); w.z = cvtpk(v1[0], v1[1]); w.w = cvtpk(v1[2], v1[3]);
                        *(u32x4*)(UB + ((size_t)chunk * 4 + slot) * NUP + bj * DFF + gcol) = w;
                    }
                }
            }
        }
#define CONV_TAP(t, u, g, ctl) asm("v_fmac_f32_dpp %0, %1, %2 " ctl " row_mask:0xf bank_mask:0xf bound_ctrl:0" : "+v"(t) : "v"(u), "v"(g))
        __builtin_amdgcn_sched_barrier(0);
        asm volatile("s_nop 1" ::: "memory");
#pragma unroll
        for (int n = 0; n < 2; ++n) {
            const int cg4 = gcol + 4 * n, cv4 = cg4 + DFF;
            const f32x4 g0v = *(const f32x4*)(cw + cg4), g1v = *(const f32x4*)(cw + NUP + cg4), g2v = *(const f32x4*)(cw + 2 * NUP + cg4), gbv = *(const f32x4*)(cb + cg4);
            const f32x4 h0v = *(const f32x4*)(cw + cv4), h1v = *(const f32x4*)(cw + NUP + cv4), h2v = *(const f32x4*)(cw + 2 * NUP + cv4), hbv = *(const f32x4*)(cb + cv4);
#pragma unroll
            for (int ai = 0; ai < 2; ++ai) {
                unsigned wpk[4][2]; float rlo[4];
#pragma unroll
                for (int i = 0; i < 4; ++i) {
                    const float g0 = g0v[i], g1 = g1v[i], g2 = g2v[i], gb = gbv[i], h0 = h0v[i], h1 = h1v[i], h2 = h2v[i], hb = hbv[i];
                    float gt[4], vl[4];
#pragma unroll
                    for (int m = 0; m < 4; ++m) { gt[m] = __builtin_fmaf(g1, acc[ai][0][m][n][i], gb); vl[m] = __builtin_fmaf(h1, acc[ai][1][m][n][i], hb); }
#pragma unroll
                    for (int m = 0; m < 4; ++m) {
                        CONV_TAP(gt[m], acc[ai][0][m][n][i], g0, "row_shr:1"); CONV_TAP(gt[m], acc[ai][0][m][n][i], g2, "row_shl:1");
                        CONV_TAP(vl[m], acc[ai][1][m][n][i], h0, "row_shr:1"); CONV_TAP(vl[m], acc[ai][1][m][n][i], h2, "row_shl:1");
                        if (m > 0) { CONV_TAP(gt[m], acc[ai][0][m - 1][n][i], g0, "row_shl:15"); CONV_TAP(vl[m], acc[ai][1][m - 1][n][i], h0, "row_shl:15"); }
                        if (m < 3) { CONV_TAP(gt[m], acc[ai][0][m + 1][n][i], g2, "row_shr:15"); CONV_TAP(vl[m], acc[ai][1][m + 1][n][i], h2, "row_shr:15"); }
                    }
#pragma unroll
                    for (int m = 0; m < 4; ++m) {
                        const float sg = gt[m] * fast_rcp(1.f + fast_exp2(-LOG2E * gt[m]));
                        const float rv = sg * vl[m];
                        if (i & 1) wpk[m][i >> 1] = cvtpk(rlo[m], rv); else rlo[m] = rv;
                    }
                    asm volatile("" ::: "memory");
                }
#pragma unroll
                for (int m = 0; m < 4; ++m) { u32x2 w; w.x = wpk[m][0]; w.y = wpk[m][1];
                    *(u32x2*)(ACT + (size_t)(row0 + ai * 128 + m * 16) * DFF + gcol + 4 * n) = w; }
                asm volatile("" ::: "memory");
            }
        }
#undef CONV_TAP
    }
};

constexpr float AT_THR = 8.0f;
constexpr int AT_BUF = 20480, AT_V = 12288, AT_TAB = 3 * AT_BUF, AT_TABC = 16384 + 64;
static_assert(AT_TAB + 4 * AT_TABC <= 131072, "attention LDS");
__device__ __forceinline__ float xmax(float a) { auto rr = __builtin_amdgcn_permlane32_swap(__float_as_uint(a), __float_as_uint(a), false, false); return fmaxf(__uint_as_float(rr[0]), __uint_as_float(rr[1])); }
__device__ __forceinline__ float xsum(float a) { auto rr = __builtin_amdgcn_permlane32_swap(__float_as_uint(a), __float_as_uint(a), false, false); return __uint_as_float(rr[0]) + __uint_as_float(rr[1]); }
__device__ __forceinline__ u32x4 pair_swap(u32x2 a, u32x2 b) {
    auto r0 = __builtin_amdgcn_permlane32_swap(a.x, b.x, false, false);
    auto r1 = __builtin_amdgcn_permlane32_swap(a.y, b.y, false, false);
    return (u32x4){r0[0], r1[0], r0[1], r1[1]};
}
typedef short v4i16_t __attribute__((ext_vector_type(4)));
__device__ __forceinline__ s16x4 vtr(const LAS unsigned char* p) { return __builtin_bit_cast(s16x4, __builtin_amdgcn_ds_read_tr16_b64_v4i16((LAS v4i16_t*)p)); }

template <int MODE, int NQ>
__device__ __forceinline__ void attn_unit(LAS unsigned char* lds, const Params& P, int layer, int b, int h, int qb) {
    constexpr int NMAP = (MODE == 1) ? 2 : 1, ND0 = (MODE == 0) ? 6 : (MODE == 1 ? 2 : 4), NC = NQ * NMAP, QROWS = 256 * NQ;
    int tid = threadIdx.x; asm volatile("" : "+v"(tid));
    const int lane = tid & 63, r32 = lane & 31, hi = lane >> 5, wave = __builtin_amdgcn_readfirstlane(tid >> 6);
    const bf16_t* proj = (const bf16_t*)(P.ws + WS_PROJ); const bf16_t* cq = (const bf16_t*)(P.ws + WS_CQ); const bf16_t* ckv = (const bf16_t*)(P.ws + WS_CKV);
    bf16_t* mix = (bf16_t*)(P.ws + WS_MIX);
    const size_t rowbase = (size_t)b * SEQ; const int q0 = qb * QROWS;
    const bf16_t *Qp, *Kp, *Vp; int qpitch, kpitch, vpitch, ocol; float c;
    if (MODE == 0) { Qp = cq + h * 96; qpitch = PCQ; Kp = ckv + h * 128; kpitch = PCKV; Vp = ckv + h * 128 + 64; vpitch = PCKV; ocol = 512 + h * 64; c = 0.10206207261596577f * LOG2E; }
    else if (MODE == 1) { Qp = proj + h * 64; qpitch = NPROJ; Kp = proj + 256 + h * 64; kpitch = NPROJ; Vp = proj + 512 + h * 64; vpitch = NPROJ; ocol = h * 64; c = 0.17677669529663687f * LOG2E; }
    else { Qp = proj + 768 + h * 64; qpitch = NPROJ; Kp = proj + 1024 + h * 64; kpitch = NPROJ; Vp = proj + 1280 + h * 64; vpitch = NPROJ; ocol = 256 + h * 64; c = 0.125f * LOG2E; }
    int kt0 = 0, kt1 = SEQ / 64;
    if (MODE == 2) { kt0 = (q0 - 1024) / 64; if (kt0 < 0) kt0 = 0; kt1 = (q0 + QROWS + 1024) / 64; if (kt1 > SEQ / 64) kt1 = SEQ / 64; }
    LAS unsigned char* tabb = lds + AT_TAB;
    if (MODE != 0) {
        const float slope = (MODE == 1) ? exp2f(-(float)(2 * h + 1)) : exp2f(-(float)(2 * h + 2));
        for (int jj = tid; jj < 4 * 4096; jj += 512) {
            const int sc_ = jj >> 12, j = (jj & 4095) + sc_;
            const int d = (j > 2047) ? (j - 2047) : (2047 - j);
            float v = -slope * LOG2E * (float)d;
            if (MODE == 2) {
                const int mult = (d <= 64 ? 1 : 0) + (((d & 3) == 0 && d <= 256) ? 1 : 0) + (((d & 15) == 0 && d <= 1024) ? 1 : 0);
                v = (mult == 0) ? -1e30f : (mult == 1 ? v : (mult == 2 ? v + 1.0f : v + 1.5849625007211562f));
            }
            *(LAS float*)(tabb + sc_ * AT_TABC + (jj & 4095) * 4) = v;
        }
    }
    const int qpos0 = q0 + wave * (32 * NQ) + r32;
    const int tb0_ = 4 * hi - qpos0 + 2047, ts_ = tb0_ & 3;
    const LAS unsigned char* tlane = tabb + ts_ * AT_TABC + (tb0_ - ts_) * 4;
    bf16x8 qf[NC][ND0];
#pragma unroll
    for (int jq = 0; jq < NQ; ++jq) {
        const bf16_t* qrow = Qp + (rowbase + qpos0 + 32 * jq) * qpitch + hi * 8;
#pragma unroll
        for (int mp = 0; mp < NMAP; ++mp)
#pragma unroll
            for (int d0 = 0; d0 < ND0; ++d0) qf[jq * NMAP + mp][d0] = *(const bf16x8*)(qrow + mp * 32 + d0 * 16);
    }
    u32x4 kreg, kreg2 = (u32x4){0u, 0u, 0u, 0u}, vreg;
#define AT_GLOADK(kt) do { const size_t r_ = rowbase + (size_t)(kt) * 64; \
        kreg = *(const u32x4*)(Kp + (r_ + lane) * kpitch + wave * 8); \
        if (MODE == 0 && wave < 4) kreg2 = *(const u32x4*)(proj + (r_ + lane) * NPROJ + 1920 + wave * 8); } while (0)
#define AT_GLOADV(kt) do { const size_t r_ = rowbase + (size_t)(kt) * 64; \
        vreg = *(const u32x4*)(Vp + (r_ + 16 * (wave & 3) + (lane >> 2)) * vpitch + (wave >> 2) * 32 + (lane & 3) * 8); } while (0)
#define AT_LSTOREK(buf) do { LAS unsigned char* d_ = lds + (buf) * AT_BUF; \
        *(LAS u32x4*)(d_ + wave * 1024 + lane * 16) = kreg; \
        if (MODE == 0 && wave < 4) *(LAS u32x4*)(d_ + (8 + wave) * 1024 + lane * 16) = kreg2; } while (0)
#define AT_LSTOREV(buf) do { LAS unsigned char* d_ = lds + (buf) * AT_BUF; \
        *(LAS u32x4*)(d_ + AT_V + wave * 1024 + lane * 16) = vreg; } while (0)
    float mrun[NC], lrun[NC]; f32x16 o[NC][2];
#pragma unroll
    for (int cc = 0; cc < NC; ++cc) { mrun[cc] = -1e20f; lrun[cc] = 0.f; o[cc][0] = f32x16{}; o[cc][1] = f32x16{}; }
    constexpr int NK = NMAP * ND0;
    const bf16x8 ones8 = (bf16x8){0x3F80, 0x3F80, 0x3F80, 0x3F80, 0x3F80, 0x3F80, 0x3F80, 0x3F80};
    const bf16x8 zero8 = (bf16x8){0, 0, 0, 0, 0, 0, 0, 0};
    bf16x8 kf[NK]; s16x4 vlo[4], vhi[4];
#define AT_KLOAD(bufbase, hf) do { _Pragma("unroll") for (int j_ = 0; j_ < NK; ++j_) kf[j_] = *(const LAS bf16x8*)((bufbase) + (2 * j_ + hi) * 1024 + (hf) * 512 + r32 * 16); } while (0)
#define AT_VLOAD(bufbase, hf) do { _Pragma("unroll") for (int dv_ = 0; dv_ < 2; ++dv_) _Pragma("unroll") for (int k2_ = 0; k2_ < 2; ++k2_) { \
        vlo[dv_ * 2 + k2_] = vtr((bufbase) + AT_V + vlane + dv_ * 4096 + (2 * (hf) + k2_) * 1024); vhi[dv_ * 2 + k2_] = vtr((bufbase) + AT_V + vlane + dv_ * 4096 + (2 * (hf) + k2_) * 1024 + 512); } } while (0)
    const int vlane = ((lane >> 4) & 1) * 32 + (lane & 3) * 8 + (4 * hi + ((lane & 15) >> 2)) * 64;
    const int NT = kt1 - kt0, ks = (MODE != 0) ? (q0 / 64 - kt0) : 0;
#define AT_TILE(i) (kt0 + (((ks + (i)) >= NT) ? (ks + (i) - NT) : (ks + (i))))
    AT_GLOADK(AT_TILE(0)); AT_GLOADV(AT_TILE(0)); AT_LSTOREK(0); AT_LSTOREV(0);
    if (1 < NT) { AT_GLOADK(AT_TILE(1)); AT_GLOADV(AT_TILE(1)); AT_LSTOREK(1); AT_LSTOREV(1); }
    __syncthreads();
    AT_KLOAD(lds, 0);
    if (wave >= 4) __builtin_amdgcn_s_setprio(1);
    int bcur = 0;
    for (int it = 0; it < NT; ++it) {
        const int kt = AT_TILE(it);
        const int bnx = (bcur == 2) ? 0 : bcur + 1, bn2 = (bnx == 2) ? 0 : bnx + 1;
        const LAS unsigned char* cur = lds + bcur * AT_BUF;
        const LAS unsigned char* nxt = lds + bnx * AT_BUF;
#pragma unroll
        for (int hf = 0; hf < 2; ++hf) {
            if (it + 2 < NT) { if (hf == 0) AT_GLOADK(AT_TILE(it + 2)); else AT_GLOADV(AT_TILE(it + 2)); }
            f32x16 sc[NC];
#pragma unroll
            for (int cc = 0; cc < NC; ++cc) {
                sc[cc] = f32x16{};
#pragma unroll
                for (int d0 = 0; d0 < ND0; ++d0) sc[cc] = __builtin_amdgcn_mfma_f32_32x32x16_bf16(kf[(cc % NMAP) * ND0 + d0], qf[cc][d0], sc[cc], 0, 0, 0);
            }
            __builtin_amdgcn_sched_barrier(0);
            AT_VLOAD(cur, hf);
            if (hf == 0) AT_KLOAD(cur, 1); else if (it + 1 < NT) AT_KLOAD(nxt, 0);
            __builtin_amdgcn_sched_barrier(0);
            bf16x8 pw[NC][2]; float rmrel[NC]; bool alive = false;
#pragma unroll
            for (int cc = 0; cc < NC; ++cc) {
                f32x16& s0 = sc[cc];
                float mn;
                if (MODE != 0) {
                    const LAS f32x4* tp4 = (const LAS f32x4*)(tlane + (kt * 64 + hf * 32) * 4);
                    float rm = -3e38f;
#pragma unroll
                    for (int g = 0; g < 4; ++g) { const f32x4 t4 = tp4[2 * g];
#pragma unroll
                        for (int i = 0; i < 4; ++i) { s0[4 * g + i] = s0[4 * g + i] * c + t4[i]; rm = fmaxf(rm, s0[4 * g + i]); } }
                    rm = xmax(rm);
                    mn = fmaxf(mrun[cc], rm);
                    rmrel[cc] = rm;
                } else {
                    float rm = -3e38f;
#pragma unroll
                    for (int r = 0; r < 16; ++r) rm = fmaxf(rm, s0[r]);
                    rm = xmax(rm);
                    mn = fmaxf(mrun[cc], rm * c);
                }
                if (__any(mn > mrun[cc] + AT_THR)) {
                    const float al = fast_exp2(mrun[cc] - mn); lrun[cc] *= al;
#pragma unroll
                    for (int r = 0; r < 16; ++r) { o[cc][0][r] *= al; o[cc][1][r] *= al; }
                    mrun[cc] = mn;
                }
                mn = mrun[cc];
                if (MODE != 0) rmrel[cc] -= mn;
                const bool dead = (MODE != 0) && __all(rmrel[cc] < -136.f);
                if (dead) { pw[cc][0] = zero8; pw[cc][1] = zero8; }
                else {
                    alive = true;
                    if (MODE != 0) {
#pragma unroll
                        for (int r = 0; r < 16; ++r) s0[r] = fast_exp2(s0[r] - mn);
                    } else {
                        const float nm = -mn;
#pragma unroll
                        for (int r = 0; r < 16; ++r) s0[r] = fast_exp2(__builtin_fmaf(s0[r], c, nm));
                    }
                    u32x4 w;
                    w.x = cvtpk(s0[0], s0[1]); w.y = cvtpk(s0[2], s0[3]); w.z = cvtpk(s0[4], s0[5]); w.w = cvtpk(s0[6], s0[7]); pw[cc][0] = __builtin_bit_cast(bf16x8, w);
                    w.x = cvtpk(s0[8], s0[9]); w.y = cvtpk(s0[10], s0[11]); w.z = cvtpk(s0[12], s0[13]); w.w = cvtpk(s0[14], s0[15]); pw[cc][1] = __builtin_bit_cast(bf16x8, w);
                    f32x16 t = __builtin_amdgcn_mfma_f32_32x32x16_bf16(ones8, pw[cc][0], f32x16{}, 0, 0, 0);
                    t = __builtin_amdgcn_mfma_f32_32x32x16_bf16(ones8, pw[cc][1], t, 0, 0, 0);
                    lrun[cc] += t[0];
                }
            }
            if (alive)
#pragma unroll
            for (int dv = 0; dv < 2; ++dv)
#pragma unroll
                for (int k2 = 0; k2 < 2; ++k2) {
                    const s16x4 lo = vlo[dv * 2 + k2], hh = vhi[dv * 2 + k2];
                    const bf16x8 vf = (bf16x8){lo[0], lo[1], lo[2], lo[3], hh[0], hh[1], hh[2], hh[3]};
#pragma unroll
                    for (int cc = 0; cc < NC; ++cc) o[cc][dv] = __builtin_amdgcn_mfma_f32_32x32x16_bf16(vf, pw[cc][k2], o[cc][dv], 0, 0, 0);
                }
            if (it + 2 < NT) { if (hf == 0) AT_LSTOREK(bn2); else AT_LSTOREV(bn2); }
        }
        __syncthreads();
        bcur = bnx;
    }
    __builtin_amdgcn_s_setprio(0);
#undef AT_KLOAD
#undef AT_VLOAD
#undef AT_TILE
#undef AT_GLOADK
#undef AT_GLOADV
#undef AT_LSTOREK
#undef AT_LSTOREV
    if (MODE != 1) {
#pragma unroll
        for (int jq = 0; jq < NQ; ++jq) {
            bf16_t* orow = mix + (rowbase + qpos0 + 32 * jq) * DM + ocol + 8 * hi;
            const float inv = 1.f / lrun[jq];
#pragma unroll
            for (int d = 0; d < 2; ++d)
#pragma unroll
                for (int gp = 0; gp < 2; ++gp) {
                    u32x2 a, b; const int g0 = 2 * gp, g1 = 2 * gp + 1;
                    a.x = cvtpk(o[jq][d][4 * g0] * inv, o[jq][d][4 * g0 + 1] * inv); a.y = cvtpk(o[jq][d][4 * g0 + 2] * inv, o[jq][d][4 * g0 + 3] * inv);
                    b.x = cvtpk(o[jq][d][4 * g1] * inv, o[jq][d][4 * g1 + 1] * inv); b.y = cvtpk(o[jq][d][4 * g1 + 2] * inv, o[jq][d][4 * g1 + 3] * inv);
                    *(u32x4*)(orow + 32 * d + 16 * gp) = pair_swap(a, b);
                }
        }
    } else {
        bf16_t* orow = mix + (rowbase + qpos0) * DM + ocol + 8 * hi;
        const float lam = __hip_atomic_load((const float*)(P.ws + WS_LAM) + layer, __ATOMIC_RELAXED, __HIP_MEMORY_SCOPE_AGENT);
        const float lam_init = 0.8f - 0.6f * expf(-0.3f * (float)layer);
        const float i1 = 1.f / lrun[0], i2 = lam / lrun[NC - 1];
        float ss = 0.f;
#pragma unroll
        for (int d = 0; d < 2; ++d)
#pragma unroll
            for (int r = 0; r < 16; ++r) { const float v = o[0][d][r] * i1 - o[NC - 1][d][r] * i2; o[0][d][r] = v; ss += v * v; }
        ss = xsum(ss);
        const float sc_ = rsqrtf(ss * (1.0f / 64.0f) + EPS) * (1.f - lam_init);
        const float* gn = P.a_subln + layer * 64 + 4 * hi;
#pragma unroll
        for (int d = 0; d < 2; ++d)
#pragma unroll
            for (int gp = 0; gp < 2; ++gp) {
                u32x2 ab[2];
#pragma unroll
                for (int e = 0; e < 2; ++e) { const int g = 2 * gp + e;
                    const f32x4 gv = *(const f32x4*)(gn + 32 * d + 8 * g);
                    ab[e].x = cvtpk(o[0][d][4 * g] * sc_ * gv[0], o[0][d][4 * g + 1] * sc_ * gv[1]); ab[e].y = cvtpk(o[0][d][4 * g + 2] * sc_ * gv[2], o[0][d][4 * g + 3] * sc_ * gv[3]); }
                *(u32x4*)(orow + 32 * d + 16 * gp) = pair_swap(ab[0], ab[1]);
            }
    }
}

constexpr int TT_PITCH = 272;
__device__ __forceinline__ void transpose_tile(const float* W, int K, int Nsrc, const float* g, bf16_t* WT, int n0_dst, int n0_src, int nvalid, int k0, LAS unsigned char* lds, int tid) {
    const int kgrp = tid >> 5, c4 = tid & 31;
    f32x4 v[8];
#pragma unroll
    for (int r = 0; r < 8; ++r) v[r] = (4 * c4 < nvalid) ? *(const f32x4*)(W + (size_t)(k0 + kgrp * 8 + r) * Nsrc + n0_src + 4 * c4) : (f32x4){0.f, 0.f, 0.f, 0.f};
    if (g) {
#pragma unroll
        for (int r = 0; r < 8; ++r) v[r] = v[r] * g[k0 + kgrp * 8 + r];
    }
#pragma unroll
    for (int j = 0; j < 4; ++j) {
        u32x4 w; w.x = cvtpk(v[0][j], v[1][j]); w.y = cvtpk(v[2][j], v[3][j]); w.z = cvtpk(v[4][j], v[5][j]); w.w = cvtpk(v[6][j], v[7][j]);
        *(LAS u32x4*)(lds + (4 * c4 + j) * TT_PITCH + kgrp * 16) = w;
    }
    __syncthreads();
    const int n = tid >> 2, q = tid & 3;
    bf16_t* dst = WT + (size_t)(n0_dst + n) * K + k0 + q * 32;
#pragma unroll
    for (int e = 0; e < 4; ++e) *(u32x4*)(dst + e * 8) = *(const LAS u32x4*)(lds + n * TT_PITCH + q * 64 + e * 16);
    __syncthreads();
}

__device__ __forceinline__ void zero_f32(float* p, int n) { for (int i = blockIdx.x * 512 + threadIdx.x; i < n; i += gridDim.x * 512) p[i] = 0.f; }

__device__ __forceinline__ void prologue(const Params& P, LAS unsigned char* lds) {
    const int tid = threadIdx.x, lane = tid & 63, wave = tid >> 6;
    const int gw = blockIdx.x * 8 + wave, NGW = gridDim.x * 8;
    constexpr int I_IN = 8 * 16, I_OUT = 8 * 8, I_UP = 8 * 44, I_DN = 22 * 8, I_UQ = 2 * 6, I_UKV = 8, I_L = I_IN + I_OUT + I_UP + I_DN + I_UQ + I_UKV;
    for (int it = blockIdx.x; it < I_L * DEPTH; it += gridDim.x) {
        const int l = it / I_L; int r = it % I_L;
        unsigned char* wl = P.ws + WS_W + (size_t)l * W_LAYER;
        if (r < I_IN) { const int kb = r / 16, nb = r % 16; transpose_tile(P.w_in + (size_t)l * DM * NIN, DM, NIN, P.g_attn + l * DM, (bf16_t*)(wl + W_IN), nb * 128, nb * 128, (nb < 15) ? 128 : 32, kb * 128, lds, tid); continue; } r -= I_IN;
        if (r < I_OUT) { const int kb = r / 8, nb = r % 8; transpose_tile(P.w_out + (size_t)l * DM * DM, DM, DM, nullptr, (bf16_t*)(wl + W_OUT), nb * 128, nb * 128, 128, kb * 128, lds, tid); continue; } r -= I_OUT;
        if (r < I_UP) { const int kb = r / 44, nb = r % 44; transpose_tile(P.w_up + (size_t)l * DM * NUP, DM, NUP, P.g_ffn + l * DM, (bf16_t*)(wl + W_UP), nb * 128, (nb & 1) * DFF + (nb >> 1) * 128, 128, kb * 128, lds, tid); continue; } r -= I_UP;
        if (r < I_DN) { const int kb = r / 8, nb = r % 8; transpose_tile(P.w_down + (size_t)l * DFF * DM, DFF, DM, nullptr, (bf16_t*)(wl + W_DOWN), nb * 128, nb * 128, 128, kb * 128, lds, tid); continue; } r -= I_DN;
        if (r < I_UQ) { const int kb = r / 6, nb = r % 6; transpose_tile(P.c_w_uq + (size_t)l * 256 * NCQ, 256, NCQ, P.c_g_q + l * 256, (bf16_t*)(wl + W_UQ), nb * 128, nb * 128, 128, kb * 128, lds, tid); continue; } r -= I_UQ;
        { const int nb = r; transpose_tile(P.c_w_ukv + (size_t)l * 128 * NCKV, 128, NCKV, P.c_g_kv + l * 128, (bf16_t*)(wl + W_UKV), nb * 128, nb * 128, 128, 0, lds, tid); }
    }
    float* ssqA = (float*)(P.ws + WS_SSQA); bf16_t* xb = (bf16_t*)(P.ws + WS_XB);
    for (int m = gw; m < T_TOK; m += NGW) {
        const f32x4* xr = (const f32x4*)(P.x + (size_t)m * DM) + lane; u32x2* brow = (u32x2*)(xb + (size_t)m * DM) + lane;
        float s = 0.f;
#pragma unroll
        for (int j = 0; j < 4; ++j) { const f32x4 v = xr[64 * j]; u32x2 w; w.x = cvtpk(v[0], v[1]); w.y = cvtpk(v[2], v[3]); brow[64 * j] = w; s += (v[0] * v[0] + v[1] * v[1]) + (v[2] * v[2] + v[3] * v[3]); }
        s = wave_sum(s);
        if (lane < 4) ssqA[(size_t)m * 4 + lane] = lane ? 0.f : s;
    }
    float* cost = (float*)(P.ws + WS_COS); float* sint = (float*)(P.ws + WS_SIN);
    for (int i = blockIdx.x * 512 + tid; i < SEQ * 16; i += gridDim.x * 512) {
        const int pos = i >> 4, j = i & 15; const float inv = exp2f(-(float)j * (13.287712379549449f / 16.0f)); const float ang = (float)pos * inv;
        cost[i] = cosf(ang); sint[i] = sinf(ang);
    }
    if (blockIdx.x == 0 && tid < DEPTH) {
        float d1 = 0.f, d2 = 0.f;
        for (int j = 0; j < 32; ++j) { d1 += P.a_lq1[tid * 32 + j] * P.a_lk1[tid * 32 + j]; d2 += P.a_lq2[tid * 32 + j] * P.a_lk2[tid * 32 + j]; }
        ((float*)(P.ws + WS_LAM))[tid] = expf(d1) - expf(d2) + (0.8f - 0.6f * expf(-0.3f * (float)tid));
    }
}

__device__ __forceinline__ void ffn_fixup(const Params& P, int layer) {
    const bf16_t* UB = (const bf16_t*)(P.ws + WS_UBND); bf16_t* ACT = (bf16_t*)(P.ws + WS_ACT);
    const float* cw = P.conv_w + (size_t)layer * 3 * NUP; const float* cb = P.conv_b + (size_t)layer * NUP;
    constexpr int CG = DFF / 8;
    for (int it = blockIdx.x * 512 + threadIdx.x; it < 512 * 2 * CG; it += gridDim.x * 512) {
        const int cgi = it % CG, e = (it / CG) & 1, chunk = it / (2 * CG), col = cgi * 8;
        const bf16_t *up, *mid, *dn; bool zu = false, zd = false;
        if (e == 0) { zu = (chunk % 32) == 0; up = UB + ((size_t)(zu ? chunk : chunk - 1) * 4 + 3) * NUP; mid = UB + ((size_t)chunk * 4 + 0) * NUP; dn = UB + ((size_t)chunk * 4 + 1) * NUP; }
        else { zd = (chunk % 32) == 31; up = UB + ((size_t)chunk * 4 + 2) * NUP; mid = UB + ((size_t)chunk * 4 + 3) * NUP; dn = UB + ((size_t)(zd ? chunk : chunk + 1) * 4 + 0) * NUP; }
        const float fu = zu ? 0.f : 1.f, fd = zd ? 0.f : 1.f;
        float res[8];
        bf16_t ug[8], mg[8], dg[8], uv[8], mv[8], dv[8];
        *(u32x4*)ug = *(const u32x4*)(up + col); *(u32x4*)mg = *(const u32x4*)(mid + col); *(u32x4*)dg = *(const u32x4*)(dn + col);
        *(u32x4*)uv = *(const u32x4*)(up + DFF + col); *(u32x4*)mv = *(const u32x4*)(mid + DFF + col); *(u32x4*)dv = *(const u32x4*)(dn + DFF + col);
#pragma unroll
        for (int k = 0; k < 8; ++k) {
            const int cg_ = col + k, cv_ = DFF + col + k;
            const float gt = cw[cg_] * bf2f(ug[k]) * fu + cw[NUP + cg_] * bf2f(mg[k]) + cw[2 * NUP + cg_] * bf2f(dg[k]) * fd + cb[cg_];
            const float vl = cw[cv_] * bf2f(uv[k]) * fu + cw[NUP + cv_] * bf2f(mv[k]) + cw[2 * NUP + cv_] * bf2f(dv[k]) * fd + cb[cv_];
            res[k] = gt * fast_rcp(1.f + fast_exp2(-LOG2E * gt)) * vl;
        }
        u32x4 w; w.x = cvtpk(res[0], res[1]); w.y = cvtpk(res[2], res[3]); w.z = cvtpk(res[4], res[5]); w.w = cvtpk(res[6], res[7]);
        *(u32x4*)(ACT + (size_t)(chunk * 64 + (e ? 63 : 0)) * DFF + col) = w;
    }
}


#define XB_TMO      128
#define XB_XCNT(j)  (256  + 64 * (j))
#define XB_XSUB(j)  (1280 + 64 * (j))
#define XB_XGEN(j)  (2304 + 64 * (j))
#define XB_TOP      3328
#define XB_TOPGEN   3392
#define XCD_BAR_WORDS 3456
#define XB_SPIN_CAP (1u << 22)
__device__ __forceinline__ unsigned xb_ld(unsigned* p)              { return __hip_atomic_load(p, __ATOMIC_RELAXED, __HIP_MEMORY_SCOPE_AGENT); }
__device__ __forceinline__ unsigned xb_add(unsigned* p, unsigned v) { return __hip_atomic_fetch_add(p, v, __ATOMIC_RELAXED, __HIP_MEMORY_SCOPE_AGENT); }
__device__ __forceinline__ unsigned xb_xcc_id() { return (unsigned)__builtin_amdgcn_s_getreg((3 << 11) | 20) & 0xFu; }
#define XB_SPIN(cond, bar) do { unsigned _sp = 0; while (cond) { __builtin_amdgcn_s_sleep(1); \
    if ((++_sp & 255u) == 0u) { if (xb_ld(&(bar)[XB_TMO])) break; if (_sp > XB_SPIN_CAP) { atomicAdd(&(bar)[XB_TMO], 1u); break; } } } } while (0)
struct XcdBarrier { unsigned* bar; unsigned x; volatile LAS unsigned* st; };
__device__ __forceinline__ XcdBarrier xcd_barrier_post(unsigned* bar, volatile LAS unsigned* st) {
    XcdBarrier b; b.bar = bar; b.x = xb_xcc_id(); b.st = st;
    if (threadIdx.x == 0) (void)xb_add(&bar[XB_XCNT(b.x)], 1u);
    return b;
}
__device__ __forceinline__ void xcd_barrier_complete(unsigned* bar, unsigned x, unsigned& nloc, unsigned& nx) {
    const unsigned G = gridDim.x * gridDim.y * gridDim.z;
    unsigned sum, cnt, mine, sp = 0u;
    for (;;) {
        sum = 0u; cnt = 0u; mine = 0u;
#pragma unroll
        for (unsigned j = 0; j < 16; ++j) { const unsigned c = xb_ld(&bar[XB_XCNT(j)]); sum += c; cnt += (c > 0u) ? 1u : 0u; mine = (j == x) ? c : mine; }
        if (sum == G) break;
        __builtin_amdgcn_s_sleep(1);
        if ((++sp & 255u) == 0u) { if (xb_ld(&bar[XB_TMO])) break; if (sp > XB_SPIN_CAP) { atomicAdd(&bar[XB_TMO], 1u); break; } }
    }
    nloc = mine > 0u ? mine : 1u; nx = cnt > 0u ? cnt : 1u;
}
__device__ __forceinline__ void xcd_barrier(const XcdBarrier& b) {
    asm volatile("s_waitcnt vmcnt(0)" ::: "memory");
    __syncthreads();
    if (threadIdx.x == 0) {
        unsigned* bar = b.bar;
        __builtin_amdgcn_s_waitcnt(0);
        unsigned nloc = b.st[0], nx = b.st[1];
        if (nloc == 0u) { xcd_barrier_complete(bar, b.x, nloc, nx); b.st[0] = nloc; b.st[1] = nx; }
        const unsigned old = xb_add(&bar[XB_XSUB(b.x)], 1u);
        const unsigned gen = old / nloc;
        if (old + 1u == (gen + 1u) * nloc) {
            __builtin_amdgcn_fence(__ATOMIC_RELEASE, "agent");
            asm volatile("s_waitcnt vmcnt(0)" ::: "memory");
            const unsigned og = xb_add(&bar[XB_TOP], 1u);
            const unsigned tg = og / nx;
            if (og + 1u == (tg + 1u) * nx) xb_add(&bar[XB_TOPGEN], 1u);
            else XB_SPIN(xb_ld(&bar[XB_TOPGEN]) == tg, bar);
            __builtin_amdgcn_fence(__ATOMIC_ACQUIRE, "agent");
            xb_add(&bar[XB_XGEN(b.x)], 1u);
            asm volatile("s_waitcnt vmcnt(0)" ::: "memory");
        } else {
            XB_SPIN(xb_ld(&bar[XB_XGEN(b.x)]) == gen, bar);
            __builtin_amdgcn_fence(__ATOMIC_ACQUIRE, "agent");
            asm volatile("s_waitcnt vmcnt(0)" ::: "memory");
        }
    }
    __syncthreads();
}

__global__ void __launch_bounds__(512, 2) fwd_megakernel(Params P) {
    extern __shared__ __attribute__((aligned(16))) unsigned char lds_raw[];
    LAS unsigned char* lds = (LAS unsigned char*)lds_raw;
    cg::grid_group grid = cg::this_grid();
#define GRID_SYNC() do { asm volatile("s_waitcnt vmcnt(0) lgkmcnt(0)" ::: "memory"); __syncthreads(); grid.sync(); \
        __builtin_amdgcn_fence(__ATOMIC_ACQUIRE, "agent"); asm volatile("s_waitcnt vmcnt(0)" ::: "memory"); GRID_SYNC2(); } while (0)
#if MK_DUP_SYNC > 1
#define GRID_SYNC2() do { grid.sync(); __builtin_amdgcn_fence(__ATOMIC_ACQUIRE, "agent"); asm volatile("s_waitcnt vmcnt(0)" ::: "memory"); } while (0)
#else
#define GRID_SYNC2() do {} while (0)
#endif
    unsigned char* ws = P.ws;
    if (ws == nullptr) grid.sync();
    float* ssqA = (float*)(ws + WS_SSQA); float* ssqB = (float*)(ws + WS_SSQB); float* ssqQ = (float*)(ws + WS_SSQQ); float* ssqKV = (float*)(ws + WS_SSQKV);
    const float* cost = (const float*)(ws + WS_COS); const float* sint = (const float*)(ws + WS_SIN);
    bf16_t* xb = (bf16_t*)(ws + WS_XB); bf16_t* proj = (bf16_t*)(ws + WS_PROJ); bf16_t* cq = (bf16_t*)(ws + WS_CQ); bf16_t* ckv = (bf16_t*)(ws + WS_CKV);
    bf16_t* mix = (bf16_t*)(ws + WS_MIX); bf16_t* act = (bf16_t*)(ws + WS_ACT); bf16_t* ubnd = (bf16_t*)(ws + WS_UBND);

    volatile LAS unsigned* bst = (volatile LAS unsigned*)(lds + 131072 + 64);
    if (threadIdx.x < 2) bst[threadIdx.x] = 0u;
    __syncthreads();
    const XcdBarrier xbar = xcd_barrier_post((unsigned*)(ws + WS_BAR), bst);
    prologue(P, lds);
#if MK_DUP_BAR > 1
#define XBAR() do { xcd_barrier(xbar); xcd_barrier(xbar); } while (0)
#else
#define XBAR() xcd_barrier(xbar)
#endif
    for (int l = 0; l <= DEPTH; ++l) {
        XBAR();
        if (l == DEPTH) break;
        const unsigned char* wl = ws + WS_W + (size_t)l * W_LAYER;
#if !(MK_SKIP & 1)
        { pg8::Gemm g{xb, (const bf16_t*)(wl + W_IN), T_TOK, NPROJW, DM, DM}; EpiProj E{proj, ssqA, ssqQ, ssqKV, cost, sint}; pg8::gemm_phase(lds, g, E); }
#if MK_DUP_IN > 1
        { pg8::Gemm g{xb, (const bf16_t*)(wl + W_IN), T_TOK, NPROJW, DM, DM}; EpiProj E{proj, ssqA, ssqQ, ssqKV, cost, sint}; pg8::gemm_phase(lds, g, E); }
#endif
#endif
        XBAR();
#if !(MK_SKIP & 2)
        { pg8::Gemm g{proj + 1536, (const bf16_t*)(wl + W_UQ), T_TOK, NCQ, 256, NPROJ}; EpiMla<true, 8> E{cq, PCQ, ssqQ, 1.0f / 256.0f, cost, sint}; pg8::gemm_phase(lds, g, E); }
        { pg8::Gemm g{proj + 1792, (const bf16_t*)(wl + W_UKV), T_TOK, NCKV, 128, NPROJ}; EpiMla<false, 4> E{ckv, PCKV, ssqKV, 1.0f / 128.0f, cost, sint}; pg8::gemm_phase(lds, g, E); }
#if MK_DUP_MLA > 1
        { pg8::Gemm g{proj + 1536, (const bf16_t*)(wl + W_UQ), T_TOK, NCQ, 256, NPROJ}; EpiMla<true, 8> E{cq, PCQ, ssqQ, 1.0f / 256.0f, cost, sint}; pg8::gemm_phase(lds, g, E); }
        { pg8::Gemm g{proj + 1792, (const bf16_t*)(wl + W_UKV), T_TOK, NCKV, 128, NPROJ}; EpiMla<false, 4> E{ckv, PCKV, ssqKV, 1.0f / 128.0f, cost, sint}; pg8::gemm_phase(lds, g, E); }
#endif
#endif
#if !(MK_SKIP & 4)
        for (int rep_ = 0; rep_ < MK_DUP_AB; ++rep_)
        {
            const bool xm = (gridDim.x == 256); const int x_ = blockIdx.x & 7, j_ = blockIdx.x >> 3;
            for (int u = blockIdx.x, i_ = 0; u < 512; u += gridDim.x, ++i_) {
                int bh = u >> 3, qb = u & 7;
                if (xm) { const int hh_ = i_ ? 3 - (j_ >> 3) : (j_ >> 3); bh = (x_ * 2 + i_) * 4 + hh_; qb = j_ & 7; }
                attn_unit<1, 1>(lds, P, l, bh >> 2, bh & 3, qb);
            }
            for (int u = blockIdx.x, i_ = 0; u < 512; u += gridDim.x, ++i_) {
                int bh = (u >> 3) & 63, qb = u & 7; if (u >= 256) qb = (qb + 4) & 7;
                if (xm) { const int hb_ = (j_ >> 3) ^ 1, hh_ = i_ ? 3 - hb_ : hb_; bh = (x_ * 2 + i_) * 4 + hh_; qb = ((j_ & 7) + 4 * i_) & 7; }
                attn_unit<2, 1>(lds, P, l, bh >> 2, bh & 3, qb);
            }
        }
#endif
        XBAR();
#if !(MK_SKIP & 8)
        for (int rep_ = 0; rep_ < MK_DUP_C; ++rep_)
        {
            const bool xm = (gridDim.x == 256); const int x_ = blockIdx.x & 7, j_ = blockIdx.x >> 3;
            for (int u = blockIdx.x, i_ = 0; u < 512; u += gridDim.x, ++i_) {
                int bh = u >> 2, qb = u & 3; if (xm) { bh = x_ * 16 + i_ * 8 + (j_ >> 2); qb = j_ & 3; }
                attn_unit<0, 2>(lds, P, l, bh >> 3, bh & 7, qb);
            }
        }
#endif
        XBAR();
#if !(MK_SKIP & 16)
        { pg8::Gemm g{mix, (const bf16_t*)(wl + W_OUT), T_TOK, DM, DM, DM}; EpiResid E{xb, ssqB, (LAS float*)(lds + 131072 + 1024)}; pg8::gemm_phase(lds, g, E); }
#endif
        XBAR();
#if !(MK_SKIP & 32)
        { pg8::Gemm g{xb, (const bf16_t*)(wl + W_UP), T_TOK, NUP, DM, DM}; EpiUp E{act, ubnd, ssqB, P.conv_w + (size_t)l * 3 * NUP, P.conv_b + (size_t)l * NUP}; pg8::gemm_phase(lds, g, E); }
#if MK_DUP_UP > 1
        { pg8::Gemm g{xb, (const bf16_t*)(wl + W_UP), T_TOK, NUP, DM, DM}; EpiUp E{act, ubnd, ssqB, P.conv_w + (size_t)l * 3 * NUP, P.conv_b + (size_t)l * NUP}; pg8::gemm_phase(lds, g, E); }
#endif
#endif
        XBAR();
        ffn_fixup(P, l);
        XBAR();
#if !(MK_SKIP & 64)
        { pg8::Gemm g{act, (const bf16_t*)(wl + W_DOWN), T_TOK, DM, DFF, DFF}; EpiResid E{xb, ssqA, (LAS float*)(lds + 131072 + 1024)}; pg8::gemm_phase(lds, g, E); }
#endif
    }
    for (int i = blockIdx.x * 512 + threadIdx.x; i < T_TOK * (DM / 4); i += gridDim.x * 512) {
        const int row = i >> 8, c4 = i & 255;
        const float rs = rsqrtf(ssq_sum<4>(ssqA + (size_t)row * 4) * (1.0f / DM) + EPS);
        const u32x2 xv = ((const u32x2*)xb)[i]; const f32x4 gv = ((const f32x4*)P.g_final)[c4];
        f32x4 v; v[0] = __uint_as_float(xv.x << 16); v[1] = __uint_as_float(xv.x & 0xffff0000u); v[2] = __uint_as_float(xv.y << 16); v[3] = __uint_as_float(xv.y & 0xffff0000u);
        ((f32x4*)P.out)[i] = v * rs * gv;
    }
}

extern "C" void kernel_launch(void* const* d_in, const int* in_sizes, int n_in, void* d_out, int out_size, void* d_ws, size_t ws_size, hipStream_t stream) {
    static int grid_blocks = 0;
    if (!grid_blocks) {
        if (n_in != 19 || ws_size < WS_END) { fprintf(stderr, "kernel_launch: unexpected n_in %d / ws %zu\n", n_in, ws_size); grid_blocks = -1; return; }
        int dev = 0, cus = 0, per_cu = 0;
        hipGetDevice(&dev);
        hipDeviceGetAttribute(&cus, hipDeviceAttributeMultiprocessorCount, dev);
        hipFuncSetAttribute((const void*)fwd_megakernel, hipFuncAttributeMaxDynamicSharedMemorySize, LDS_BYTES);
        hipOccupancyMaxActiveBlocksPerMultiprocessor(&per_cu, (const void*)fwd_megakernel, 512, LDS_BYTES);
        if (per_cu < 1) { fprintf(stderr, "kernel_launch: occupancy query says %d blocks/CU\n", per_cu); per_cu = 1; }
        grid_blocks = cus * per_cu;
    }
    if (grid_blocks < 0) return;
    Params p{};
    const float** f = (const float**)&p;
    for (int i = 0; i < 19; ++i) f[i] = (const float*)d_in[i];
    p.out = (float*)d_out; p.ws = (unsigned char*)d_ws;
    (void)hipMemsetAsync((char*)d_ws + WS_BAR, 0, WS_BAR_BYTES, stream);
    void* args[] = {&p};
    hipError_t e = hipLaunchCooperativeKernel((const void*)fwd_megakernel, dim3(grid_blocks), dim3(512), args, LDS_BYTES, stream);
    if (e != hipSuccess) fprintf(stderr, "cooperative launch failed: %s (grid %d)\n", hipGetErrorString(e), grid_blocks);
}
```
